# Optimizing an MI355X kernel written in HIP

```python
import jax
import jax.numpy as jnp
from jax import lax
import numpy as np

D_MODEL = 1024
BATCH = 8
SEQ = 4096
DEPTH = 1

GRID_W = 64
CTX_LEN = 256

CONV_CH = 512
CONV_GROUPS = 8
GLA_HEADS = 4
GLA_DK = 64
GLA_DV = 128
GLA_KEY = GLA_HEADS * GLA_DK
GLA_VAL = GLA_HEADS * GLA_DV
GLA_GATE_RANK = 16
GLA_TAU = 16.0
GLA_CHUNK = 16
MIX_WIDTH = CONV_CH + GLA_VAL

OFF_AB = 0
OFF_AC = OFF_AB + CONV_CH
OFF_AX = OFF_AC + CONV_CH
OFF_Q = OFF_AX + CONV_CH
OFF_K = OFF_Q + GLA_KEY
OFF_V = OFF_K + GLA_KEY
OFF_R = OFF_V + GLA_VAL
OFF_GF = OFF_R + GLA_VAL
OFF_GB = OFF_GF + GLA_GATE_RANK
D_PROJ = OFF_GB + GLA_GATE_RANK

N_GROUPS = 4
EXPERTS_PER_GROUP = 4
N_EXPERTS = N_GROUPS * EXPERTS_PER_GROUP
TOP_K_IN_GROUP = 2
D_EXPERT = 512

LN_EPS = 1e-5
RMS_EPS = 1e-6
DEEPNORM_ALPHA = (2.0 * DEPTH) ** 0.25
DEEPNORM_BETA = (8.0 * DEPTH) ** -0.25

kernel_name = "hymba_conv_gla_hmoe_diffusion_layer"


def layer_norm(x, g, b):
    xf = x.astype(jnp.float32)
    mu = jnp.mean(xf, axis=-1, keepdims=True)
    var = jnp.mean(jnp.square(xf - mu), axis=-1, keepdims=True)
    y = (xf - mu) * lax.rsqrt(var + LN_EPS)
    return (y * g.astype(jnp.float32) + b.astype(jnp.float32)).astype(x.dtype)


def rms_norm(x, g):
    xf = x.astype(jnp.float32)
    y = xf * lax.rsqrt(jnp.mean(jnp.square(xf), axis=-1, keepdims=True) + RMS_EPS)
    return y * g.astype(jnp.float32)


def ada_params(cond, w_ada, b_ada):
    return jnp.split(jax.nn.silu(cond) @ w_ada + b_ada, 6, axis=-1)


def modulate(x, shift, scale):
    return x * (1.0 + scale) + shift


def post_norm_residual(x, y, gate, g, b):
    return layer_norm(DEEPNORM_ALPHA * x + gate * y, g, b)


def dwconv3(u, w, b):
    n = u.shape[-2]
    pad = [(0, 0)] * (u.ndim - 2) + [(1, 1), (0, 0)]
    up = jnp.pad(u, pad)
    return up[..., 0:n, :] * w[0] + up[..., 1:n + 1, :] * w[1] + up[..., 2:n + 2, :] * w[2] + b


def to_heads(a, d):
    bsz, t, _ = a.shape
    return a.reshape(bsz, t, GLA_HEADS, d).transpose(0, 2, 1, 3).astype(jnp.float32)


def log_decay(low, w2, b2):
    return jax.nn.log_sigmoid((low @ w2 + b2).astype(jnp.float32)) / GLA_TAU


def gla_chunked(q, k, v, g, s0):
    bsz, h, t, dk = q.shape
    dv = v.shape[-1]
    n = t // GLA_CHUNK
    q, k, g = (a.reshape(bsz, h, n, GLA_CHUNK, dk) for a in (q, k, g))
    v = v.reshape(bsz, h, n, GLA_CHUNK, dv)
    gc = jnp.cumsum(g, axis=3)
    g_last = gc[:, :, :, -1:, :]
    q_dec = q * jnp.exp(gc)
    k_inv = k * jnp.exp(-gc)
    k_end = k * jnp.exp(g_last - gc)
    lower = jnp.tril(jnp.ones((GLA_CHUNK, GLA_CHUNK), dtype=bool))
    scores = jnp.where(lower, jnp.einsum("bhncd,bhnsd->bhncs", q_dec, k_inv), 0.0)
    o_intra = jnp.einsum("bhncs,bhnse->bhnce", scores, v)
    u = jnp.einsum("bhncd,bhnce->bhnde", k_end, v)
    decay = jnp.exp(g_last[:, :, :, 0, :])

    def step(s, inp):
        dec_n, u_n = inp
        return dec_n[..., None] * s + u_n, s

    s_final, s_start = lax.scan(step, s0, (jnp.moveaxis(decay, 2, 0), jnp.moveaxis(u, 2, 0)))
    s_start = jnp.moveaxis(s_start, 0, 2)
    o_inter = jnp.einsum("bhncd,bhnde->bhnce", q_dec, s_start)
    return (o_intra + o_inter).reshape(bsz, h, t, dv), s_final


def flip_t(a):
    return jnp.flip(a, axis=2)


def gla_bidirectional(q, k, v, g_fwd, g_bwd, s0_fwd, s0_bwd):
    o_f, s_f = gla_chunked(q, k, v, g_fwd, s0_fwd)
    o_b, s_b = gla_chunked(flip_t(q), flip_t(k), flip_t(v), flip_t(g_bwd), s0_bwd)
    return o_f + flip_t(o_b), s_f, s_b


def gla_final_state(k, v, g):
    gc = jnp.cumsum(g, axis=2)
    w = jnp.exp(gc[:, :, -1:, :] - gc)
    return jnp.einsum("bhtd,bhte->bhde", k * w, v)


def hybrid_mixer(h, w_in, conv_w, conv_b, gw_f, gb_f, gw_b, gb_b, gla_norm_g, w_out,
                 s0_fwd, s0_bwd, on_grid):
    bsz, t, _ = h.shape
    p = h @ w_in
    a_b, a_c, a_x, q, k, v, r, low_f, low_b = jnp.split(
        p, [OFF_AC, OFF_AX, OFF_Q, OFF_K, OFF_V, OFF_R, OFF_GF, OFF_GB], axis=-1)
    u = a_c * a_x
    if on_grid:
        rows = t // GRID_W
        u_conv = dwconv3(u.reshape(bsz, rows, GRID_W, CONV_CH), conv_w, conv_b).reshape(bsz, t, CONV_CH)
    else:
        u_conv = dwconv3(u, conv_w, conv_b)
    y_a = a_b * u_conv
    qh = to_heads(q, GLA_DK) * (GLA_DK ** -0.5)
    kh = to_heads(k, GLA_DK)
    vh = to_heads(v, GLA_DV)
    gf = to_heads(log_decay(low_f, gw_f, gb_f), GLA_DK)
    gb = to_heads(log_decay(low_b, gw_b, gb_b), GLA_DK)
    o, s_f, s_b = gla_bidirectional(qh, kh, vh, gf, gb, s0_fwd, s0_bwd)
    o = rms_norm(o, gla_norm_g).transpose(0, 2, 1, 3).reshape(bsz, t, GLA_VAL)
    y_b = o.astype(h.dtype) * jax.nn.silu(r)
    y = jnp.concatenate([y_a, y_b], axis=-1) @ w_out
    return y, s_f, s_b


def context_gla_states(hc, w_in, gw_f, gb_f, gw_b, gb_b):
    kv = hc @ w_in[:, OFF_K:OFF_R]
    low = hc @ w_in[:, OFF_GF:D_PROJ]
    kh = to_heads(kv[..., :GLA_KEY], GLA_DK)
    vh = to_heads(kv[..., GLA_KEY:], GLA_DV)
    gf = to_heads(log_decay(low[..., :GLA_GATE_RANK], gw_f, gb_f), GLA_DK)
    gb = to_heads(log_decay(low[..., GLA_GATE_RANK:], gw_b, gb_b), GLA_DK)
    return gla_final_state(kh, vh, gf), gla_final_state(flip_t(kh), flip_t(vh), flip_t(gb))


def hier_moe(h, wgr, bgr, wer, ber, w1, w3, w2):
    bsz, t, d = h.shape
    tok = h.reshape(bsz * t, d)
    group_prob = jax.nn.softmax((tok @ wgr + bgr).astype(jnp.float32), axis=-1)
    p_g, g_idx = lax.top_k(group_prob, 1)
    exp_logits = (tok @ wer + ber).astype(jnp.float32).reshape(-1, N_GROUPS, EXPERTS_PER_GROUP)
    sel = jnp.take_along_axis(exp_logits, g_idx[:, :, None], axis=1)[:, 0]
    top_w, top_i = lax.top_k(jax.nn.softmax(sel, axis=-1), TOP_K_IN_GROUP)
    top_w = top_w / jnp.sum(top_w, axis=-1, keepdims=True)
    within = jnp.sum(jax.nn.one_hot(top_i, EXPERTS_PER_GROUP, dtype=jnp.float32) * top_w[..., None], axis=1)
    combine = jax.nn.one_hot(g_idx[:, 0], N_GROUPS, dtype=jnp.float32)[:, :, None] * (
        p_g[:, :, None] * within[:, None, :])
    combine = combine.reshape(-1, N_EXPERTS).astype(h.dtype)
    out = jnp.zeros_like(tok)
    for e in range(N_EXPERTS):
        act = jax.nn.silu(tok @ w1[e]) * (tok @ w3[e])
        out = out + combine[:, e:e + 1] * (act @ w2[e])
    return out.reshape(bsz, t, d)


def setup_inputs(seed: int = 0) -> dict:
    key = jax.random.key(seed)
    ks = jax.random.split(key, 28)
    f32 = jnp.float32
    L, D = DEPTH, D_MODEL

    def nrm(k, shape, s):
        return jax.random.normal(k, shape, f32) * s

    return {
        "x": nrm(ks[0], (BATCH, SEQ, D), 1.0),
        "c": nrm(ks[1], (BATCH, D), 1.0),
        "ctx": nrm(ks[2], (BATCH, CTX_LEN, D), 1.0),
        "c_ctx": nrm(ks[3], (D,), 1.0),
        "ln_in_g": 1.0 + nrm(ks[4], (D,), 0.02),
        "ln_in_b": nrm(ks[5], (D,), 0.02),
        "w_ada": nrm(ks[6], (L, D, 6 * D), D ** -0.5),
        "b_ada": nrm(ks[7], (L, 6 * D), 0.02),
        "w_in": nrm(ks[8], (L, D, D_PROJ), D ** -0.5),
        "conv_w": nrm(ks[9], (L, 3, CONV_CH), 3 ** -0.5),
        "conv_b": nrm(ks[10], (L, CONV_CH), 0.02),
        "gate_w2_fwd": nrm(ks[11], (L, GLA_GATE_RANK, GLA_KEY), GLA_GATE_RANK ** -0.5),
        "gate_b_fwd": nrm(ks[12], (L, GLA_KEY), 0.02),
        "gate_w2_bwd": nrm(ks[13], (L, GLA_GATE_RANK, GLA_KEY), GLA_GATE_RANK ** -0.5),
        "gate_b_bwd": nrm(ks[14], (L, GLA_KEY), 0.02),
        "gla_norm_g": 1.0 + nrm(ks[15], (L, GLA_DV), 0.02),
        "w_out": nrm(ks[16], (L, MIX_WIDTH, D), MIX_WIDTH ** -0.5 * DEEPNORM_BETA),
        "ln1_g": 1.0 + nrm(ks[17], (L, D), 0.02),
        "ln1_b": nrm(ks[18], (L, D), 0.02),
        "router_group_w": nrm(ks[19], (L, D, N_GROUPS), D ** -0.5),
        "router_group_b": nrm(ks[20], (L, N_GROUPS), 0.01),
        "router_expert_w": nrm(ks[21], (L, D, N_EXPERTS), D ** -0.5),
        "router_expert_b": nrm(ks[22], (L, N_EXPERTS), 0.01),
        "expert_w1": nrm(ks[23], (L, N_EXPERTS, D, D_EXPERT), D ** -0.5),
        "expert_w3": nrm(ks[24], (L, N_EXPERTS, D, D_EXPERT), D ** -0.5),
        "expert_w2": nrm(ks[25], (L, N_EXPERTS, D_EXPERT, D), D_EXPERT ** -0.5 * DEEPNORM_BETA),
        "ln2_g": 1.0 + nrm(ks[26], (L, D), 0.02),
        "ln2_b": nrm(ks[27], (L, D), 0.02),
    }


def reference(x, c, ctx, c_ctx, ln_in_g, ln_in_b, w_ada, b_ada, w_in, conv_w, conv_b,
              gate_w2_fwd, gate_b_fwd, gate_w2_bwd, gate_b_bwd, gla_norm_g, w_out,
              ln1_g, ln1_b, router_group_w, router_group_b, router_expert_w, router_expert_b,
              expert_w1, expert_w3, expert_w2, ln2_g, ln2_b):
    bsz = x.shape[0]
    x = layer_norm(x, ln_in_g, ln_in_b)
    xc = layer_norm(ctx, ln_in_g, ln_in_b)
    for l in range(DEPTH):
        last = l == DEPTH - 1
        sh1, sc1, g1, sh2, sc2, g2 = (m[:, None, :] for m in ada_params(c, w_ada[l], b_ada[l]))
        csh1, csc1, cg1, csh2, csc2, cg2 = ada_params(c_ctx, w_ada[l], b_ada[l])
        mix_w = (w_in[l], conv_w[l], conv_b[l], gate_w2_fwd[l], gate_b_fwd[l],
                 gate_w2_bwd[l], gate_b_bwd[l], gla_norm_g[l], w_out[l])
        moe_w = (router_group_w[l], router_group_b[l], router_expert_w[l], router_expert_b[l],
                 expert_w1[l], expert_w3[l], expert_w2[l])
        hc = modulate(xc, csh1, csc1)
        if last:
            s_f, s_b = context_gla_states(hc, w_in[l], gate_w2_fwd[l], gate_b_fwd[l],
                                          gate_w2_bwd[l], gate_b_bwd[l])
        else:
            zeros = jnp.zeros((bsz, GLA_HEADS, GLA_DK, GLA_DV), jnp.float32)
            yc, s_f, s_b = hybrid_mixer(hc, *mix_w, zeros, zeros, False)
            xc = post_norm_residual(xc, yc, cg1, ln1_g[l], ln1_b[l])
            xc = post_norm_residual(xc, hier_moe(modulate(xc, csh2, csc2), *moe_w), cg2, ln2_g[l], ln2_b[l])
        h = modulate(x, sh1, sc1)
        y, _, _ = hybrid_mixer(h, *mix_w, s_f, s_b, True)
        x = post_norm_residual(x, y, g1, ln1_g[l], ln1_b[l])
        x = post_norm_residual(x, hier_moe(modulate(x, sh2, sc2), *moe_w), g2, ln2_g[l], ln2_b[l])
    return x
```

```cpp
#include <hip/hip_runtime.h>
#include <stdint.h>
#include <stdio.h>

typedef unsigned short bf16_t;
constexpr int D = 1024, NB = 8, SEQ = 4096, NTOK = NB * SEQ, CTXL = 256, NCTX = NB * CTXL;
constexpr int DPROJ = 3104, NP = 3072;
constexpr int OFF_AB = 0, OFF_AC = 512, OFF_AX = 1024, OFF_Q = 1536, OFF_K = 1792, OFF_V = 2048, OFF_R = 2560;
constexpr int NCLS = 24, MOE_ROWS = NTOK + NCLS * 256, MOE_TILES = MOE_ROWS / 256;
constexpr float ALPHA = 1.189207115002721f;

struct Params {
  const float *x, *c, *ctx, *c_ctx, *ln_in_g, *ln_in_b, *w_ada, *b_ada, *w_in, *conv_w, *conv_b, *gw_f, *gb_f, *gw_b, *gb_b, *gla_g, *w_out,
      *ln1_g, *ln1_b, *wgr, *bgr, *wer, *ber, *w1, *w3, *w2, *ln2_g, *ln2_b;
  float* out;
  unsigned* ctrl;
  float* mod;
  bf16_t* WinT;
  bf16_t* WgT;
  bf16_t* WoutT;
  unsigned char* W13Q;
  unsigned char* W2Q;
  unsigned char* h2q;
  unsigned char* h2qs;
  unsigned char* actq;
  bf16_t* hln;
  bf16_t* hc;
  float* stats;
  float* low;
  bf16_t* p;
  bf16_t* pctx;
  float* ctxS;
  bf16_t* ymix;
  bf16_t* ybuf;
  bf16_t* x1;
  bf16_t* h2;
  int* cls;
  float* cw;
  int* hist;
  int* perm;
  int* sidx;
  int* tileinfo;
  float* cws;
  bf16_t* h2s;
  bf16_t* act;
  bf16_t* moes;
  bf16_t* gqd;
  bf16_t* gkinv;
  bf16_t* gke;
  float* gdec;
  float* Useg;
  float* Dseg;
  bf16_t* opart;
  float* o_f;
  float* o_b;
};

constexpr int MEGA_LDS = 160 * 1024, TIDTAB_OFF = MEGA_LDS - 16 - 256;
__device__ __forceinline__ int opaque_tid() {
  const unsigned hw = (unsigned)__builtin_amdgcn_s_getreg((6 << 11) | 4) & 63u;
  int lane; asm volatile("v_mbcnt_lo_u32_b32 %0, -1, 0\n\tv_mbcnt_hi_u32_b32 %0, -1, %0" : "=v"(lane));
  int wid = *(const __attribute__((address_space(3))) int*)(TIDTAB_OFF + hw * 4);
  wid = __builtin_amdgcn_readfirstlane(wid);
  int t = wid * 64 + lane; asm volatile("" : "+v"(t)); return t;
}
__device__ __forceinline__ float bf2f(bf16_t v) { return __uint_as_float(((unsigned)v) << 16); }
__device__ __forceinline__ bf16_t f2bf(float f) { return __builtin_bit_cast(bf16_t, (__bf16)f); }
typedef __bf16 bf16v2_t __attribute__((ext_vector_type(2)));
typedef float f32v2_t __attribute__((ext_vector_type(2)));
__device__ __forceinline__ unsigned pack2(float a, float b) { const f32v2_t v = {a, b}; return __builtin_bit_cast(unsigned, __builtin_convertvector(v, bf16v2_t)); }
__device__ __forceinline__ unsigned pack4_fp8(float a, float b, float c, float d) {
  a = __builtin_amdgcn_fmed3f(a, -448.f, 448.f); b = __builtin_amdgcn_fmed3f(b, -448.f, 448.f); c = __builtin_amdgcn_fmed3f(c, -448.f, 448.f); d = __builtin_amdgcn_fmed3f(d, -448.f, 448.f);
  unsigned w = 0; w = __builtin_amdgcn_cvt_pk_fp8_f32(a, b, w, false); w = __builtin_amdgcn_cvt_pk_fp8_f32(c, d, w, true); return w;
}
__device__ __forceinline__ float wave_sum(float v) {
#define DPP_ADD_(ctrl, rmask) v += __int_as_float(__builtin_amdgcn_update_dpp(0, __float_as_int(v), ctrl, rmask, 0xF, true))
  DPP_ADD_(0xB1, 0xF); DPP_ADD_(0x4E, 0xF); DPP_ADD_(0x141, 0xF); DPP_ADD_(0x140, 0xF); DPP_ADD_(0x142, 0xA); DPP_ADD_(0x143, 0xC);
#undef DPP_ADD_
  return __int_as_float(__builtin_amdgcn_readlane(__float_as_int(v), 63));
}
__device__ __forceinline__ float siluf(float v) { return v * __builtin_amdgcn_rcpf(1.f + __expf(-v)); }
__device__ __forceinline__ float logsigmoidf(float z) { return fminf(z, 0.f) - log1pf(__expf(-fabsf(z))); }
__device__ __forceinline__ float logsigmoid_fast(float z) { return fminf(z, 0.f) - 0.6931471806f * __builtin_amdgcn_logf(1.f + __builtin_amdgcn_exp2f(-1.4426950409f * fabsf(z))); }

__device__ __forceinline__ int rowmap(int n, int mode) { return mode == 0 ? n : ((n >> 7) * 256 + (mode == 2 ? 128 : 0) + (n & 127)); }
struct CvJob { const float* src; bf16_t* dst; int ld_src, k0, n0, nvalid, nbase, ldd, mode, q8; };
__device__ __forceinline__ void cv_decode(const Params& P, int ti, CvJob& j) {
  j.nvalid = 64; j.nbase = 0; j.mode = 0; j.q8 = 0;
  if (ti < 384) { const int kt = ti % 8, nt = ti / 8; j.src = P.w_in; j.ld_src = DPROJ; j.k0 = kt * 128; j.n0 = nt * 64; j.dst = P.WinT; j.ldd = 1024;
    if (j.n0 >= OFF_AC && j.n0 < OFF_AX + 512) { const int isx = j.n0 >= OFF_AX, c = j.n0 - (isx ? OFF_AX : OFF_AC); j.nbase = j.n0 - ((2 + (c >> 7)) * 256 + isx * 128 + (c & 127)); } }
  else if (ti < 392) { const int kt = ti - 384; j.src = P.w_in; j.ld_src = DPROJ; j.k0 = kt * 128; j.n0 = 3072; j.nvalid = 32; j.nbase = 3072; j.dst = P.WgT; j.ldd = 1024; }
  else if (ti < 520) { const int t = ti - 392, kt = t % 8, nt = t / 8; j.src = P.w_out; j.ld_src = 1024; j.k0 = kt * 128; j.n0 = nt * 64; j.dst = P.WoutT; j.ldd = 1024; }
  else if (ti < 2568) { const int t = ti - 520, e = t / 128, r = t % 128, which = r / 64, r2 = r % 64, kt = r2 % 8, nt = r2 / 8;
    j.src = (which ? P.w3 : P.w1) + (size_t)e * 1024 * 512; j.ld_src = 512; j.k0 = kt * 128; j.n0 = nt * 64; j.dst = (bf16_t*)(P.W13Q + (size_t)e * 1024 * 1024); j.ldd = 1024; j.mode = 1 + which; j.q8 = 1; }
  else { const int t = ti - 2568, e = t / 64, r = t % 64, kt = r % 4, nt = r / 4; j.src = P.w2 + (size_t)e * 512 * 1024; j.ld_src = 1024; j.k0 = kt * 128; j.n0 = nt * 64; j.dst = (bf16_t*)(P.W2Q + (size_t)e * 1024 * 512); j.ldd = 512; j.q8 = 1; }
}
typedef float cvf4 __attribute__((ext_vector_type(4)));
__device__ __forceinline__ void cv_load(const CvJob& j, int tid, cvf4 (&r)[4]) {
  if (j.q8) { const int kq = (tid >> 2) & 31, n4 = 4 * ((tid & 3) + 4 * (tid >> 7)); const float* p = j.src + (size_t)(j.k0 + 4 * kq) * j.ld_src + j.n0 + n4;
#pragma unroll
    for (int i = 0; i < 4; ++i) r[i] = *(const cvf4*)(p + (size_t)i * j.ld_src);
    return; }
  const int kp = (tid >> 2) & 63;
#pragma unroll
  for (int i = 0; i < 2; ++i) { const int n4 = 4 * ((tid & 3) + 4 * ((tid >> 8) & 1) + 8 * i);
    if (n4 < j.nvalid) { const float* p = j.src + (size_t)(j.k0 + 2 * kp) * j.ld_src + j.n0 + n4; r[2 * i] = *(const cvf4*)p; r[2 * i + 1] = *(const cvf4*)(p + j.ld_src); } else { r[2 * i] = (cvf4){0.f, 0.f, 0.f, 0.f}; r[2 * i + 1] = r[2 * i]; } }
}
__device__ __forceinline__ void cv_to_lds(const CvJob& j, int tid, const cvf4 (&r)[4], bf16_t* T) {
  if (j.q8) { const int kq = (tid >> 2) & 31, n4 = 4 * ((tid & 3) + 4 * (tid >> 7)); unsigned* t = (unsigned*)((unsigned char*)T + n4 * 144 + 4 * kq);
#pragma unroll
    for (int c = 0; c < 4; ++c) t[36 * c] = pack4_fp8(r[0][c] * 8.f, r[1][c] * 8.f, r[2][c] * 8.f, r[3][c] * 8.f);
    return; }
  const int kp = (tid >> 2) & 63;
#pragma unroll
  for (int i = 0; i < 2; ++i) { const int n4 = 4 * ((tid & 3) + 4 * ((tid >> 8) & 1) + 8 * i);
    if (n4 < j.nvalid) { unsigned* t = (unsigned*)(T + n4 * 136 + 2 * kp);
      t[0] = pack2(r[2 * i][0], r[2 * i + 1][0]); t[68] = pack2(r[2 * i][1], r[2 * i + 1][1]); t[136] = pack2(r[2 * i][2], r[2 * i + 1][2]); t[204] = pack2(r[2 * i][3], r[2 * i + 1][3]); } }
}
__device__ __forceinline__ void cv_store(const CvJob& j, int tid, const bf16_t* T) {
  if (j.q8) { const int n = tid >> 3, kc = (tid & 7) * 16;
    *(uint4*)((unsigned char*)j.dst + (size_t)rowmap(j.n0 + n, j.mode) * j.ldd + j.k0 + kc) = *(const uint4*)((const unsigned char*)T + n * 144 + kc); return; }
#pragma unroll
  for (int i = 0; i < 2; ++i) { const int cidx = tid + 512 * i, n = cidx / 16, kc = (cidx % 16) * 8;
    if (n < j.nvalid) *(uint4*)(j.dst + (size_t)rowmap(j.n0 - j.nbase + n, j.mode) * j.ldd + j.k0 + kc) = *(const uint4*)(T + n * 136 + kc); }
}
__device__ void phase_pre(const Params& P, float* lds) {
  float* s = lds; float* red = lds + 9 * 1024;
  const int tid = opaque_tid();
  const int cg = tid % 6, kg = tid / 6, g0 = blockIdx.x * 6;
  cvf4 w[13];
  if (kg < 85) {
#pragma unroll
    for (int i = 0; i < 13; ++i) { const int k = kg + 85 * i; w[i] = (k < 1024) ? *(const cvf4*)(P.w_ada + (size_t)k * 6144 + (size_t)(g0 + cg) * 4) : (cvf4){0.f, 0.f, 0.f, 0.f}; }
  } else {
#pragma unroll
    for (int i = 0; i < 13; ++i) w[i] = (cvf4){0.f, 0.f, 0.f, 0.f};
  }
  CvJob job; cvf4 r[4]; int ti = blockIdx.x;
  cv_decode(P, ti, job); cv_load(job, tid, r);
  for (int i = tid; i < 9 * 1024; i += 512) { const float v = (i < 8 * 1024) ? P.c[i] : P.c_ctx[i - 8192]; s[i] = siluf(v); }
  __syncthreads();
  if (kg < 85) {
    float a[9][4];
#pragma unroll
    for (int rr = 0; rr < 9; ++rr) { a[rr][0] = a[rr][1] = a[rr][2] = a[rr][3] = 0.f; }
#pragma unroll
    for (int i = 0; i < 13; ++i) { const int k = kg + 85 * i; if (k < 1024) {
#pragma unroll
        for (int rr = 0; rr < 9; ++rr) { const float sv = s[rr * 1024 + k]; a[rr][0] += sv * w[i][0]; a[rr][1] += sv * w[i][1]; a[rr][2] += sv * w[i][2]; a[rr][3] += sv * w[i][3]; } } }
#pragma unroll
    for (int rr = 0; rr < 9; ++rr)
#pragma unroll
      for (int jj = 0; jj < 4; ++jj) red[kg * 216 + rr * 24 + cg * 4 + jj] = a[rr][jj];
  }
  __syncthreads();
  if (tid < 216) { float t = 0.f; for (int kk = 0; kk < 85; ++kk) t += red[kk * 216 + tid]; const int rr = tid / 24, cc = tid % 24, col = g0 * 4 + cc; P.mod[rr * 6144 + col] = t + P.b_ada[col]; }
  __syncthreads();
  bf16_t* T = (bf16_t*)lds;
  while (ti < 3592) {
    cv_to_lds(job, tid, r, T);
    const int tn = ti + gridDim.x;
    CvJob nj = job; cvf4 rn[4] = {r[0], r[1], r[2], r[3]};
    if (tn < 3592) { cv_decode(P, tn, nj); cv_load(nj, tid, rn); }
    __syncthreads();
    cv_store(job, tid, T);
    __syncthreads();
    job = nj; r[0] = rn[0]; r[1] = rn[1]; r[2] = rn[2]; r[3] = rn[3];
    ti = tn;
  }
  uint4* z = (uint4*)(P.WgT + 32 * 1024);
  for (int i = blockIdx.x * 512 + tid; i < 224 * 1024 / 8; i += gridDim.x * 512) z[i] = make_uint4(0, 0, 0, 0);
}

namespace hl {
typedef short bf16x8 __attribute__((ext_vector_type(8)));
typedef float f32x4 __attribute__((ext_vector_type(4)));
typedef unsigned u32x4 __attribute__((ext_vector_type(4)));
#define HLAS __attribute__((address_space(3)))
constexpr int WST = 2064;
__device__ __forceinline__ void ln_row(const float* src, const HLAS float* GB, bf16_t* dst, float* stats, int lane) {
    float v[16];
#pragma unroll
    for (int j = 0; j < 4; ++j) { const float4 t = *(const float4*)(src + j * 256 + lane * 4); v[4 * j] = t.x; v[4 * j + 1] = t.y; v[4 * j + 2] = t.z; v[4 * j + 3] = t.w; }
    float s = 0.f;
#pragma unroll
    for (int j = 0; j < 16; ++j) s += v[j];
    const float mean = wave_sum(s) * (1.f / 1024.f);
    float q = 0.f;
#pragma unroll
    for (int j = 0; j < 16; ++j) { const float d = v[j] - mean; q += d * d; }
    const float rstd = rsqrtf(wave_sum(q) * (1.f / 1024.f) + 1e-5f);
    if (stats && lane == 0) { stats[0] = mean; stats[1] = rstd; }
#pragma unroll
    for (int j = 0; j < 4; ++j) {
        const int k = j * 256 + lane * 4;
        const f32x4 g = *(const HLAS f32x4*)(GB + k), bb = *(const HLAS f32x4*)(GB + 1024 + k);
        const float h0 = (v[4 * j] - mean) * rstd * g[0] + bb[0], h1 = (v[4 * j + 1] - mean) * rstd * g[1] + bb[1];
        const float h2 = (v[4 * j + 2] - mean) * rstd * g[2] + bb[2], h3 = (v[4 * j + 3] - mean) * rstd * g[3] + bb[3];
        uint2 w; w.x = pack2(h0, h1); w.y = pack2(h2, h3); *(uint2*)(dst + k) = w;
    }
}
}
__device__ void phase_hln(const Params& P, HLAS unsigned char* lds) {
    const int tid = opaque_tid(), lane = tid & 63, wid = tid >> 6;
    { hl::u32x4 wt[8];
#pragma unroll
      for (int u = 0; u < 8; ++u) { const int i = tid + 512 * u, n = i >> 7, c = i & 127; wt[u] = *(const hl::u32x4*)(P.WgT + (size_t)n * 1024 + c * 8); }
#pragma unroll
      for (int u = 0; u < 8; ++u) { const int i = tid + 512 * u, n = i >> 7, c = i & 127; *(HLAS hl::u32x4*)(lds + n * hl::WST + c * 16) = wt[u]; } }
    const int R0 = blockIdx.x * 128 + wid * 16;
    HLAS float* GB = (HLAS float*)(lds + 32 * hl::WST);
    { float lsc[4], lsh[4], lg_[4], lb_[4];
#pragma unroll
      for (int u = 0; u < 4; ++u) { const int i = tid + 512 * u, which = i >> 10, k = i & 1023; const float* md = P.mod + (which ? 8 : R0 / SEQ) * 6144; lsc[u] = md[1024 + k]; lsh[u] = md[k]; lg_[u] = P.ln_in_g[k]; lb_[u] = P.ln_in_b[k]; }
#pragma unroll
      for (int u = 0; u < 4; ++u) { const int i = tid + 512 * u, which = i >> 10, k = i & 1023; const float sc1 = 1.f + lsc[u]; GB[which * 2048 + k] = lg_[u] * sc1; GB[which * 2048 + 1024 + k] = lb_[u] * sc1 + lsh[u]; } }
    __syncthreads();
    for (int rr = 0; rr < 16; ++rr) { const int row = R0 + rr; hl::ln_row(P.x + (size_t)row * D, GB, P.hln + (size_t)row * D, P.stats + row * 2, lane); }
    { const int crow = blockIdx.x * 8 + wid; hl::ln_row(P.ctx + (size_t)crow * D, GB + 2048, P.hc + (size_t)crow * D, nullptr, lane); }
    asm volatile("s_waitcnt vmcnt(0)" ::: "memory");
    __syncthreads();
    const int r16 = lane & 15, q = lane >> 4;
    hl::f32x4 a0 = {0.f, 0.f, 0.f, 0.f}, a1 = {0.f, 0.f, 0.f, 0.f};
    const bf16_t* arow = P.hln + (size_t)(R0 + r16) * D + 8 * q;
#pragma unroll 8
    for (int ks = 0; ks < 32; ++ks) {
        const hl::bf16x8 a = *(const hl::bf16x8*)(arow + 32 * ks);
        const hl::bf16x8 b0 = *(const HLAS hl::bf16x8*)(lds + r16 * hl::WST + (32 * ks + 8 * q) * 2), b1 = *(const HLAS hl::bf16x8*)(lds + (16 + r16) * hl::WST + (32 * ks + 8 * q) * 2);
        a0 = __builtin_amdgcn_mfma_f32_16x16x32_bf16(a, b0, a0, 0, 0, 0); a1 = __builtin_amdgcn_mfma_f32_16x16x32_bf16(a, b1, a1, 0, 0, 0);
    }
#pragma unroll
    for (int j = 0; j < 4; ++j) { float* lp = P.low + (size_t)(R0 + 4 * q + j) * 32; lp[r16] = a0[j]; lp[16 + r16] = a1[j]; }
}

namespace pg8 {
#define PG8_LAS __attribute__((address_space(3)))
typedef short bf16x8 __attribute__((ext_vector_type(8)));
typedef float f32x4 __attribute__((ext_vector_type(4)));
typedef unsigned u32x4 __attribute__((ext_vector_type(4)));
constexpr int BM = 256, BK = 64, HALF = 128, HTB = HALF * BK * 2, STAGE_BYTES = 8 * HTB, NXCD = 8, WGM = 8;
__host__ __device__ __forceinline__ int lds_byte(int r, int c) { const int st = (r >> 4) * 2 + (c >> 5), rr = r & 15, cc = c & 31, ob = rr * 64 + cc * 2; return st * 1024 + (ob ^ (((ob >> 9) & 1) << 5)); }
__host__ __device__ __forceinline__ void stage_rc(int b, int& R, int& C) { const int st = b / 1024, sb = b % 1024, swz = sb ^ (((sb >> 9) & 1) << 5); R = (st >> 1) * 16 + swz / 64; C = (st & 1) * 32 + (swz % 64) / 2; }
__host__ __device__ __forceinline__ int perm32(int rho) { const int n = rho >> 4, i = rho & 15; return 8 * (i >> 2) + 4 * n + (i & 3); }
__device__ __forceinline__ unsigned cvt_pk_bf16(float lo, float hi) { unsigned r; asm volatile("v_cvt_pk_bf16_f32 %0, %1, %2" : "=v"(r) : "v"(lo), "v"(hi)); return r; }

template <class T> struct sched_waits { static constexpr bool v = false; };
template <class T> struct epi_publishes { static constexpr bool v = false; };
struct Unit { const char* A; const char* B; const char* B2; int pm, pn, aux; };
struct GemmCfg { int lda, ldb, nt, ksplit, ldb2, ksplit2; };

__device__ __forceinline__ void static_order(int L, int nM, int nN, int& pm, int& pn) {
    const int nwg = nM * nN; int wgid = L;
    { const int q = nwg / NXCD, r = nwg % NXCD, xcd = wgid % NXCD, off = wgid / NXCD; wgid = (xcd < r ? xcd * (q + 1) : r * (q + 1) + (xcd - r) * q) + off; }
    const int nig = WGM * nN, gid = wgid / nig, fm = gid * WGM, gsz = (nM - fm) < WGM ? (nM - fm) : WGM;
    pm = fm + ((wgid % nig) % gsz); pn = (wgid % nig) / gsz;
}

template <int MODE, bool FP8, class Epi, class Sched>
__device__ __forceinline__ void gemm_phase(PG8_LAS unsigned char* lds, const GemmCfg g, const Sched& S, const Epi& E) {
    const int tid = opaque_tid(), wid = __builtin_amdgcn_readfirstlane(tid >> 6), lane = tid & 63, wr = wid >> 2, wc = wid & 3, fr = lane & 15, fq = lane >> 4;
    typedef int pg8_i32x4 __attribute__((ext_vector_type(4))); typedef int pg8_i32x8 __attribute__((ext_vector_type(8)));
    constexpr bool GATHER = MODE == 1, MIXED = MODE == 2, WAITS = MIXED || sched_waits<Sched>::v, PUBL = epi_publishes<Epi>::v; constexpr int ES = FP8 ? 1 : 2;
    const int nt = g.nt;
    unsigned voffA[2], voffB[2], voffB2[2];
#pragma unroll
    for (int i = 0; i < 2; ++i) { int R, C; stage_rc(tid * 16 + i * 8192, R, C); const int Rb = (R & ~31) + perm32(R & 31);
        voffA[i] = (unsigned)(R * g.lda * ES + 2 * C); voffB[i] = (unsigned)(Rb * g.ldb * ES + 2 * C); voffB2[i] = (unsigned)(Rb * g.ldb2 * ES + 2 * C); }
    const PG8_LAS int* gidx = (const PG8_LAS int*)(lds + STAGE_BYTES);
    unsigned vAc[2][2], vAn[2][2];
#define PG8_GIDX(ui_, vo) do { _Pragma("unroll") for (int _i = 0; _i < 2; ++_i) { int _R, _C; stage_rc(tid * 16 + _i * 8192, _R, _C); _Pragma("unroll") for (int _h = 0; _h < 2; ++_h) \
        vo[_h][_i] = (unsigned)(gidx[(ui_) * 256 + _h * 128 + _R] * g.lda * ES + 2 * _C); } } while (0)
#define PG8_STAGE_A(bufoff, base, h, nx) do { if constexpr (GATHER) { unsigned _vo[2] = {(nx) ? vAn[h][0] : vAc[h][0], (nx) ? vAn[h][1] : vAc[h][1]}; PG8_STAGE(bufoff, base, _vo); } \
        else { PG8_STAGE(bufoff, (base) + (h) * hstepA, voffA); } } while (0)
    const size_t kstep = (size_t)(BK * 2);
    const size_t hstepA = (size_t)HALF * g.lda * ES, hstepB = (size_t)HALF * g.ldb * ES, hstepB2 = (size_t)HALF * g.ldb2 * ES;
    const unsigned ldsw = (unsigned)wid * 1024u;
    const int aoff = lds_byte(wr * 64 + fr, fq * 8), boff = lds_byte(wc * 32 + fr, fq * 8);
#define PG8_SA(b, h) (((b) * 2 + (h)) * HTB)
#define PG8_SB(b, h) ((4 + (b) * 2 + (h)) * HTB)
#define PG8_STAGE(bufoff, gbase, voff) do { _Pragma("unroll") for (int _i = 0; _i < 2; ++_i) { unsigned _o = (voff)[_i]; asm volatile("" : "+v"(_o));   \
        __builtin_amdgcn_global_load_lds((const unsigned*)((const char*)(gbase) + _o), (PG8_LAS unsigned*)(lds + (bufoff) + ldsw + _i * 8192), 16, 0, 0); } } while (0)
#define PG8_LDA(dst, b, h) do { if constexpr (FP8) { _Pragma("unroll") for (int m = 0; m < 4; ++m) { dst##q[m].lo = *(const PG8_LAS pg8_i32x4*)(lds + PG8_SA(b, h) + aoff + m * 2048); dst##q[m].hi = *(const PG8_LAS pg8_i32x4*)(lds + PG8_SA(b, h) + aoff + m * 2048 + 1024); } } \
        else { _Pragma("unroll") for (int m = 0; m < 4; ++m) _Pragma("unroll") for (int k = 0; k < 2; ++k) dst[m][k] = *(const PG8_LAS bf16x8*)(lds + PG8_SA(b, h) + aoff + m * 2048 + k * 1024); } } while (0)
#define PG8_LDB(dst, b, h) do { if constexpr (FP8) { _Pragma("unroll") for (int n = 0; n < 2; ++n) { dst##q[n].lo = *(const PG8_LAS pg8_i32x4*)(lds + PG8_SB(b, h) + boff + n * 2048); dst##q[n].hi = *(const PG8_LAS pg8_i32x4*)(lds + PG8_SB(b, h) + boff + n * 2048 + 1024); } } \
        else { _Pragma("unroll") for (int n = 0; n < 2; ++n) _Pragma("unroll") for (int k = 0; k < 2; ++k) dst[n][k] = *(const PG8_LAS bf16x8*)(lds + PG8_SB(b, h) + boff + n * 2048 + k * 1024); } } while (0)
#define PG8_CAT(v) (v)
#define PG8_MMA(ai, bj, At, Bt) do { __builtin_amdgcn_s_setprio(1); \
        if constexpr (FP8) { _Pragma("unroll") for (int m = 0; m < 4; ++m) _Pragma("unroll") for (int n = 0; n < 2; ++n) \
            acc[ai][bj][m][n] = __builtin_amdgcn_mfma_scale_f32_16x16x128_f8f6f4(Bt##q[n], At##q[m], acc[ai][bj][m][n], 0, 0, 0, 0x7c7c7c7c, 0, 0x7c7c7c7c); } \
        else { _Pragma("unroll") for (int m = 0; m < 4; ++m) _Pragma("unroll") for (int n = 0; n < 2; ++n) _Pragma("unroll") for (int k = 0; k < 2; ++k) \
            acc[ai][bj][m][n] = __builtin_amdgcn_mfma_f32_16x16x32_bf16(Bt[n][k], At[m][k], acc[ai][bj][m][n], 0, 0, 0); } \
        __builtin_amdgcn_s_setprio(0); } while (0)
#define PG8_WAIT_V(n) asm volatile("s_waitcnt vmcnt(" #n ")" ::: "memory")
#define PG8_WAIT_L(n) asm volatile("s_waitcnt lgkmcnt(" #n ")" ::: "memory")
#define PG8_BAR __builtin_amdgcn_s_barrier()
#define PG8_SCHED __builtin_amdgcn_sched_barrier(0)
#define PG8_KSP(u) ((MIXED && (u).aux) ? g.ksplit2 : g.ksplit)
#define PG8_BK(u, t) ((t) < PG8_KSP(u) ? (u).B + (size_t)(t) * kstep : (u).B2 + (size_t)((t) - PG8_KSP(u)) * kstep)
#define PG8_VB2(i_) (FP8 ? (((voffB[i_] & ~1023u) >> 1) + (voffB[i_] & 1023u)) : voffB2[i_])
#define PG8_STAGE_B(bufoff, base, h, kd) do { if constexpr (MIXED) { unsigned _vb[2] = {(kd) ? PG8_VB2(0) : voffB[0], (kd) ? PG8_VB2(1) : voffB[1]}; PG8_STAGE(bufoff, (base) + (h) * ((kd) ? hstepB2 : hstepB), _vb); } \
        else { PG8_STAGE(bufoff, (base) + (h) * hstepB, voffB); } } while (0)
    Unit cur, nxt; int ui = 0; int pub_pm = -1;
    if (!S.next(0, cur)) return;
    f32x4 acc[2][2][4][2];
#pragma unroll
    for (int a = 0; a < 2; ++a)
#pragma unroll
        for (int b = 0; b < 2; ++b)
#pragma unroll
            for (int m = 0; m < 4; ++m)
#pragma unroll
                for (int n = 0; n < 2; ++n) acc[a][b][m][n] = (f32x4){0.f, 0.f, 0.f, 0.f};
    bf16x8 At[4][2], B0[2][2], B1[2][2];
    pg8_i32x8 Atq[4], B0q[2], B1q[2];
    {
        const char* cA = cur.A; const char* b0 = PG8_BK(cur, 0); const char* b1 = PG8_BK(cur, 1);
        if constexpr (WAITS) S.a_ready(cur);
        if constexpr (GATHER) { PG8_GIDX(0, vAc); }
        const int kc = cur.aux;
        PG8_STAGE_B(PG8_SB(0, 0), b0, 0, kc); PG8_STAGE_B(PG8_SB(0, 1), b0, 1, kc); PG8_STAGE_A(PG8_SA(0, 0), cA, 0, false); PG8_STAGE_A(PG8_SA(0, 1), cA, 1, false);
        if (wr == 1) PG8_BAR;
        PG8_WAIT_V(2); PG8_BAR;
        PG8_STAGE_B(PG8_SB(1, 0), b1, 0, kc); PG8_STAGE_A(PG8_SA(1, 0), cA + kstep, 0, false); PG8_STAGE_B(PG8_SB(1, 1), b1, 1, kc);
        PG8_WAIT_V(6); PG8_BAR;
    }
    for (;;) {
        const bool has_next = S.next(ui + 1, nxt);
        if (!has_next) nxt = cur;
        if constexpr (GATHER) { PG8_GIDX(has_next ? ui + 1 : ui, vAn); }
        const char* cA = cur.A;
#pragma unroll 1
        for (int t = 0; t < nt; t += 2) {
            const bool last = (t == nt - 2);
            const char* a1 = cA + (size_t)(t + 1) * kstep;
            const char* a2 = last ? nxt.A : cA + (size_t)(t + 2) * kstep;
            const char* a3 = a2 + kstep;
            const char* b2 = last ? PG8_BK(nxt, 0) : PG8_BK(cur, t + 2);
            const char* b3 = last ? PG8_BK(nxt, 1) : PG8_BK(cur, t + 3);
            const int kb = last ? nxt.aux : cur.aux;
            if constexpr (WAITS) { if (last && has_next) S.a_ready(nxt); }
            PG8_LDB(B0, 0, 0); PG8_LDB(B1, 0, 1); PG8_SCHED; PG8_LDA(At, 0, 0); PG8_STAGE_A(PG8_SA(1, 1), a1, 1, false);
            PG8_WAIT_V(8); PG8_WAIT_L(0); PG8_BAR;
            if constexpr (PUBL) { if (t == 2 && pub_pm >= 0) { if (wid == 0 && lane == 0) E.publish(pub_pm); pub_pm = -1; } }
            PG8_MMA(0, 0, At, B0); PG8_MMA(0, 1, At, B1); PG8_BAR; PG8_SCHED;
            PG8_LDA(At, 0, 1); PG8_STAGE_B(PG8_SB(0, 0), b2, 0, kb); PG8_STAGE_B(PG8_SB(0, 1), b2, 1, kb); PG8_STAGE_A(PG8_SA(0, 0), a2, 0, last);
            PG8_WAIT_V(8); PG8_WAIT_L(0); PG8_BAR; PG8_MMA(1, 0, At, B0); PG8_MMA(1, 1, At, B1); PG8_BAR; PG8_SCHED;
            PG8_LDB(B0, 1, 0); PG8_LDB(B1, 1, 1); PG8_SCHED; PG8_LDA(At, 1, 0); PG8_STAGE_A(PG8_SA(0, 1), a2, 1, last);
            PG8_WAIT_V(8); PG8_WAIT_L(0); PG8_BAR; PG8_MMA(0, 0, At, B0); PG8_MMA(0, 1, At, B1); PG8_BAR; PG8_SCHED;
            PG8_LDA(At, 1, 1); PG8_STAGE_B(PG8_SB(1, 0), b3, 0, kb); PG8_STAGE_B(PG8_SB(1, 1), b3, 1, kb); PG8_STAGE_A(PG8_SA(1, 0), a3, 0, last);
            PG8_WAIT_V(8); PG8_WAIT_L(0); PG8_BAR; PG8_MMA(1, 0, At, B0); PG8_MMA(1, 1, At, B1); PG8_BAR; PG8_SCHED;
        }
        if (wr == 0) PG8_BAR;
        E(acc, cur, wr, wc, fr, fq);
        if constexpr (PUBL) pub_pm = cur.pm;
        if (!has_next) break;
#pragma unroll
        for (int a = 0; a < 2; ++a)
#pragma unroll
            for (int b = 0; b < 2; ++b)
#pragma unroll
                for (int m = 0; m < 4; ++m)
#pragma unroll
                    for (int n = 0; n < 2; ++n) acc[a][b][m][n] = (f32x4){0.f, 0.f, 0.f, 0.f};
        cur = nxt; ++ui;
        if constexpr (GATHER) { _Pragma("unroll") for (int _h = 0; _h < 2; ++_h) _Pragma("unroll") for (int _i = 0; _i < 2; ++_i) vAc[_h][_i] = vAn[_h][_i]; }
        if (wr == 1) PG8_BAR;
    }
    PG8_WAIT_V(0);
    PG8_BAR;
    if constexpr (PUBL) { if (pub_pm >= 0 && wid == 0 && lane == 0) E.publish(pub_pm); }
#undef PG8_SA
#undef PG8_SB
#undef PG8_STAGE
#undef PG8_LDA
#undef PG8_LDB
#undef PG8_MMA
#undef PG8_CAT
#undef PG8_WAIT_V
#undef PG8_WAIT_L
#undef PG8_BAR
#undef PG8_SCHED
#undef PG8_BK
#undef PG8_KSP
#undef PG8_STAGE_B
#undef PG8_VB2
#undef PG8_GIDX
#undef PG8_STAGE_A
}

struct EpiStore {
    bf16_t* p; bf16_t* pctx; int mode;
    __device__ __forceinline__ void operator()(const f32x4 (&acc)[2][2][4][2], const Unit& u, int wr_, int wc_, int fr_, int fq_) const {
        const int t_ = opaque_tid(), wid_ = __builtin_amdgcn_readfirstlane(t_ >> 6), wr = wid_ >> 2, wc = wid_ & 3, fr = t_ & 15, fq = (t_ & 63) >> 4; (void)wr_; (void)wc_; (void)fr_; (void)fq_;
        bf16_t* base; int ldc;
        if (mode == 0) { if (u.aux) { base = pctx; ldc = 1024; } else { base = p; ldc = 3072; } } else { base = p; ldc = 1024; }
        const int row0 = u.pm * BM + wr * 64 + fr, col0 = u.pn * BM + wc * 32 + 8 * fq;
        if (mode == 0 && u.pn >= 2 && u.pn < 6) {
            const int colu = 512 + (u.pn - 2) * 128 + wc * 32 + 8 * fq;
#pragma unroll
            for (int ai = 0; ai < 2; ++ai)
#pragma unroll
                for (int m = 0; m < 4; ++m) { const f32x4 a0 = acc[ai][0][m][0], a1 = acc[ai][0][m][1], x0 = acc[ai][1][m][0], x1 = acc[ai][1][m][1];
                    u32x4 w; w.x = cvt_pk_bf16(a0[0] * x0[0], a0[1] * x0[1]); w.y = cvt_pk_bf16(a0[2] * x0[2], a0[3] * x0[3]); w.z = cvt_pk_bf16(a1[0] * x1[0], a1[1] * x1[1]); w.w = cvt_pk_bf16(a1[2] * x1[2], a1[3] * x1[3]);
                    *(u32x4*)(base + (size_t)(row0 + ai * HALF + m * 16) * ldc + colu) = w; }
            return;
        }
#pragma unroll
        for (int ai = 0; ai < 2; ++ai)
#pragma unroll
            for (int m = 0; m < 4; ++m) { bf16_t* rowp = base + (size_t)(row0 + ai * HALF + m * 16) * ldc + col0;
#pragma unroll
                for (int bj = 0; bj < 2; ++bj) { const f32x4 v0 = acc[ai][bj][m][0], v1 = acc[ai][bj][m][1];
                    u32x4 w; w.x = cvt_pk_bf16(v0[0], v0[1]); w.y = cvt_pk_bf16(v0[2], v0[3]); w.z = cvt_pk_bf16(v1[0], v1[1]); w.w = cvt_pk_bf16(v1[2], v1[3]);
                    *(u32x4*)(rowp + bj * HALF) = w; } }
    }
};
}

struct SchedG1 {
    const char* hln; const char* WinT; const char* hc; const char* WgT; int G, c;
    __device__ __forceinline__ bool next(int i, pg8::Unit& u) const {
        const int L = i * G + c;
        if (L < 1536) { int pm, pn; pg8::static_order(L, 128, 12, pm, pn); u.pm = pm; u.pn = pn; u.aux = 0; u.A = hln + (size_t)pm * 256 * 2048; u.B = WinT + (size_t)pn * 256 * 2048; u.B2 = u.B; return true; }
        return false;
    }
};
struct SchedG2 {
    const char* A; const char* Bt; int G, c;
    __device__ __forceinline__ bool next(int i, pg8::Unit& u) const {
        const int L = i * G + c; if (L >= 512) return false;
        int pm, pn; pg8::static_order(L, 128, 4, pm, pn); u.pm = pm; u.pn = pn; u.aux = 0; u.A = A + (size_t)pm * 256 * 2048; u.B = Bt + (size_t)pn * 256 * 2048; u.B2 = u.B; return true;
    }
};
__device__ __forceinline__ void cls_experts(int c, int& e_lo, int& e_hi) { const int g = c / 6, pi = c % 6; e_lo = g * 4 + (pi < 3 ? 0 : (pi < 5 ? 1 : 2)); e_hi = g * 4 + (pi < 3 ? pi + 1 : (pi < 5 ? pi - 1 : 3)); }
__device__ void phase_gemm1(const Params& P, PG8_LAS unsigned char* lds) {
    SchedG1 S{(const char*)P.hln, (const char*)P.WinT, (const char*)P.hc, (const char*)P.WgT, (int)gridDim.x, (int)blockIdx.x};
    pg8::EpiStore E{P.p, P.pctx, 0}; pg8::GemmCfg g{1024, 1024, 16, 16, 1024, 16};
    pg8::gemm_phase<0, false>(lds, g, S, E);
}
__device__ void phase_ctx_proj(const Params& P) {
    typedef short bf16x8 __attribute__((ext_vector_type(8))); typedef float f32x4 __attribute__((ext_vector_type(4)));
    const int tid = opaque_tid(), lane = tid & 63, wid = tid >> 6, r16 = lane & 15, q = lane >> 4;
    const int g = blockIdx.x >> 3, j = blockIdx.x & 7, rt = wid & 3, hf = wid >> 2;
    const bf16_t* arow = P.hc + (size_t)(g * 64 + rt * 16 + r16) * D + 8 * q;
    const bf16_t* brow[4]; bool ok[4];
#pragma unroll
    for (int u = 0; u < 4; ++u) { const int t = 7 * j + 4 * hf + u; ok[u] = (u < 4 - hf) && t < 50; const int tc = ok[u] ? t : 0;
        brow[u] = (tc < 48 ? P.WinT + (size_t)(OFF_K + 16 * tc + r16) * D : P.WgT + (size_t)(16 * (tc - 48) + r16) * D) + 8 * q; }
    f32x4 acc[4];
#pragma unroll
    for (int u = 0; u < 4; ++u) acc[u] = (f32x4){0.f, 0.f, 0.f, 0.f};
#pragma unroll 8
    for (int ks = 0; ks < 32; ++ks) { const bf16x8 a = *(const bf16x8*)(arow + 32 * ks);
#pragma unroll
        for (int u = 0; u < 4; ++u) acc[u] = __builtin_amdgcn_mfma_f32_16x16x32_bf16(a, *(const bf16x8*)(brow[u] + 32 * ks), acc[u], 0, 0, 0); }
#pragma unroll
    for (int u = 0; u < 4; ++u) if (ok[u]) { const int t = 7 * j + 4 * hf + u;
#pragma unroll
        for (int jj = 0; jj < 4; ++jj) P.pctx[(size_t)(g * 64 + rt * 16 + 4 * q + jj) * 1024 + 16 * t + r16] = f2bf(acc[u][jj]); }
}
__device__ void phase_gemm2(const Params& P, PG8_LAS unsigned char* lds) {
    SchedG2 S{(const char*)P.ymix, (const char*)P.WoutT, (int)gridDim.x, (int)blockIdx.x};
    pg8::EpiStore E{P.ybuf, nullptr, 1}; pg8::GemmCfg g{1024, 1024, 16, 16, 1024, 16};
    pg8::gemm_phase<0, false>(lds, g, S, E);
}

struct SchedUpQ {
    const char* h2qs; const char* W13Q; const int* tileinfo; int ntiles, c;
    __device__ __forceinline__ bool next(int i, pg8::Unit& u) const {
        const int x = c & 7, j = c >> 3, pm = 32 * i + 4 * (j >> 2) + (x >> 1), pn = 4 * (x & 1) + (j & 3);
        if (pm >= ntiles) return false;
        int e_lo, e_hi; cls_experts(__builtin_amdgcn_readfirstlane(tileinfo[1 + pm]), e_lo, e_hi); const int e = (pn >> 2) ? e_hi : e_lo;
        u.pm = pm; u.pn = pn; u.aux = 0; u.A = h2qs + (size_t)pm * 256 * 1024; u.B = W13Q + ((size_t)e * 1024 + (pn & 3) * 256) * 1024; u.B2 = u.B; return true;
    }
};
struct SchedDownQ {
    const char* actq; const char* W2Q; const int* tileinfo; const unsigned* cnt; int ntiles, c;
    __device__ __forceinline__ bool next(int k, pg8::Unit& u) const {
        const int x = c & 7, j = c >> 3, jj = j >> 2, rem = ntiles & 31;
        int Hx = (rem - (x >> 1) + 3) >> 2; Hx = Hx < 0 ? 0 : (Hx > 8 ? 8 : Hx);
        const int L = 8 - Hx; const bool light = jj >= Hx;
        const int pl = light ? (k == 0 ? jj - Hx : L + 8 * (k - 1) + jj) : L + 8 * k + jj;
        const int pm = 8 * pl + x, pn = j & 3;
        if (pm >= ntiles) return false;
        int e_lo, e_hi; cls_experts(__builtin_amdgcn_readfirstlane(tileinfo[1 + pm]), e_lo, e_hi);
        u.pm = pm; u.pn = pn; u.aux = 1; u.A = actq + (size_t)pm * 256 * 1024; u.B = W2Q + ((size_t)e_lo * 1024 + pn * 256) * 512; u.B2 = W2Q + ((size_t)e_hi * 1024 + pn * 256) * 512; return true;
    }
    __device__ __forceinline__ void a_ready(const pg8::Unit& u) const {
        const unsigned* p = cnt + u.pm; unsigned sp = 0;
        while (__hip_atomic_load(p, __ATOMIC_RELAXED, __HIP_MEMORY_SCOPE_AGENT) < 8u) { __builtin_amdgcn_s_sleep(4); if (++sp > (1u << 22)) break; }
    }
};
namespace pg8 { template <> struct sched_waits<SchedDownQ> { static constexpr bool v = true; }; }
namespace pg8 {
struct EpiUpQ {
    unsigned char* act; const float* cws; unsigned* cnt;
    __device__ __forceinline__ void publish(int pm) const { __hip_atomic_fetch_add(cnt + pm, 1u, __ATOMIC_RELAXED, __HIP_MEMORY_SCOPE_AGENT); }
    __device__ __forceinline__ void operator()(const f32x4 (&acc)[2][2][4][2], const Unit& u, int wr, int wc, int fr, int fq) const {
        const int half = u.pn >> 2, row0 = u.pm * BM + wr * 64 + fr, col0 = half * 512 + (u.pn & 3) * 128 + wc * 32 + 8 * fq;
#pragma unroll
        for (int ai = 0; ai < 2; ++ai)
#pragma unroll
            for (int m = 0; m < 4; ++m) { const int row = row0 + ai * HALF + m * 16; const float cwv = cws[(size_t)row * 2 + half] * 8.f;
                float o[8];
#pragma unroll
                for (int n = 0; n < 2; ++n)
#pragma unroll
                    for (int j = 0; j < 4; ++j) { const float a = acc[ai][0][m][n][j], b = acc[ai][1][m][n][j]; o[n * 4 + j] = a * __builtin_amdgcn_rcpf(1.f + __expf(-a)) * b * cwv; }
                uint2 w; w.x = pack4_fp8(o[0], o[1], o[2], o[3]); w.y = pack4_fp8(o[4], o[5], o[6], o[7]);
                __hip_atomic_store((unsigned long long*)(act + (size_t)row * 1024 + col0), ((unsigned long long)w.y << 32) | w.x, __ATOMIC_RELAXED, __HIP_MEMORY_SCOPE_AGENT); }
    }
};
template <> struct epi_publishes<EpiUpQ> { static constexpr bool v = true; };
}
__device__ void phase_moe_up(const Params& P, PG8_LAS unsigned char* lds) {
    SchedUpQ S{(const char*)P.h2qs, (const char*)P.W13Q, P.tileinfo, __builtin_amdgcn_readfirstlane((int)P.ctrl[4096 + 64 * NCLS]), (int)blockIdx.x};
    pg8::EpiUpQ E{P.actq, P.cws, P.ctrl + 12288}; pg8::GemmCfg g{1024, 1024, 8, 8, 1024, 8};
    pg8::gemm_phase<0, true>(lds, g, S, E);
}
__device__ void phase_moe_down(const Params& P, PG8_LAS unsigned char* lds) {
    SchedDownQ S{(const char*)P.actq, (const char*)P.W2Q, P.tileinfo, P.ctrl + 12288, __builtin_amdgcn_readfirstlane((int)P.ctrl[4096 + 64 * NCLS]), (int)blockIdx.x};
    pg8::EpiStore E{P.moes, nullptr, 1}; pg8::GemmCfg g{1024, 512, 8, 4, 512, 4};
    pg8::gemm_phase<0, true>(lds, g, S, E);
}

__device__ __forceinline__ void unpack8(const uint4& t, float* f) {
  f[0] = __uint_as_float(t.x << 16); f[1] = __uint_as_float(t.x & 0xffff0000u); f[2] = __uint_as_float(t.y << 16); f[3] = __uint_as_float(t.y & 0xffff0000u);
  f[4] = __uint_as_float(t.z << 16); f[5] = __uint_as_float(t.z & 0xffff0000u); f[6] = __uint_as_float(t.w << 16); f[7] = __uint_as_float(t.w & 0xffff0000u);
}
__device__ __forceinline__ uint4 pack8(const float* f) { uint4 w; w.x = pack2(f[0], f[1]); w.y = pack2(f[2], f[3]); w.z = pack2(f[4], f[5]); w.w = pack2(f[6], f[7]); return w; }

namespace gla {
typedef short bf16x8 __attribute__((ext_vector_type(8)));
typedef short s16x4 __attribute__((ext_vector_type(4)));
typedef short v4i16_t __attribute__((ext_vector_type(4)));
typedef float f32x4 __attribute__((ext_vector_type(4)));
typedef float f32x2 __attribute__((ext_vector_type(2)));
typedef unsigned u32x4 __attribute__((ext_vector_type(4)));
typedef unsigned u32x2 __attribute__((ext_vector_type(2)));
#define GLAS __attribute__((address_space(3)))
typedef GLAS unsigned char* ldsp;
constexpr int VST = 288, NST = 144, KEST = 160;
constexpr int L_V = 0, L_KR = L_V + 64 * VST, L_QR = L_KR + 64 * NST, L_LW = L_QR + 64 * NST, L_PT = L_LW + 64 * 32 * 4, L_DEC = L_PT + 2 * 16 * 64 * 4,
              L_QD = L_DEC + 512, L_KINV = L_QD + 64 * NST, L_KE = L_KINV + 64 * NST, L_KE2 = L_KE + 64 * KEST, L_P = L_KE2 + 64 * KEST, L_ST = L_P + 64 * NST,
              L_RS = L_ST + 128 * NST, L_GW = L_RS + 512, L_GB = L_GW + 2 * 16 * 64 * 4, L_END = L_GB + 512;
static_assert(L_END <= 128 * 1024, "gla lds");
constexpr int L_PB0 = L_KR, L_GG = L_PB0 + 2 * 16384, L_PB1 = L_GW;
static_assert(L_GG + 512 <= L_DEC && L_PB1 + 2 * 16384 <= TIDTAB_OFF, "gla pass B lds");
__device__ __forceinline__ s16x4 trr(const GLAS unsigned char* p) { return __builtin_bit_cast(s16x4, __builtin_amdgcn_ds_read_tr16_b64_v4i16((GLAS v4i16_t*)p)); }
__device__ __forceinline__ bf16x8 tr_frag(const GLAS unsigned char* img, int stride, int k0, int col0, int lane) {
    const int q = lane >> 4, r = (lane & 15) >> 2, pp = lane & 3;
    const GLAS unsigned char* a = img + (k0 + 4 * q + r) * stride + (col0 + 4 * pp) * 2;
    const s16x4 lo = trr(a), hi = trr(a + 16 * stride);
    return (bf16x8){lo[0], lo[1], lo[2], lo[3], hi[0], hi[1], hi[2], hi[3]};
}
__device__ __forceinline__ bf16x8 nat_frag(const GLAS unsigned char* img, int stride, int row0, int k0, int lane) {
    return *(const GLAS bf16x8*)(img + (row0 + (lane & 15)) * stride + (k0 + 8 * (lane >> 4)) * 2);
}
__device__ __forceinline__ bf16x8 natp_frag(const GLAS unsigned char* img, int stride, int row0, int k0, int lane) {
    const GLAS unsigned char* a = img + (row0 + (lane & 15)) * stride + (k0 + 4 * (lane >> 4)) * 2;
    const s16x4 lo = *(const GLAS s16x4*)a, hi = *(const GLAS s16x4*)(a + 32);
    return (bf16x8){lo[0], lo[1], lo[2], lo[3], hi[0], hi[1], hi[2], hi[3]};
}
#define GMFMA(a, b, c) __builtin_amdgcn_mfma_f32_16x16x32_bf16(a, b, c, 0, 0, 0)

struct Src { const bf16_t* pp; int ld, qoff, koff, voff; const float* low; int lowbf; };

struct ChunkRegs { u32x4 k, q, v0, v1; f32x4 lw; };
__device__ __forceinline__ void chunk_load(ChunkRegs& cr, const Src& s, size_t row0, int h, bool withq, int tid) {
    { const int r = tid >> 3, c8 = (tid & 7) * 8; const bf16_t* pr = s.pp + (row0 + r) * s.ld;
      cr.k = *(const u32x4*)(pr + s.koff + h * 64 + c8);
      if (withq) cr.q = *(const u32x4*)(pr + s.qoff + h * 64 + c8); }
    { const int r = tid >> 4, c8 = (tid & 15) * 8; cr.v0 = *(const u32x4*)(s.pp + (row0 + r) * s.ld + s.voff + h * 128 + c8); cr.v1 = *(const u32x4*)(s.pp + (row0 + 32 + r) * s.ld + s.voff + h * 128 + c8); }
    { const int r = tid >> 3, c4 = (tid & 7) * 4;
      if (s.lowbf) { const uint2 t = *(const uint2*)(s.pp + (row0 + r) * s.ld + 768 + c4);
        cr.lw = (f32x4){__uint_as_float(t.x << 16), __uint_as_float(t.x & 0xffff0000u), __uint_as_float(t.y << 16), __uint_as_float(t.y & 0xffff0000u)}; }
      else cr.lw = *(const f32x4*)(s.low + (row0 + r) * 32 + c4); }
}
__device__ __forceinline__ void chunk_store(ldsp lds, const ChunkRegs& cr, bool withq, int tid) {
    { const int r = tid >> 3, c8 = (tid & 7) * 8; *(GLAS u32x4*)(lds + L_KR + r * NST + c8 * 2) = cr.k; if (withq) *(GLAS u32x4*)(lds + L_QR + r * NST + c8 * 2) = cr.q; }
    { const int r = tid >> 4, c8 = (tid & 15) * 8; *(GLAS u32x4*)(lds + L_V + r * VST + c8 * 2) = cr.v0; *(GLAS u32x4*)(lds + L_V + (32 + r) * VST + c8 * 2) = cr.v1; }
    { const int r = tid >> 3, c4 = (tid & 7) * 4; *(GLAS f32x4*)(lds + L_LW + (r * 32 + c4) * 4) = cr.lw; }
}
__device__ __forceinline__ void gate_scan(ldsp lds, int dir, int dp, int part, float (&c)[4][2]) {
    float z[4][2];
    { const f32x2 bb = *(const GLAS f32x2*)(lds + L_GB + (dir * 64 + 2 * dp) * 4);
#pragma unroll
      for (int rr = 0; rr < 4; ++rr) { z[rr][0] = bb[0]; z[rr][1] = bb[1]; } }
#pragma unroll
    for (int r4 = 0; r4 < 4; ++r4) {
        f32x2 wv[4];
#pragma unroll
        for (int r = 0; r < 4; ++r) wv[r] = *(const GLAS f32x2*)(lds + L_GW + ((dir * 16 + 4 * r4 + r) * 64 + 2 * dp) * 4);
#pragma unroll
        for (int rr = 0; rr < 4; ++rr) { const f32x4 l = *(const GLAS f32x4*)(lds + L_LW + ((4 * part + rr) * 32 + dir * 16 + 4 * r4) * 4);
#pragma unroll
            for (int r = 0; r < 4; ++r) { z[rr][0] += l[r] * wv[r][0]; z[rr][1] += l[r] * wv[r][1]; } }
    }
    float g[4][2];
#pragma unroll
    for (int rr = 0; rr < 4; ++rr) { g[rr][0] = logsigmoid_fast(z[rr][0]) * (1.f / 16.f); g[rr][1] = logsigmoid_fast(z[rr][1]) * (1.f / 16.f); }
#pragma unroll
    for (int e = 0; e < 2; ++e) {
        const float a0 = g[0][e], a1 = a0 + g[1][e], a2 = a1 + g[2][e], a3 = a2 + g[3][e];
        c[0][e] = dir ? a3 : a0; c[1][e] = dir ? a3 - a0 : a1; c[2][e] = dir ? a3 - a1 : a2; c[3][e] = dir ? a3 - a2 : a3;
    }
}
__device__ __forceinline__ void stage_gate_w(const Params& P, ldsp lds, int h, int tid) {
#pragma unroll
    for (int i = 0; i < 4; ++i) { const int idx = tid + 512 * i, dir = idx >> 10, r = (idx >> 6) & 15, d = idx & 63;
        *(GLAS float*)(lds + L_GW + idx * 4) = (dir ? P.gw_b : P.gw_f)[r * 256 + h * 64 + d]; }
    if (tid < 128) *(GLAS float*)(lds + L_GB + tid * 4) = ((tid >> 6) ? P.gb_b : P.gb_f)[h * 64 + (tid & 63)];
}

__device__ void pass_a(const Params& P, ldsp lds) {
    const int tid = opaque_tid(), lane = tid & 63, wid = tid >> 6, dp = tid & 31, part = tid >> 5;
    const int dt = wid & 3, eh = wid >> 2, q = lane >> 4, c16 = lane & 15;
    for (int item = blockIdx.x; item < 256 + 128; item += gridDim.x) {
        const bool isctx = item >= 256;
        int b, h, seg, nch; Src s; size_t rowbase;
        if (!isctx) { b = item >> 5; h = (item >> 3) & 3; seg = item & 7; nch = 8; s = Src{P.p, NP, OFF_Q, OFF_K, OFF_V, P.low, 0}; rowbase = (size_t)b * SEQ + seg * 512; }
        else { const int j = item - 256; b = j >> 4; h = (j >> 2) & 3; seg = 0; nch = 1; s = Src{P.pctx, 1024, 0, 0, 256, P.low, 1}; rowbase = (size_t)b * CTXL + (j & 3) * 64; }
        __syncthreads(); stage_gate_w(P, lds, h, tid);
        f32x4 Sf[4], Sb[4];
#pragma unroll
        for (int n = 0; n < 4; ++n) { Sf[n] = (f32x4){0.f, 0.f, 0.f, 0.f}; Sb[n] = (f32x4){0.f, 0.f, 0.f, 0.f}; }
        float LPb[2] = {0.f, 0.f}, LPf[2] = {0.f, 0.f};
        const bool wq = !isctx;
        ChunkRegs cr; chunk_load(cr, s, rowbase, h, wq, tid);
        for (int n = 0; n < nch; ++n) {
            __syncthreads();
            chunk_store(lds, cr, wq, tid);
            if (n + 1 < nch) chunk_load(cr, s, rowbase + (n + 1) * 64, h, wq, tid);
            __syncthreads();
            float cf[4][2], cb[4][2];
            gate_scan(lds, 0, dp, part, cf); gate_scan(lds, 1, dp, part, cb);
            GLAS float* PT = (GLAS float*)(lds + L_PT);
            *(GLAS f32x2*)(PT + part * 64 + 2 * dp) = (f32x2){cf[3][0], cf[3][1]};
            *(GLAS f32x2*)(PT + 1024 + part * 64 + 2 * dp) = (f32x2){cb[0][0], cb[0][1]};
            __syncthreads();
            float offf[2] = {0.f, 0.f}, totf[2] = {0.f, 0.f}, offb[2] = {0.f, 0.f}, totb[2] = {0.f, 0.f};
#pragma unroll 4
            for (int pq = 0; pq < 16; ++pq) { const f32x2 a = *(const GLAS f32x2*)(PT + pq * 64 + 2 * dp), bq = *(const GLAS f32x2*)(PT + 1024 + pq * 64 + 2 * dp);
                totf[0] += a[0]; totf[1] += a[1]; totb[0] += bq[0]; totb[1] += bq[1];
                const float mf = (pq < part) ? 1.f : 0.f, mb = (pq > part) ? 1.f : 0.f; offf[0] += mf * a[0]; offf[1] += mf * a[1]; offb[0] += mb * bq[0]; offb[1] += mb * bq[1]; }
            const float etf0 = __expf(totf[0]), etf1 = __expf(totf[1]), etb0 = __expf(totb[0]), etb1 = __expf(totb[1]), elp0 = __expf(LPb[0]), elp1 = __expf(LPb[1]);
#pragma unroll
            for (int rr = 0; rr < 4; ++rr) { const int i = 4 * part + rr;
                const unsigned kk = *(const GLAS unsigned*)(lds + L_KR + i * NST + 4 * dp);
                const float k0 = __uint_as_float(kk << 16), k1 = __uint_as_float(kk & 0xffff0000u);
                const float egf0 = __expf(cf[rr][0] + offf[0]), egf1 = __expf(cf[rr][1] + offf[1]), egb0 = __expf(cb[rr][0] + offb[0]), egb1 = __expf(cb[rr][1] + offb[1]);
                const float eif0 = __builtin_amdgcn_rcpf(egf0), eif1 = __builtin_amdgcn_rcpf(egf1), eib0 = __builtin_amdgcn_rcpf(egb0), eib1 = __builtin_amdgcn_rcpf(egb1);
                const float kef0 = k0 * (etf0 * eif0), kef1 = k1 * (etf1 * eif1), keb0 = k0 * (etb0 * eib0), keb1 = k1 * (etb1 * eib1);
                *(GLAS unsigned*)(lds + L_KE + i * KEST + 4 * dp) = pack2(kef0, kef1);
                *(GLAS unsigned*)(lds + L_KE2 + i * KEST + 4 * dp) = pack2(keb0 * elp0, keb1 * elp1);
                if (wq) {
                    const unsigned qq = *(const GLAS unsigned*)(lds + L_QR + i * NST + 4 * dp);
                    const float q0 = __uint_as_float(qq << 16) * 0.125f, q1 = __uint_as_float(qq & 0xffff0000u) * 0.125f;
                    const size_t o0 = (rowbase + n * 64 + i) * 256 + h * 64 + 2 * dp, o1 = o0 + (size_t)NTOK * 256;
                    *(unsigned*)(P.gqd + o0) = pack2(q0 * egf0, q1 * egf1); *(unsigned*)(P.gkinv + o0) = pack2(k0 * eif0, k1 * eif1);
                    *(unsigned*)(P.gqd + o1) = pack2(q0 * egb0, q1 * egb1); *(unsigned*)(P.gkinv + o1) = pack2(k0 * eib0, k1 * eib1); } }
            if (part == 0) { *(GLAS f32x2*)(lds + L_DEC + 8 * dp) = (f32x2){etf0, etf1};
                if (wq) { const size_t ch = (rowbase >> 6) + n; *(float2*)(P.gdec + (ch * 4 + h) * 64 + 2 * dp) = (float2){etf0, etf1}; *(float2*)(P.gdec + ((512 + ch) * 4 + h) * 64 + 2 * dp) = (float2){etb0, etb1}; } }
            LPb[0] += totb[0]; LPb[1] += totb[1]; LPf[0] += totf[0]; LPf[1] += totf[1];
            __syncthreads();
            const f32x4 dec = *(const GLAS f32x4*)(lds + L_DEC + (16 * dt + 4 * q) * 4);
#pragma unroll
            for (int nn = 0; nn < 4; ++nn) Sf[nn] = Sf[nn] * dec;
#pragma unroll
            for (int ks = 0; ks < 2; ++ks) {
                const bf16x8 af = tr_frag(lds + L_KE, KEST, 32 * ks, 16 * dt, lane), ab = tr_frag(lds + L_KE2, KEST, 32 * ks, 16 * dt, lane);
#pragma unroll
                for (int nn = 0; nn < 4; ++nn) { const bf16x8 bv = tr_frag(lds + L_V, VST, 32 * ks, 64 * eh + 16 * nn, lane); Sf[nn] = GMFMA(af, bv, Sf[nn]); Sb[nn] = GMFMA(ab, bv, Sb[nn]); }
            }
        }
        float* Uf; float* Ub;
        if (!isctx) { Uf = P.Useg + (size_t)(item * 2) * 8192; Ub = Uf + 8192; }
        else { Uf = P.ctxS + (size_t)((item - 256) * 2) * 8192; Ub = Uf + 8192; }
#pragma unroll
        for (int nn = 0; nn < 4; ++nn) { *(f32x4*)(Uf + tid * 16 + 4 * nn) = Sf[nn]; *(f32x4*)(Ub + tid * 16 + 4 * nn) = Sb[nn]; }
        if (part == 0) { float* Dg = isctx ? P.ctxS + (size_t)256 * 8192 + (size_t)((item - 256) * 2) * 64 : P.Dseg + (size_t)(item * 2) * 64;
            *(float2*)(Dg + 2 * dp) = (float2){__expf(LPf[0]), __expf(LPf[1])}; *(float2*)(Dg + 64 + 2 * dp) = (float2){__expf(LPb[0]), __expf(LPb[1])}; }
    }
}

struct ChunkB { u32x4 qd, kinv, v0, v1; f32x4 dec; };
__device__ __forceinline__ void chunkb_load(ChunkB& cr, const Params& P, int dir, size_t row0, int h, int tid) {
    { const int r = tid >> 3, c8 = (tid & 7) * 8; const size_t o = ((size_t)dir * NTOK + row0 + r) * 256 + h * 64 + c8;
      cr.qd = *(const u32x4*)(P.gqd + o); cr.kinv = *(const u32x4*)(P.gkinv + o); }
    { const int r = tid >> 4, c8 = (tid & 15) * 8; cr.v0 = *(const u32x4*)(P.p + (row0 + r) * NP + OFF_V + h * 128 + c8); cr.v1 = *(const u32x4*)(P.p + (row0 + 32 + r) * NP + OFF_V + h * 128 + c8); }
    if (tid < 16) cr.dec = *(const f32x4*)(P.gdec + (((size_t)dir * 512 + (row0 >> 6)) * 4 + h) * 64 + 4 * tid);
}
__device__ __forceinline__ void chunkb_store(ldsp lds, const ChunkB& cr, int tid) {
    { const int r = tid >> 3, c8 = (tid & 7) * 8; *(GLAS u32x4*)(lds + L_QD + r * NST + c8 * 2) = cr.qd; *(GLAS u32x4*)(lds + L_KE + r * KEST + c8 * 2) = cr.kinv; }
    { const int r = tid >> 4, c8 = (tid & 15) * 8; *(GLAS u32x4*)(lds + L_V + r * VST + c8 * 2) = cr.v0; *(GLAS u32x4*)(lds + L_V + (32 + r) * VST + c8 * 2) = cr.v1; }
    if (tid < 16) *(GLAS f32x4*)(lds + L_DEC + 16 * tid) = cr.dec;
}
__device__ __forceinline__ void fold_state(const Params& P, f32x4 (&S)[4], int item, int dir, int tid, int dt, int q) {
    const int b = item >> 5, h = (item >> 3) & 3, seg = item & 7;
    {
        f32x4 u[4][4], dd[4];
#pragma unroll
        for (int ff = 0; ff < 4; ++ff) { const int cc = dir ? 3 - ff : ff, e = (((b * 4 + h) * 4 + cc) * 2 + dir);
            const float* U = P.ctxS + (size_t)e * 8192 + tid * 16;
            dd[ff] = *(const f32x4*)(P.ctxS + (size_t)256 * 8192 + (size_t)e * 64 + 16 * dt + 4 * q);
#pragma unroll
            for (int nn = 0; nn < 4; ++nn) u[ff][nn] = *(const f32x4*)(U + 4 * nn); }
#pragma unroll
        for (int nn = 0; nn < 4; ++nn) S[nn] = u[0][nn];
#pragma unroll
        for (int ff = 1; ff < 4; ++ff)
#pragma unroll
            for (int nn = 0; nn < 4; ++nn) S[nn] = dd[ff] * S[nn] + u[ff][nn]; }
    const int nfold = dir ? 7 - seg : seg;
    for (int f0 = 0; f0 < nfold; f0 += 4) { f32x4 u[4][4], dd[4];
#pragma unroll
        for (int ff = 0; ff < 4; ++ff) { const int f = min(f0 + ff, nfold - 1), sp = dir ? 7 - f : f, it2 = (item & ~7) + sp;
            const float* U = P.Useg + (size_t)(it2 * 2 + dir) * 8192 + tid * 16;
            dd[ff] = *(const f32x4*)(P.Dseg + (size_t)(it2 * 2 + dir) * 64 + 16 * dt + 4 * q);
#pragma unroll
            for (int nn = 0; nn < 4; ++nn) u[ff][nn] = *(const f32x4*)(U + 4 * nn); }
#pragma unroll
        for (int ff = 0; ff < 4; ++ff) { const bool v = f0 + ff < nfold; const f32x4 one = (f32x4){1.f, 1.f, 1.f, 1.f}, zero = (f32x4){0.f, 0.f, 0.f, 0.f}; const f32x4 de = v ? dd[ff] : one;
#pragma unroll
            for (int nn = 0; nn < 4; ++nn) S[nn] = de * S[nn] + (v ? u[ff][nn] : zero); } }
}
__device__ void pass_b(const Params& P, ldsp lds) {
    const int tid = opaque_tid(), lane = tid & 63, wid = tid >> 6;
    const int dt = wid & 3, eh = wid >> 2, q = lane >> 4, c16 = lane & 15, it = wid & 3;
    for (int item = blockIdx.x; item < 256; item += gridDim.x) {
        const int b = item >> 5, h = (item >> 3) & 3, seg = item & 7;
        const size_t rowbase = (size_t)b * SEQ + seg * 512;
        __syncthreads();
        if (tid < 128) *(GLAS float*)(lds + L_GG + tid * 4) = P.gla_g[tid];
        f32x4 Sd[2][4];
        fold_state(P, Sd[0], item, 0, tid, dt, q); fold_state(P, Sd[1], item, 1, tid, dt, q);
        u32x2 part[4][4];
        ChunkB cr; chunkb_load(cr, P, 0, rowbase, h, tid);
#pragma unroll
        for (int t = 0; t < 8; ++t) {
#pragma unroll
            for (int dir = 0; dir < 2; ++dir) {
                const int n = dir ? 7 - t : t;
                const bool fin = dir ? (n < 4) : (n >= 4);
                int n_o = n, nx_o = dir ? t + 1 : 7 - t;
                asm volatile("" : "+s"(n_o), "+s"(nx_o));
                const size_t row0 = rowbase + n_o * 64;
                __syncthreads();
#pragma unroll
                for (int nn = 0; nn < 4; ++nn) { u32x2 wv; wv[0] = pack2(Sd[dir][nn][0], Sd[dir][nn][1]); wv[1] = pack2(Sd[dir][nn][2], Sd[dir][nn][3]);
                    *(GLAS u32x2*)(lds + L_ST + (64 * eh + 16 * nn + c16) * NST + (16 * dt + 4 * q) * 2) = wv; }
                chunkb_store(lds, cr, tid);
                if (dir == 0) chunkb_load(cr, P, 1, rowbase + nx_o * 64, h, tid);
                else if (t < 7) chunkb_load(cr, P, 0, rowbase + nx_o * 64, h, tid);
                uint2 rvr[4];
                if (fin) {
#pragma unroll
                    for (int nn = 0; nn < 4; ++nn) rvr[nn] = *(const uint2*)(P.p + (row0 + 16 * it + c16) * NP + OFF_R + h * 128 + 64 * eh + 16 * nn + 4 * q);
                }
                __syncthreads();
#pragma unroll
                for (int t2 = 0; t2 < 2; ++t2) { const int jt = eh * 2 + t2;
                    f32x4 sc = (f32x4){0.f, 0.f, 0.f, 0.f};
#pragma unroll
                    for (int ks = 0; ks < 2; ++ks) sc = GMFMA(nat_frag(lds + L_KE, KEST, 16 * jt, 32 * ks, lane), nat_frag(lds + L_QD, NST, 16 * it, 32 * ks, lane), sc);
                    const int i = 16 * it + c16;
#pragma unroll
                    for (int j = 0; j < 4; ++j) { const int jj = 16 * jt + 4 * q + j; const bool keep = dir ? (jj >= i) : (jj <= i); if (!keep) sc[j] = 0.f; }
                    u32x2 wv; wv[0] = pack2(sc[0], sc[1]); wv[1] = pack2(sc[2], sc[3]);
                    *(GLAS u32x2*)(lds + L_P + i * NST + (16 * jt + 4 * q) * 2) = wv; }
                __syncthreads();
                f32x4 o[4];
#pragma unroll
                for (int nn = 0; nn < 4; ++nn) o[nn] = (f32x4){0.f, 0.f, 0.f, 0.f};
#pragma unroll
                for (int ks = 0; ks < 2; ++ks) {
                    const bf16x8 pb = natp_frag(lds + L_P, NST, 16 * it, 32 * ks, lane), qb = nat_frag(lds + L_QD, NST, 16 * it, 32 * ks, lane);
#pragma unroll
                    for (int nn = 0; nn < 4; ++nn) { o[nn] = GMFMA(tr_frag(lds + L_V, VST, 32 * ks, 64 * eh + 16 * nn, lane), pb, o[nn]);
                        o[nn] = GMFMA(nat_frag(lds + L_ST, NST, 64 * eh + 16 * nn, 32 * ks, lane), qb, o[nn]); }
                }
                { const f32x4 dec = *(const GLAS f32x4*)(lds + L_DEC + (16 * dt + 4 * q) * 4);
#pragma unroll
                  for (int ks = 0; ks < 2; ++ks) { const bf16x8 af = tr_frag(lds + L_KE, KEST, 32 * ks, 16 * dt, lane);
#pragma unroll
                    for (int nn = 0; nn < 4; ++nn) Sd[dir][nn] = GMFMA(af, tr_frag(lds + L_V, VST, 32 * ks, 64 * eh + 16 * nn, lane), Sd[dir][nn]); }
#pragma unroll
                  for (int nn = 0; nn < 4; ++nn) Sd[dir][nn] = Sd[dir][nn] * dec; }
                if (!fin) {
#pragma unroll
                    for (int nn = 0; nn < 4; ++nn) { u32x2 wv; wv[0] = pack2(o[nn][0], o[nn][1]); wv[1] = pack2(o[nn][2], o[nn][3]);
                        if (n < 4) part[n & 3][nn] = wv; else *(GLAS u32x2*)(lds + (n < 6 ? L_PB0 + (n - 4) * 16384 : L_PB1 + (n - 6) * 16384) + nn * 4096 + tid * 8) = wv; }
                } else {
                    float ss = 0.f;
#pragma unroll
                    for (int nn = 0; nn < 4; ++nn) { const u32x2 pv = n < 4 ? part[n & 3][nn] : *(const GLAS u32x2*)(lds + (n < 6 ? L_PB0 + (n - 4) * 16384 : L_PB1 + (n - 6) * 16384) + nn * 4096 + tid * 8);
                        o[nn][0] += __uint_as_float(pv[0] << 16); o[nn][1] += __uint_as_float(pv[0] & 0xffff0000u); o[nn][2] += __uint_as_float(pv[1] << 16); o[nn][3] += __uint_as_float(pv[1] & 0xffff0000u);
                        ss += o[nn][0] * o[nn][0] + o[nn][1] * o[nn][1] + o[nn][2] * o[nn][2] + o[nn][3] * o[nn][3]; }
                    ss += __shfl_xor(ss, 16); ss += __shfl_xor(ss, 32);
                    GLAS float* RS = (GLAS float*)(lds + L_RS);
                    if (q == 0) RS[eh * 64 + 16 * it + c16] = ss;
                    __syncthreads();
                    const float tot2 = RS[16 * it + c16] + RS[64 + 16 * it + c16];
                    const float rs = rsqrtf(tot2 * (1.f / 128.f) + 1e-6f);
                    const size_t tok = row0 + 16 * it + c16;
#pragma unroll
                    for (int nn = 0; nn < 4; ++nn) { const int e = 64 * eh + 16 * nn + 4 * q;
                        const uint2 rv = rvr[nn];
                        const f32x4 gg = *(const GLAS f32x4*)(lds + L_GG + e * 4);
                        const float r0 = __uint_as_float(rv.x << 16), r1 = __uint_as_float(rv.x & 0xffff0000u), r2 = __uint_as_float(rv.y << 16), r3 = __uint_as_float(rv.y & 0xffff0000u);
                        uint2 wv; wv.x = pack2(o[nn][0] * rs * gg[0] * siluf(r0), o[nn][1] * rs * gg[1] * siluf(r1)); wv.y = pack2(o[nn][2] * rs * gg[2] * siluf(r2), o[nn][3] * rs * gg[3] * siluf(r3));
                        *(uint2*)(P.ymix + tok * D + 512 + h * 128 + e) = wv; }
                }
            }
        }
    }
}
}

__device__ void phase_conv(const Params& P) {
  typedef unsigned cu32x4 __attribute__((ext_vector_type(4)));
  const int tid_ = opaque_tid(); const int lane = tid_ & 63, wl = blockIdx.x * 8 + (tid_ >> 6);
  const int ch = lane * 8;
  float cw0[8], cw1[8], cw2[8], cb[8];
#pragma unroll
  for (int j = 0; j < 8; ++j) { cw0[j] = P.conv_w[ch + j]; cw1[j] = P.conv_w[512 + ch + j]; cw2[j] = P.conv_w[1024 + ch + j]; cb[j] = P.conv_b[ch + j]; }
#pragma unroll 1
  for (int task = wl; task < 4096; task += 2048) {
    const int tok0 = task * 8, gx0 = tok0 & 63;
    const bool hl = gx0 > 0, hr = gx0 < 56;
    const bf16_t* pr = P.p + (size_t)tok0 * NP;
    cu32x4 ru[10], rb[8];
#pragma unroll
    for (int t = 0; t < 10; ++t) { const int dtk = (t == 0) ? (hl ? -1 : 0) : ((t == 9) ? (hr ? 8 : 7) : t - 1);
      ru[t] = *(const cu32x4*)(pr + (ptrdiff_t)dtk * NP + OFF_AC + ch); }
#pragma unroll
    for (int t = 0; t < 8; ++t) rb[t] = *(const cu32x4*)(pr + (size_t)t * NP + OFF_AB + ch);
    float um[8], u0[8];
#pragma unroll
    for (int w = 0; w < 4; ++w) { const unsigned a0 = ru[0][w], a1 = ru[1][w];
      um[2 * w] = hl ? __uint_as_float(a0 << 16) : 0.f; um[2 * w + 1] = hl ? __uint_as_float(a0 & 0xffff0000u) : 0.f;
      u0[2 * w] = __uint_as_float(a1 << 16); u0[2 * w + 1] = __uint_as_float(a1 & 0xffff0000u); }
#pragma unroll
    for (int i = 0; i < 8; ++i) {
      const bool hn = (i < 7) || hr;
      float up[8], ya[8];
#pragma unroll
      for (int w = 0; w < 4; ++w) { const unsigned a = ru[i + 2][w];
        up[2 * w] = hn ? __uint_as_float(a << 16) : 0.f; up[2 * w + 1] = hn ? __uint_as_float(a & 0xffff0000u) : 0.f; }
#pragma unroll
      for (int w = 0; w < 4; ++w) { const unsigned bv = rb[i][w]; const float b0 = __uint_as_float(bv << 16), b1 = __uint_as_float(bv & 0xffff0000u);
        ya[2 * w] = b0 * (um[2 * w] * cw0[2 * w] + u0[2 * w] * cw1[2 * w] + up[2 * w] * cw2[2 * w] + cb[2 * w]);
        ya[2 * w + 1] = b1 * (um[2 * w + 1] * cw0[2 * w + 1] + u0[2 * w + 1] * cw1[2 * w + 1] + up[2 * w + 1] * cw2[2 * w + 1] + cb[2 * w + 1]); }
#pragma unroll
      for (int j = 0; j < 8; ++j) { um[j] = u0[j]; u0[j] = up[j]; }
      *(uint4*)(P.ymix + (size_t)(tok0 + i) * D + ch) = pack8(ya);
    }
  }
}

struct Ln1In { float4 x[4]; uint2 y[4]; float mean0, rstd0; };
__device__ __forceinline__ void ln1_load(const Params& P, int tok, int lane, Ln1In& in) {
#pragma unroll
    for (int j = 0; j < 4; ++j) { const int k = j * 256 + lane * 4; in.x[j] = *(const float4*)(P.x + (size_t)tok * D + k); in.y[j] = *(const uint2*)(P.ybuf + (size_t)tok * D + k); }
    in.mean0 = P.stats[tok * 2]; in.rstd0 = P.stats[tok * 2 + 1];
}
__device__ __forceinline__ void ln1_row(const Params& P, int tok, int lane, const Ln1In& in, const float* PR) {
    typedef float f32x4 __attribute__((ext_vector_type(4)));
    const float mean0 = in.mean0, rstd0 = in.rstd0;
    float v[16];
#pragma unroll
    for (int j = 0; j < 4; ++j) {
      const int k = j * 256 + lane * 4;
      const float4 xv = in.x[j]; const uint2 yv = in.y[j];
      const f32x4 g = *(const f32x4*)(PR + k), bb = *(const f32x4*)(PR + 1024 + k), g1 = *(const f32x4*)(PR + 2048 + k);
      v[4 * j] = (xv.x - mean0) * rstd0 * g[0] + bb[0] + g1[0] * __uint_as_float(yv.x << 16);
      v[4 * j + 1] = (xv.y - mean0) * rstd0 * g[1] + bb[1] + g1[1] * __uint_as_float(yv.x & 0xffff0000u);
      v[4 * j + 2] = (xv.z - mean0) * rstd0 * g[2] + bb[2] + g1[2] * __uint_as_float(yv.y << 16);
      v[4 * j + 3] = (xv.w - mean0) * rstd0 * g[3] + bb[3] + g1[3] * __uint_as_float(yv.y & 0xffff0000u);
    }
    float s = 0.f;
#pragma unroll
    for (int j = 0; j < 16; ++j) s += v[j];
    const float mean = wave_sum(s) * (1.f / 1024.f);
    float q = 0.f;
#pragma unroll
    for (int j = 0; j < 16; ++j) { const float dd = v[j] - mean; q += dd * dd; }
    const float rstd = rsqrtf(wave_sum(q) * (1.f / 1024.f) + 1e-5f);
#pragma unroll
    for (int j = 0; j < 4; ++j) {
      const int k = j * 256 + lane * 4;
      const f32x4 g = *(const f32x4*)(PR + 3072 + k), bb = *(const f32x4*)(PR + 4096 + k), sc = *(const f32x4*)(PR + 5120 + k), sh = *(const f32x4*)(PR + 6144 + k);
      const float x0 = (v[4 * j] - mean) * rstd * g[0] + bb[0], x1v = (v[4 * j + 1] - mean) * rstd * g[1] + bb[1], x2 = (v[4 * j + 2] - mean) * rstd * g[2] + bb[2], x3 = (v[4 * j + 3] - mean) * rstd * g[3] + bb[3];
      uint2 w; w.x = pack2(x0, x1v); w.y = pack2(x2, x3); *(uint2*)(P.x1 + (size_t)tok * D + k) = w;
      const float hh0 = x0 * sc[0] + sh[0], hh1 = x1v * sc[1] + sh[1], hh2 = x2 * sc[2] + sh[2], hh3 = x3 * sc[3] + sh[3];
      *(unsigned*)(P.h2q + (size_t)tok * D + k) = pack4_fp8(hh0 * 8.f, hh1 * 8.f, hh2 * 8.f, hh3 * 8.f);
    }
}
__device__ __forceinline__ void route_token(const Params& P, const float (&lg)[20], int* hcnt, int& c_out, int& rank_out, float& wlo_out, float& whi_out) {
    const float g0 = lg[0] + P.bgr[0], g1 = lg[1] + P.bgr[1], g2 = lg[2] + P.bgr[2], g3 = lg[3] + P.bgr[3];
    int gi = 0; float gm = g0;
    if (g1 > gm) { gm = g1; gi = 1; } if (g2 > gm) { gm = g2; gi = 2; } if (g3 > gm) { gm = g3; gi = 3; }
    const float pg = 1.f / (__expf(g0 - gm) + __expf(g1 - gm) + __expf(g2 - gm) + __expf(g3 - gm));
    float e[4];
#pragma unroll
    for (int n = 0; n < 4; ++n) e[n] = (gi == 0 ? lg[4 + n] : (gi == 1 ? lg[8 + n] : (gi == 2 ? lg[12 + n] : lg[16 + n]))) + P.ber[gi * 4 + n];
    int i1 = 0; float m1 = e[0];
    if (e[1] > m1) { m1 = e[1]; i1 = 1; } if (e[2] > m1) { m1 = e[2]; i1 = 2; } if (e[3] > m1) { m1 = e[3]; i1 = 3; }
    int i2 = -1; float m2 = -3.0e38f;
#pragma unroll
    for (int n = 0; n < 4; ++n) if (n != i1 && (i2 < 0 || e[n] > m2)) { m2 = e[n]; i2 = n; }
    const float ex2 = __expf(m2 - m1);
    const float w1 = 1.f / (1.f + ex2), w2 = ex2 / (1.f + ex2);
    const int lo = i1 < i2 ? i1 : i2, hi = i1 < i2 ? i2 : i1;
    const float wlo = (i1 < i2 ? w1 : w2) * pg, whi = (i1 < i2 ? w2 : w1) * pg;
    const int pidx = lo == 0 ? hi - 1 : (lo == 1 ? hi + 1 : 5);
    const int c = gi * 6 + pidx;
    c_out = c; wlo_out = wlo; whi_out = whi;
    rank_out = atomicAdd(&hcnt[c], 1);
}
__device__ void phase_ln1_router(const Params& P, float* ldsf) {
  typedef short bf16x8 __attribute__((ext_vector_type(8))); typedef float f32x4 __attribute__((ext_vector_type(4)));
  constexpr int WST = 2064;
  unsigned char* lds = (unsigned char*)ldsf;
  float* LG = (float*)(lds + 20 * WST);
  int* hcnt = (int*)(lds + 20 * WST + 8 * 16 * 32 * 4);
  float* PR = (float*)(lds + 20 * WST + 8 * 16 * 32 * 4 + 128);
  const int tid = opaque_tid(), lane = tid & 63, wid = tid >> 6;
  { const float* md = P.mod + ((blockIdx.x * 128) / SEQ) * 6144;
    for (int k = tid; k < 1024; k += 512) { PR[k] = ALPHA * P.ln_in_g[k]; PR[1024 + k] = ALPHA * P.ln_in_b[k]; PR[2048 + k] = md[2048 + k]; PR[3072 + k] = P.ln1_g[k]; PR[4096 + k] = P.ln1_b[k];
      PR[5120 + k] = 1.f + md[4096 + k]; PR[6144 + k] = md[3072 + k]; } }
  float* BS = PR + 7 * 1024;
  int* tcls = (int*)(BS + 192); int* trank = tcls + 128; int* tpos = trank + 128; int* cbase = tpos + 128; float* tw = (float*)(cbase + 32);
  { const float* md = P.mod + ((blockIdx.x * 128) / SEQ) * 6144;
    typedef float lf4 __attribute__((ext_vector_type(4)));
    lf4 wl[10]; float scl[10];
#pragma unroll
    for (int u = 0; u < 10; ++u) { const int i = tid + 512 * u, k = i / 5, c4 = i % 5; wl[u] = c4 == 0 ? *(const lf4*)(P.wgr + k * 4) : *(const lf4*)(P.wer + k * 16 + (c4 - 1) * 4); scl[u] = md[4096 + k]; }
#pragma unroll
    for (int u = 0; u < 10; ++u) {
      const int i = tid + 512 * u, k = i / 5, c4 = i % 5; const float4 t = make_float4(wl[u][0], wl[u][1], wl[u][2], wl[u][3]);
      const float sc = 1.f + scl[u];
      *(bf16_t*)(lds + (c4 * 4 + 0) * WST + k * 2) = f2bf(t.x * sc); *(bf16_t*)(lds + (c4 * 4 + 1) * WST + k * 2) = f2bf(t.y * sc);
      *(bf16_t*)(lds + (c4 * 4 + 2) * WST + k * 2) = f2bf(t.z * sc); *(bf16_t*)(lds + (c4 * 4 + 3) * WST + k * 2) = f2bf(t.w * sc); }
    float bp[20];
#pragma unroll
    for (int n = 0; n < 20; ++n) bp[n] = 0.f;
#pragma unroll
    for (int kk = 0; kk < 2; ++kk) { const int k = tid + 512 * kk; const float sh = md[3072 + k];
      const float4 g4 = *(const float4*)(P.wgr + k * 4); bp[0] += sh * g4.x; bp[1] += sh * g4.y; bp[2] += sh * g4.z; bp[3] += sh * g4.w;
#pragma unroll
      for (int c4 = 0; c4 < 4; ++c4) { const float4 e4 = *(const float4*)(P.wer + k * 16 + c4 * 4); bp[4 + 4 * c4] += sh * e4.x; bp[5 + 4 * c4] += sh * e4.y; bp[6 + 4 * c4] += sh * e4.z; bp[7 + 4 * c4] += sh * e4.w; } }
#pragma unroll
    for (int n = 0; n < 20; ++n) { const float t = wave_sum(bp[n]); if (lane == 0) BS[wid * 20 + n] = t; } }
  if (tid < NCLS) hcnt[tid] = 0;
  const int tokb = blockIdx.x * 128 + wid * 16;
  Ln1In inA, inB;
  ln1_load(P, tokb, lane, inA); ln1_load(P, tokb + 1, lane, inB);
  __syncthreads();
#pragma unroll 1
  for (int it = 0; it < 8; ++it) {
    const int tok0 = tokb + it * 2;
    const Ln1In cA = inA, cB = inB;
    if (it < 7) { ln1_load(P, tok0 + 2, lane, inA); ln1_load(P, tok0 + 3, lane, inB); }
    ln1_row(P, tok0, lane, cA, PR); ln1_row(P, tok0 + 1, lane, cB, PR);
  }
  asm volatile("s_waitcnt vmcnt(0)" ::: "memory");
  __syncthreads();
  const int r16 = lane & 15, q = lane >> 4;
  f32x4 a0 = {0.f, 0.f, 0.f, 0.f}, a1 = {0.f, 0.f, 0.f, 0.f};
  const bf16_t* arow = P.x1 + (size_t)(tokb + r16) * D + 8 * q;
  const unsigned char* b0p = lds + r16 * WST + 16 * q; const unsigned char* b1p = lds + (r16 < 4 ? 16 + r16 : 19) * WST + 16 * q;
#pragma unroll 8
  for (int ks = 0; ks < 32; ++ks) {
    const bf16x8 a = *(const bf16x8*)(arow + 32 * ks);
    a0 = __builtin_amdgcn_mfma_f32_16x16x32_bf16(a, *(const bf16x8*)(b0p + 64 * ks), a0, 0, 0, 0);
    a1 = __builtin_amdgcn_mfma_f32_16x16x32_bf16(a, *(const bf16x8*)(b1p + 64 * ks), a1, 0, 0, 0);
  }
  float* lgw = LG + wid * 512;
#pragma unroll
  for (int j = 0; j < 4; ++j) { lgw[(4 * q + j) * 32 + r16] = a0[j]; if (r16 < 4) lgw[(4 * q + j) * 32 + 16 + r16] = a1[j]; }
  __syncthreads();
  if (lane < 16) {
    float lg[20];
#pragma unroll
    for (int n4 = 0; n4 < 5; ++n4) { const float4 t = *(const float4*)(lgw + lane * 32 + 4 * n4); lg[4 * n4] = t.x; lg[4 * n4 + 1] = t.y; lg[4 * n4 + 2] = t.z; lg[4 * n4 + 3] = t.w; }
#pragma unroll
    for (int n = 0; n < 20; ++n) { float bsum = 0.f;
#pragma unroll
      for (int w8 = 0; w8 < 8; ++w8) bsum += BS[w8 * 20 + n];
      lg[n] += bsum; }
    int c, rk; float w0, w1; route_token(P, lg, hcnt, c, rk, w0, w1);
    const int ti = wid * 16 + lane; tcls[ti] = c; trank[ti] = rk; tw[2 * ti] = w0; tw[2 * ti + 1] = w1;
  }
  __syncthreads();
  unsigned* ctl = P.ctrl;
  if (tid < NCLS) { const int n = hcnt[tid]; unsigned base = 0u;
    if (n > 0) { base = __hip_atomic_fetch_add(ctl + 4096 + 64 * tid, (unsigned)n, __ATOMIC_RELAXED, __HIP_MEMORY_SCOPE_AGENT);
      for (unsigned k = (base + 255u) >> 8; (k << 8) < base + (unsigned)n; ++k) { const unsigned id = __hip_atomic_fetch_add(ctl + 4096 + 64 * NCLS, 1u, __ATOMIC_RELAXED, __HIP_MEMORY_SCOPE_AGENT);
        P.tileinfo[1 + id] = tid; __hip_atomic_store(ctl + 8192 + tid * 128 + k, id + 1u, __ATOMIC_RELAXED, __HIP_MEMORY_SCOPE_AGENT); } }
    cbase[tid] = (int)base; }
  __syncthreads();
  if (tid < 128) { const int c = tcls[tid]; const unsigned slot = (unsigned)(cbase[c] + trank[tid]), k = slot >> 8; unsigned* pe = ctl + 8192 + c * 128 + k; unsigned pt, sp = 0;
    while ((pt = __hip_atomic_load(pe, __ATOMIC_RELAXED, __HIP_MEMORY_SCOPE_AGENT)) == 0u) { __builtin_amdgcn_s_sleep(1); if (++sp > (1u << 24)) { pt = 1u; break; } }
    const int pos = (int)((pt - 1u) * 256u + (slot & 255u)); tpos[tid] = pos;
    P.perm[blockIdx.x * 128 + tid] = pos; P.cws[(size_t)pos * 2] = tw[2 * tid]; P.cws[(size_t)pos * 2 + 1] = tw[2 * tid + 1]; }
  __syncthreads();
  { typedef unsigned cu32x4 __attribute__((ext_vector_type(4))); cu32x4 t[16];
#pragma unroll
    for (int r = 0; r < 16; ++r) t[r] = *(const cu32x4*)(P.h2q + (size_t)(tokb + r) * D + lane * 16);
#pragma unroll
    for (int r = 0; r < 16; ++r) *(cu32x4*)(P.h2qs + (size_t)tpos[wid * 16 + r] * D + lane * 16) = t[r]; }
}

__device__ void phase_moe_sort(const Params& P, int* lds) {
  int* H = lds;
  int* tot = lds + 256 * NCLS;
  int* cstart = tot + NCLS;
  int* base = cstart + 32;
  int* mycls = base + NCLS;
  int* mypos = mycls + 128;
  const int tid = opaque_tid(), b = blockIdx.x;
  { int hv[12];
#pragma unroll
    for (int u = 0; u < 12; ++u) hv[u] = P.hist[tid + 512 * u];
#pragma unroll
    for (int u = 0; u < 12; ++u) H[tid + 512 * u] = hv[u]; }
  if (tid < 128) mycls[tid] = P.cls[b * 128 + tid];
  __syncthreads();
  if (tid < NCLS) { int t = 0, pre = 0; for (int bb = 0; bb < 256; ++bb) { if (bb == b) pre = t; t += H[bb * NCLS + tid]; } tot[tid] = t; base[tid] = pre; }
  __syncthreads();
  if (tid == 0) { int s = 0; for (int c = 0; c < NCLS; ++c) { cstart[c] = s; s += (tot[c] + 255) / 256 * 256; } cstart[NCLS] = s; }
  __syncthreads();
  if (tid < 128) { const int c = mycls[tid]; int r = 0; for (int j = 0; j < tid; ++j) r += (mycls[j] == c) ? 1 : 0; const int pos = cstart[c] + base[c] + r; mypos[tid] = pos;
    P.perm[b * 128 + tid] = pos; P.sidx[pos] = b * 128 + tid; P.cws[(size_t)pos * 2] = P.cw[(b * 128 + tid) * 2]; P.cws[(size_t)pos * 2 + 1] = P.cw[(b * 128 + tid) * 2 + 1]; }
  __syncthreads();
  { typedef unsigned su32x4 __attribute__((ext_vector_type(4))); su32x4 t[16];
#pragma unroll
    for (int i = 0; i < 16; ++i) { const int idx = tid + 512 * i, r = idx >> 6, cc = idx & 63; t[i] = *(const su32x4*)(P.h2q + (size_t)(b * 128 + r) * D + cc * 16); }
#pragma unroll
    for (int i = 0; i < 16; ++i) { const int idx = tid + 512 * i, r = idx >> 6, cc = idx & 63; *(su32x4*)(P.h2qs + (size_t)mypos[r] * D + cc * 16) = t[i]; } }
  if (b < NCLS) {
    const int r0 = cstart[b] + tot[b], r1 = cstart[b + 1];
    for (int i = tid; i < (r1 - r0) * 64; i += blockDim.x) *(uint4*)(P.h2qs + (size_t)(r0 + i / 64) * D + (i % 64) * 16) = make_uint4(0, 0, 0, 0);
    for (int i = tid; i < (r1 - r0); i += blockDim.x) { P.sidx[r0 + i] = 0; P.cws[(size_t)(r0 + i) * 2] = 0.f; P.cws[(size_t)(r0 + i) * 2 + 1] = 0.f; }
  }
  if (b == 0) {
    const int nt = cstart[NCLS] / 256;
    if (tid == 0) P.tileinfo[0] = nt;
    for (int t = tid; t < nt; t += blockDim.x) { int c = 0; while (c < NCLS - 1 && t * 256 >= cstart[c + 1]) ++c; P.tileinfo[1 + t] = c; }
  }
}

struct FinIn { uint2 x[4], m[4]; };
__device__ __forceinline__ void fin_load(const Params& P, int tok, int pos, int lane, FinIn& in) {
#pragma unroll
  for (int j = 0; j < 4; ++j) { const int k = j * 256 + lane * 4; in.x[j] = *(const uint2*)(P.x1 + (size_t)tok * D + k); in.m[j] = *(const uint2*)(P.moes + (size_t)pos * D + k); }
}
__device__ __forceinline__ void fin_row(const Params& P, int tok, int lane, const FinIn& in, const float4 (&g2)[4], const float4 (&lg)[4], const float4 (&lb)[4]) {
  float v[16];
#pragma unroll
  for (int j = 0; j < 4; ++j) {
    const uint2 xv = in.x[j], mv = in.m[j];
    v[4 * j] = ALPHA * __uint_as_float(xv.x << 16) + g2[j].x * __uint_as_float(mv.x << 16);
    v[4 * j + 1] = ALPHA * __uint_as_float(xv.x & 0xffff0000u) + g2[j].y * __uint_as_float(mv.x & 0xffff0000u);
    v[4 * j + 2] = ALPHA * __uint_as_float(xv.y << 16) + g2[j].z * __uint_as_float(mv.y << 16);
    v[4 * j + 3] = ALPHA * __uint_as_float(xv.y & 0xffff0000u) + g2[j].w * __uint_as_float(mv.y & 0xffff0000u);
  }
  float s = 0.f;
#pragma unroll
  for (int j = 0; j < 16; ++j) s += v[j];
  const float mean = wave_sum(s) * (1.f / 1024.f);
  float q = 0.f;
#pragma unroll
  for (int j = 0; j < 16; ++j) { const float dd = v[j] - mean; q += dd * dd; }
  const float rstd = rsqrtf(wave_sum(q) * (1.f / 1024.f) + 1e-5f);
#pragma unroll
  for (int j = 0; j < 4; ++j) {
    float4 o;
    o.x = (v[4 * j] - mean) * rstd * lg[j].x + lb[j].x; o.y = (v[4 * j + 1] - mean) * rstd * lg[j].y + lb[j].y;
    o.z = (v[4 * j + 2] - mean) * rstd * lg[j].z + lb[j].z; o.w = (v[4 * j + 3] - mean) * rstd * lg[j].w + lb[j].w;
    *(float4*)(P.out + (size_t)tok * D + j * 256 + lane * 4) = o;
  }
}
__device__ void phase_final(const Params& P) {
  const int tid_ = opaque_tid(); const int lane = tid_ & 63, wv = (blockIdx.x * blockDim.x + tid_) >> 6;
  const int tok0 = wv * 16;
  const float* md = P.mod + (tok0 / SEQ) * 6144;
  float4 g2[4], lg[4], lb[4];
#pragma unroll
  for (int j = 0; j < 4; ++j) { const int k = j * 256 + lane * 4; g2[j] = *(const float4*)(md + 5120 + k); lg[j] = *(const float4*)(P.ln2_g + k); lb[j] = *(const float4*)(P.ln2_b + k); }
  const int posl = P.perm[tok0 + (lane & 15)];
  FinIn inA, inB;
  fin_load(P, tok0, __shfl(posl, 0), lane, inA); fin_load(P, tok0 + 1, __shfl(posl, 1), lane, inB);
#pragma unroll 1
  for (int i = 0; i < 16; i += 2) {
    FinIn cA = inA, cB = inB;
    if (i + 2 < 16) { fin_load(P, tok0 + i + 2, __shfl(posl, i + 2), lane, inA); fin_load(P, tok0 + i + 3, __shfl(posl, i + 3), lane, inB); }
    fin_row(P, tok0 + i, lane, cA, g2, lg, lb); fin_row(P, tok0 + i + 1, lane, cB, g2, lg, lb);
  }
}

extern __shared__ __attribute__((aligned(16))) unsigned char dyn_lds[];

#define XB_TMO      128
#define XB_XCNT(j)  (256  + 64 * (j))
#define XB_XSUB(j)  (1280 + 64 * (j))
#define XB_XGEN(j)  (2304 + 64 * (j))
#define XB_TOP      3328
#define XB_TOPGEN   3392
#define XCD_BAR_WORDS 3456
#define XB_SPIN_CAP (1u << 22)
#define XLAS __attribute__((address_space(3)))
__device__ __forceinline__ unsigned xb_ld(unsigned* p)              { return __hip_atomic_load(p, __ATOMIC_RELAXED, __HIP_MEMORY_SCOPE_AGENT); }
__device__ __forceinline__ unsigned xb_add(unsigned* p, unsigned v) { return __hip_atomic_fetch_add(p, v, __ATOMIC_RELAXED, __HIP_MEMORY_SCOPE_AGENT); }
__device__ __forceinline__ unsigned xb_xcc_id() { return (unsigned)__builtin_amdgcn_s_getreg((3 << 11) | 20) & 0xFu; }
#define XB_SPIN(cond, bar) do { unsigned _sp = 0; while (cond) { __builtin_amdgcn_s_sleep(1); \
    if ((++_sp & 255u) == 0u) { if (xb_ld(&(bar)[XB_TMO])) break; if (_sp > XB_SPIN_CAP) { atomicAdd(&(bar)[XB_TMO], 1u); break; } } } } while (0)
struct XcdBarrier { unsigned* bar; unsigned x; volatile XLAS unsigned* st; };
__device__ __forceinline__ XcdBarrier xcd_barrier_post(unsigned* bar, volatile XLAS unsigned* st) {
    XcdBarrier b; b.bar = bar; b.x = xb_xcc_id(); b.st = st;
    if (threadIdx.x == 0) (void)xb_add(&bar[XB_XCNT(b.x)], 1u);
    return b;
}
__device__ __forceinline__ void xcd_barrier_complete(unsigned* bar, unsigned x, unsigned& nloc, unsigned& nx) {
    const unsigned G = gridDim.x * gridDim.y * gridDim.z;
    unsigned sum, cnt, mine, sp = 0u;
    for (;;) {
        sum = 0u; cnt = 0u; mine = 0u;
#pragma unroll
        for (unsigned j = 0; j < 16; ++j) { const unsigned c = xb_ld(&bar[XB_XCNT(j)]); sum += c; cnt += (c > 0u) ? 1u : 0u; mine = (j == x) ? c : mine; }
        if (sum == G) break;
        __builtin_amdgcn_s_sleep(1);
        if ((++sp & 255u) == 0u) { if (xb_ld(&bar[XB_TMO])) break; if (sp > XB_SPIN_CAP) { atomicAdd(&bar[XB_TMO], 1u); break; } }
    }
    nloc = mine > 0u ? mine : 1u; nx = cnt > 0u ? cnt : 1u;
}
__device__ __forceinline__ void xcd_barrier(const XcdBarrier& b) {
    asm volatile("s_waitcnt vmcnt(0)" ::: "memory");
    __syncthreads();
    if (opaque_tid() == 0) {
        unsigned* bar = b.bar;
        __builtin_amdgcn_s_waitcnt(0);
        unsigned nloc = b.st[0], nx = b.st[1];
        if (nloc == 0u) { xcd_barrier_complete(bar, b.x, nloc, nx); b.st[0] = nloc; b.st[1] = nx; }
        const unsigned old = xb_add(&bar[XB_XSUB(b.x)], 1u);
        const unsigned gen = old / nloc;
        if (old + 1u == (gen + 1u) * nloc) {
            __builtin_amdgcn_fence(__ATOMIC_RELEASE, "agent");
            asm volatile("s_waitcnt vmcnt(0)" ::: "memory");
            const unsigned og = xb_add(&bar[XB_TOP], 1u);
            const unsigned tg = og / nx;
            if (og + 1u == (tg + 1u) * nx) xb_add(&bar[XB_TOPGEN], 1u);
            else XB_SPIN(xb_ld(&bar[XB_TOPGEN]) == tg, bar);
            __builtin_amdgcn_fence(__ATOMIC_ACQUIRE, "agent");
            xb_add(&bar[XB_XGEN(b.x)], 1u);
            asm volatile("s_waitcnt vmcnt(0)" ::: "memory");
        } else {
            XB_SPIN(xb_ld(&bar[XB_XGEN(b.x)]) == gen, bar);
            __builtin_amdgcn_fence(__ATOMIC_ACQUIRE, "agent");
            asm volatile("s_waitcnt vmcnt(0)" ::: "memory");
        }
    }
    __syncthreads();
}

#ifndef REP_PRE
#define REP_PRE 1
#endif
#ifndef REP_HLN
#define REP_HLN 1
#endif
#ifndef REP_GEMM
#define REP_GEMM 1
#endif
#ifndef REP_GLAA
#define REP_GLAA 1
#endif
#ifndef REP_GLAB
#define REP_GLAB 1
#endif
#ifndef REP_CONV
#define REP_CONV 1
#endif
#ifndef REP_LN1
#define REP_LN1 1
#endif
#ifndef REP_SORT
#define REP_SORT 1
#endif
#ifndef REP_FIN
#define REP_FIN 1
#endif
#ifndef REP_BAR
#define REP_BAR 1
#endif
#define RUN_1(x) do { x; __syncthreads(); } while (0)
#define RUN_2(x) do { x; __syncthreads(); x; __syncthreads(); } while (0)
#define RUN_3(x) do { x; __syncthreads(); x; __syncthreads(); x; __syncthreads(); } while (0)
#define RUN__(n, x) RUN_##n(x)
#define RUN(n, x) RUN__(n, x)
#define GBAR() do { for (int _r = 0; _r < REP_BAR; ++_r) { XcdBarrier _b; _b.bar = P.ctrl; _b.x = xb_xcc_id(); _b.st = (volatile XLAS unsigned*)((XLAS unsigned char*)dyn_lds + MEGA_LDS - 16); xcd_barrier(_b); } } while (0)
__global__ __launch_bounds__(512, 2) void mega(Params P) {
  XLAS unsigned* stw = (XLAS unsigned*)((XLAS unsigned char*)dyn_lds + MEGA_LDS - 16);
  if (threadIdx.x < 4) stw[threadIdx.x] = 0u;
  if ((threadIdx.x & 63) == 0) { const unsigned hw = (unsigned)__builtin_amdgcn_s_getreg((6 << 11) | 4) & 63u; *(XLAS int*)((XLAS unsigned char*)dyn_lds + TIDTAB_OFF + hw * 4) = (int)(threadIdx.x >> 6); }
  __syncthreads();
  (void)xcd_barrier_post(P.ctrl, (volatile XLAS unsigned*)stw);
  RUN(REP_PRE, phase_pre(P, (float*)dyn_lds));
  GBAR();
  RUN(REP_HLN, phase_hln(P, (HLAS unsigned char*)dyn_lds));
  GBAR();
  for (int stage = 0; stage < 2; ++stage) {
    if (((stage ^ (int)(blockIdx.x >> 3)) & 1) == 0) { RUN(REP_GEMM, phase_gemm1(P, (PG8_LAS unsigned char*)dyn_lds)); }
    else { RUN(REP_GEMM, phase_ctx_proj(P)); }
  }
  GBAR();
  for (int stage = 0; stage < 2; ++stage) {
    if (((stage ^ (int)(blockIdx.x >> 3)) & 1) == 0) { RUN(REP_GLAA, gla::pass_a(P, (gla::ldsp)dyn_lds)); }
    else { RUN(REP_CONV, phase_conv(P)); }
  }
  GBAR();
  RUN(REP_GLAB, gla::pass_b(P, (gla::ldsp)dyn_lds));
  GBAR();
  RUN(REP_GEMM, phase_gemm2(P, (PG8_LAS unsigned char*)dyn_lds));
  GBAR();
  RUN(REP_LN1, phase_ln1_router(P, (float*)dyn_lds));
  GBAR();
  RUN(REP_GEMM, phase_moe_up(P, (PG8_LAS unsigned char*)dyn_lds));
  RUN(REP_GEMM, phase_moe_down(P, (PG8_LAS unsigned char*)dyn_lds));
  GBAR();
  RUN(REP_FIN, phase_final(P));
}

static inline size_t al256(size_t v) { return (v + 255) & ~(size_t)255; }

extern "C" void kernel_launch(void* const* d_in, const int* in_sizes, int n_in, void* d_out, int out_size, void* d_ws, size_t ws_size, hipStream_t stream) {
  Params P{};
  const float* const* in = (const float* const*)d_in;
  P.x = in[0]; P.c = in[1]; P.ctx = in[2]; P.c_ctx = in[3]; P.ln_in_g = in[4]; P.ln_in_b = in[5]; P.w_ada = in[6]; P.b_ada = in[7]; P.w_in = in[8];
  P.conv_w = in[9]; P.conv_b = in[10]; P.gw_f = in[11]; P.gb_f = in[12]; P.gw_b = in[13]; P.gb_b = in[14]; P.gla_g = in[15]; P.w_out = in[16];
  P.ln1_g = in[17]; P.ln1_b = in[18]; P.wgr = in[19]; P.bgr = in[20]; P.wer = in[21]; P.ber = in[22]; P.w1 = in[23]; P.w3 = in[24]; P.w2 = in[25];
  P.ln2_g = in[26]; P.ln2_b = in[27];
  P.out = (float*)d_out;
  unsigned char* w = (unsigned char*)d_ws; size_t off = 0;
  auto take = [&](size_t bytes) { unsigned char* r = w + off; off = al256(off + bytes); return r; };
  P.ctrl = (unsigned*)take(65536);
  P.mod = (float*)take(9 * 6144 * 4);
  P.WinT = (bf16_t*)take((size_t)3072 * 1024 * 2);
  P.WgT = (bf16_t*)take((size_t)256 * 1024 * 2);
  P.WoutT = (bf16_t*)take((size_t)1024 * 1024 * 2);
  P.W13Q = (unsigned char*)take((size_t)16 * 1024 * 1024);
  P.W2Q = (unsigned char*)take((size_t)16 * 1024 * 512);
  P.h2q = (unsigned char*)take((size_t)NTOK * D);
  P.h2qs = (unsigned char*)take((size_t)MOE_ROWS * D);
  P.actq = (unsigned char*)take((size_t)MOE_ROWS * D);
  P.gqd = (bf16_t*)P.h2q; P.gkinv = P.gqd + (size_t)2 * NTOK * 256; P.gke = P.gkinv + (size_t)2 * NTOK * 256;
  P.hc = (bf16_t*)take((size_t)NCTX * D * 2);
  P.stats = (float*)take((size_t)NTOK * 2 * 4);
  P.low = (float*)take((size_t)(NTOK + NCTX) * 32 * 4);
  P.pctx = (bf16_t*)take((size_t)NCTX * 1024 * 2);
  P.cls = (int*)take((size_t)NTOK * 4);
  P.cw = (float*)take((size_t)NTOK * 2 * 4);
  P.hist = (int*)take(256 * NCLS * 4);
  P.perm = (int*)take((size_t)NTOK * 4);
  P.sidx = (int*)take((size_t)MOE_ROWS * 4);
  P.tileinfo = (int*)take(1024);
  P.cws = (float*)take((size_t)MOE_ROWS * 2 * 4);
  P.gdec = (float*)take((size_t)2 * 512 * 4 * 64 * 4);
  P.Useg = (float*)take((size_t)512 * 8192 * 4);
  P.Dseg = (float*)take((size_t)512 * 64 * 4);
  P.hln = (bf16_t*)take((size_t)NTOK * D * 2); P.ymix = P.hln;
  P.p = (bf16_t*)take((size_t)NTOK * NP * 2);
  P.ybuf = P.p; P.x1 = P.p + (size_t)NTOK * D; P.h2 = P.p + (size_t)2 * NTOK * D;
  P.h2s = (bf16_t*)take((size_t)MOE_ROWS * D * 2); P.moes = P.h2s; P.opart = P.h2s; P.ctxS = (float*)P.h2s;
  if (off > ws_size) { fprintf(stderr, "workspace too small: need %zu have %zu\n", off, ws_size); return; }
  static bool said = false; if (!said) { said = true; fprintf(stderr, "workspace: need %zu have %zu\n", off, ws_size); }

  static int ready = 0;
  if (!ready) {
    if (hipFuncSetAttribute((const void*)mega, hipFuncAttributeMaxDynamicSharedMemorySize, MEGA_LDS) != hipSuccess) { fprintf(stderr, "hipFuncSetAttribute failed\n"); ready = -1; return; }
    int dev = 0, cus = 0, per_cu = 0;
    (void)hipGetDevice(&dev); (void)hipDeviceGetAttribute(&cus, hipDeviceAttributeMultiprocessorCount, dev);
    (void)hipOccupancyMaxActiveBlocksPerMultiprocessor(&per_cu, (const void*)mega, 512, MEGA_LDS);
    if (cus < 256 || per_cu < 1) { fprintf(stderr, "mega: needs 256 CUs with one resident block each (cus %d, per_cu %d)\n", cus, per_cu); ready = -1; return; }
    ready = 1;
  }
  if (ready < 0) return;
  (void)hipMemsetAsync(P.ctrl, 0, 65536, stream);
  void* args[] = {&P};
  hipError_t e = hipLaunchCooperativeKernel((const void*)mega, dim3(256), dim3(512), args, MEGA_LDS, stream);
  if (e != hipSuccess) fprintf(stderr, "cooperative launch failed: %s\n", hipGetErrorString(e));
}
```

```cpp
#include <hip/hip_runtime.h>
#include <stdint.h>
#include <stdio.h>

typedef unsigned short bf16_t;
constexpr int D = 1024, NB = 8, SEQ = 4096, NTOK = NB * SEQ, CTXL = 256, NCTX = NB * CTXL;
constexpr int DPROJ = 3104, NP = 3072;
constexpr int OFF_AB = 0, OFF_AC = 512, OFF_AX = 1024, OFF_Q = 1536, OFF_K = 1792, OFF_V = 2048, OFF_R = 2560;
constexpr int NCLS = 24, MOE_ROWS = NTOK + NCLS * 256, MOE_TILES = MOE_ROWS / 256;
constexpr float ALPHA = 1.189207115002721f;

struct Params {
  const float *x, *c, *ctx, *c_ctx, *ln_in_g, *ln_in_b, *w_ada, *b_ada, *w_in, *conv_w, *conv_b, *gw_f, *gb_f, *gw_b, *gb_b, *gla_g, *w_out,
      *ln1_g, *ln1_b, *wgr, *bgr, *wer, *ber, *w1, *w3, *w2, *ln2_g, *ln2_b;
  float* out;
  unsigned* ctrl;
  float* mod;
  bf16_t* WinT;
  bf16_t* WgT;
  bf16_t* WoutT;
  unsigned char* W13Q;
  unsigned char* W2Q;
  unsigned char* h2q;
  unsigned char* h2qs;
  unsigned char* actq;
  bf16_t* hln;
  bf16_t* hc;
  float* stats;
  float* low;
  bf16_t* p;
  bf16_t* pctx;
  float* ctxS;
  bf16_t* ymix;
  bf16_t* ybuf;
  bf16_t* x1;
  bf16_t* h2;
  int* cls;
  float* cw;
  int* hist;
  int* perm;
  int* sidx;
  int* tileinfo;
  float* cws;
  bf16_t* h2s;
  bf16_t* act;
  bf16_t* moes;
  bf16_t* gqd;
  bf16_t* gkinv;
  bf16_t* gke;
  float* gdec;
  float* Useg;
  float* Dseg;
  bf16_t* opart;
  float* o_f;
  float* o_b;
};

constexpr int MEGA_LDS = 160 * 1024, TIDTAB_OFF = MEGA_LDS - 16 - 256;
__device__ __forceinline__ int opaque_tid() {
  const unsigned hw = (unsigned)__builtin_amdgcn_s_getreg((6 << 11) | 4) & 63u;
  int lane; asm volatile("v_mbcnt_lo_u32_b32 %0, -1, 0\n\tv_mbcnt_hi_u32_b32 %0, -1, %0" : "=v"(lane));
  int wid = *(const __attribute__((address_space(3))) int*)(TIDTAB_OFF + hw * 4);
  wid = __builtin_amdgcn_readfirstlane(wid);
  int t = wid * 64 + lane; asm volatile("" : "+v"(t)); return t;
}
__device__ __forceinline__ float bf2f(bf16_t v) { return __uint_as_float(((unsigned)v) << 16); }
__device__ __forceinline__ bf16_t f2bf(float f) { return __builtin_bit_cast(bf16_t, (__bf16)f); }
typedef __bf16 bf16v2_t __attribute__((ext_vector_type(2)));
typedef float f32v2_t __attribute__((ext_vector_type(2)));
__device__ __forceinline__ unsigned pack2(float a, float b) { const f32v2_t v = {a, b}; return __builtin_bit_cast(unsigned, __builtin_convertvector(v, bf16v2_t)); }
__device__ __forceinline__ unsigned pack4_fp8(float a, float b, float c, float d) {
  a = __builtin_amdgcn_fmed3f(a, -448.f, 448.f); b = __builtin_amdgcn_fmed3f(b, -448.f, 448.f); c = __builtin_amdgcn_fmed3f(c, -448.f, 448.f); d = __builtin_amdgcn_fmed3f(d, -448.f, 448.f);
  unsigned w = 0; w = __builtin_amdgcn_cvt_pk_fp8_f32(a, b, w, false); w = __builtin_amdgcn_cvt_pk_fp8_f32(c, d, w, true); return w;
}
__device__ __forceinline__ float wave_sum(float v) {
#define DPP_ADD_(ctrl, rmask) v += __int_as_float(__builtin_amdgcn_update_dpp(0, __float_as_int(v), ctrl, rmask, 0xF, true))
  DPP_ADD_(0xB1, 0xF); DPP_ADD_(0x4E, 0xF); DPP_ADD_(0x141, 0xF); DPP_ADD_(0x140, 0xF); DPP_ADD_(0x142, 0xA); DPP_ADD_(0x143, 0xC);
#undef DPP_ADD_
  return __int_as_float(__builtin_amdgcn_readlane(__float_as_int(v), 63));
}
__device__ __forceinline__ float siluf(float v) { return v * __builtin_amdgcn_rcpf(1.f + __expf(-v)); }
__device__ __forceinline__ float logsigmoidf(float z) { return fminf(z, 0.f) - log1pf(__expf(-fabsf(z))); }
__device__ __forceinline__ float logsigmoid_fast(float z) { return fminf(z, 0.f) - 0.6931471806f * __builtin_amdgcn_logf(1.f + __builtin_amdgcn_exp2f(-1.4426950409f * fabsf(z))); }

__device__ __forceinline__ int rowmap(int n, int mode) { return mode == 0 ? n : ((n >> 7) * 256 + (mode == 2 ? 128 : 0) + (n & 127)); }
struct CvJob { const float* src; bf16_t* dst; int ld_src, k0, n0, nvalid, nbase, ldd, mode, q8; };
__device__ __forceinline__ void cv_decode(const Params& P, int ti, CvJob& j) {
  j.nvalid = 64; j.nbase = 0; j.mode = 0; j.q8 = 0;
  if (ti < 384) { const int kt = ti % 8, nt = ti / 8; j.src = P.w_in; j.ld_src = DPROJ; j.k0 = kt * 128; j.n0 = nt * 64; j.dst = P.WinT; j.ldd = 1024;
    if (j.n0 >= OFF_AC && j.n0 < OFF_AX + 512) { const int isx = j.n0 >= OFF_AX, c = j.n0 - (isx ? OFF_AX : OFF_AC); j.nbase = j.n0 - ((2 + (c >> 7)) * 256 + isx * 128 + (c & 127)); } }
  else if (ti < 392) { const int kt = ti - 384; j.src = P.w_in; j.ld_src = DPROJ; j.k0 = kt * 128; j.n0 = 3072; j.nvalid = 32; j.nbase = 3072; j.dst = P.WgT; j.ldd = 1024; }
  else if (ti < 520) { const int t = ti - 392, kt = t % 8, nt = t / 8; j.src = P.w_out; j.ld_src = 1024; j.k0 = kt * 128; j.n0 = nt * 64; j.dst = P.WoutT; j.ldd = 1024; }
  else if (ti < 2568) { const int t = ti - 520, e = t / 128, r = t % 128, which = r / 64, r2 = r % 64, kt = r2 % 8, nt = r2 / 8;
    j.src = (which ? P.w3 : P.w1) + (size_t)e * 1024 * 512; j.ld_src = 512; j.k0 = kt * 128; j.n0 = nt * 64; j.dst = (bf16_t*)(P.W13Q + (size_t)e * 1024 * 1024); j.ldd = 1024; j.mode = 1 + which; j.q8 = 1; }
  else { const int t = ti - 2568, e = t / 64, r = t % 64, kt = r % 4, nt = r / 4; j.src = P.w2 + (size_t)e * 512 * 1024; j.ld_src = 1024; j.k0 = kt * 128; j.n0 = nt * 64; j.dst = (bf16_t*)(P.W2Q + (size_t)e * 1024 * 512); j.ldd = 512; j.q8 = 1; }
}
typedef float cvf4 __attribute__((ext_vector_type(4)));
__device__ __forceinline__ void cv_load(const CvJob& j, int tid, cvf4 (&r)[4]) {
  if (j.q8) { const int kq = (tid >> 2) & 31, n4 = 4 * ((tid & 3) + 4 * (tid >> 7)); const float* p = j.src + (size_t)(j.k0 + 4 * kq) * j.ld_src + j.n0 + n4;
#pragma unroll
    for (int i = 0; i < 4; ++i) r[i] = *(const cvf4*)(p + (size_t)i * j.ld_src);
    return; }
  const int kp = (tid >> 2) & 63;
#pragma unroll
  for (int i = 0; i < 2; ++i) { const int n4 = 4 * ((tid & 3) + 4 * ((tid >> 8) & 1) + 8 * i);
    if (n4 < j.nvalid) { const float* p = j.src + (size_t)(j.k0 + 2 * kp) * j.ld_src + j.n0 + n4; r[2 * i] = *(const cvf4*)p; r[2 * i + 1] = *(const cvf4*)(p + j.ld_src); } else { r[2 * i] = (cvf4){0.f, 0.f, 0.f, 0.f}; r[2 * i + 1] = r[2 * i]; } }
}
__device__ __forceinline__ void cv_to_lds(const CvJob& j, int tid, const cvf4 (&r)[4], bf16_t* T) {
  if (j.q8) { const int kq = (tid >> 2) & 31, n4 = 4 * ((tid & 3) + 4 * (tid >> 7)); unsigned* t = (unsigned*)((unsigned char*)T + n4 * 144 + 4 * kq);
#pragma unroll
    for (int c = 0; c < 4; ++c) t[36 * c] = pack4_fp8(r[0][c] * 8.f, r[1][c] * 8.f, r[2][c] * 8.f, r[3][c] * 8.f);
    return; }
  const int kp = (tid >> 2) & 63;
#pragma unroll
  for (int i = 0; i < 2; ++i) { const int n4 = 4 * ((tid & 3) + 4 * ((tid >> 8) & 1) + 8 * i);
    if (n4 < j.nvalid) { unsigned* t = (unsigned*)(T + n4 * 136 + 2 * kp);
      t[0] = pack2(r[2 * i][0], r[2 * i + 1][0]); t[68] = pack2(r[2 * i][1], r[2 * i + 1][1]); t[136] = pack2(r[2 * i][2], r[2 * i + 1][2]); t[204] = pack2(r[2 * i][3], r[2 * i + 1][3]); } }
}
__device__ __forceinline__ void cv_store(const CvJob& j, int tid, const bf16_t* T) {
  if (j.q8) { const int n = tid >> 3, kc = (tid & 7) * 16;
    *(uint4*)((unsigned char*)j.dst + (size_t)rowmap(j.n0 + n, j.mode) * j.ldd + j.k0 + kc) = *(const uint4*)((const unsigned char*)T + n * 144 + kc); return; }
#pragma unroll
  for (int i = 0; i < 2; ++i) { const int cidx = tid + 512 * i, n = cidx / 16, kc = (cidx % 16) * 8;
    if (n < j.nvalid) *(uint4*)(j.dst + (size_t)rowmap(j.n0 - j.nbase + n, j.mode) * j.ldd + j.k0 + kc) = *(const uint4*)(T + n * 136 + kc); }
}
__device__ void phase_pre(const Params& P, float* lds) {
  float* s = lds; float* red = lds + 9 * 1024;
  const int tid = opaque_tid();
  const int cg = tid % 6, kg = tid / 6, g0 = blockIdx.x * 6;
  cvf4 w[13];
  if (kg < 85) {
#pragma unroll
    for (int i = 0; i < 13; ++i) { const int k = kg + 85 * i; w[i] = (k < 1024) ? *(const cvf4*)(P.w_ada + (size_t)k * 6144 + (size_t)(g0 + cg) * 4) : (cvf4){0.f, 0.f, 0.f, 0.f}; }
  } else {
#pragma unroll
    for (int i = 0; i < 13; ++i) w[i] = (cvf4){0.f, 0.f, 0.f, 0.f};
  }
  CvJob job; cvf4 r[4]; int ti = blockIdx.x;
  cv_decode(P, ti, job); cv_load(job, tid, r);
  for (int i = tid; i < 9 * 1024; i += 512) { const float v = (i < 8 * 1024) ? P.c[i] : P.c_ctx[i - 8192]; s[i] = siluf(v); }
  __syncthreads();
  if (kg < 85) {
    float a[9][4];
#pragma unroll
    for (int rr = 0; rr < 9; ++rr) { a[rr][0] = a[rr][1] = a[rr][2] = a[rr][3] = 0.f; }
#pragma unroll
    for (int i = 0; i < 13; ++i) { const int k = kg + 85 * i; if (k < 1024) {
#pragma unroll
        for (int rr = 0; rr < 9; ++rr) { const float sv = s[rr * 1024 + k]; a[rr][0] += sv * w[i][0]; a[rr][1] += sv * w[i][1]; a[rr][2] += sv * w[i][2]; a[rr][3] += sv * w[i][3]; } } }
#pragma unroll
    for (int rr = 0; rr < 9; ++rr)
#pragma unroll
      for (int jj = 0; jj < 4; ++jj) red[kg * 216 + rr * 24 + cg * 4 + jj] = a[rr][jj];
  }
  __syncthreads();
  if (tid < 216) { float t = 0.f; for (int kk = 0; kk < 85; ++kk) t += red[kk * 216 + tid]; const int rr = tid / 24, cc = tid % 24, col = g0 * 4 + cc; P.mod[rr * 6144 + col] = t + P.b_ada[col]; }
  __syncthreads();
  bf16_t* T = (bf16_t*)lds;
  while (ti < 520) {
    cv_to_lds(job, tid, r, T);
    const int tn = ti + gridDim.x;
    CvJob nj = job; cvf4 rn[4] = {r[0], r[1], r[2], r[3]};
    if (tn < 520) { cv_decode(P, tn, nj); cv_load(nj, tid, rn); }
    __syncthreads();
    cv_store(job, tid, T);
    __syncthreads();
    job = nj; r[0] = rn[0]; r[1] = rn[1]; r[2] = rn[2]; r[3] = rn[3];
    ti = tn;
  }
  uint4* z = (uint4*)(P.WgT + 32 * 1024);
  for (int i = blockIdx.x * 512 + tid; i < 224 * 1024 / 8; i += gridDim.x * 512) z[i] = make_uint4(0, 0, 0, 0);
}

__device__ void phase_cvx(const Params& P, float* lds) {
  const int tid = opaque_tid();
  bf16_t* T = (bf16_t*)lds;
  int ti = 520 + blockIdx.x;
  CvJob job; cvf4 r[4];
  cv_decode(P, ti, job); cv_load(job, tid, r);
  __syncthreads();
  while (ti < 3592) {
    cv_to_lds(job, tid, r, T);
    const int tn = ti + gridDim.x;
    CvJob nj = job; cvf4 rn[4] = {r[0], r[1], r[2], r[3]};
    if (tn < 3592) { cv_decode(P, tn, nj); cv_load(nj, tid, rn); }
    __syncthreads();
    cv_store(job, tid, T);
    __syncthreads();
    job = nj; r[0] = rn[0]; r[1] = rn[1]; r[2] = rn[2]; r[3] = rn[3];
    ti = tn;
  }
}

namespace hl {
typedef short bf16x8 __attribute__((ext_vector_type(8)));
typedef float f32x4 __attribute__((ext_vector_type(4)));
typedef unsigned u32x4 __attribute__((ext_vector_type(4)));
#define HLAS __attribute__((address_space(3)))
constexpr int WST = 2064;
__device__ __forceinline__ void ln_row(const float* src, const HLAS float* GB, bf16_t* dst, float* stats, int lane) {
    float v[16];
#pragma unroll
    for (int j = 0; j < 4; ++j) { const float4 t = *(const float4*)(src + j * 256 + lane * 4); v[4 * j] = t.x; v[4 * j + 1] = t.y; v[4 * j + 2] = t.z; v[4 * j + 3] = t.w; }
    float s = 0.f;
#pragma unroll
    for (int j = 0; j < 16; ++j) s += v[j];
    const float mean = wave_sum(s) * (1.f / 1024.f);
    float q = 0.f;
#pragma unroll
    for (int j = 0; j < 16; ++j) { const float d = v[j] - mean; q += d * d; }
    const float rstd = rsqrtf(wave_sum(q) * (1.f / 1024.f) + 1e-5f);
    if (stats && lane == 0) { stats[0] = mean; stats[1] = rstd; }
#pragma unroll
    for (int j = 0; j < 4; ++j) {
        const int k = j * 256 + lane * 4;
        const f32x4 g = *(const HLAS f32x4*)(GB + k), bb = *(const HLAS f32x4*)(GB + 1024 + k);
        const float h0 = (v[4 * j] - mean) * rstd * g[0] + bb[0], h1 = (v[4 * j + 1] - mean) * rstd * g[1] + bb[1];
        const float h2 = (v[4 * j + 2] - mean) * rstd * g[2] + bb[2], h3 = (v[4 * j + 3] - mean) * rstd * g[3] + bb[3];
        uint2 w; w.x = pack2(h0, h1); w.y = pack2(h2, h3); *(uint2*)(dst + k) = w;
    }
}
}
__device__ void phase_hln(const Params& P, HLAS unsigned char* lds) {
    const int tid = opaque_tid(), lane = tid & 63, wid = tid >> 6;
    { hl::u32x4 wt[8];
#pragma unroll
      for (int u = 0; u < 8; ++u) { const int i = tid + 512 * u, n = i >> 7, c = i & 127; wt[u] = *(const hl::u32x4*)(P.WgT + (size_t)n * 1024 + c * 8); }
#pragma unroll
      for (int u = 0; u < 8; ++u) { const int i = tid + 512 * u, n = i >> 7, c = i & 127; *(HLAS hl::u32x4*)(lds + n * hl::WST + c * 16) = wt[u]; } }
    const int R0 = blockIdx.x * 128 + wid * 16;
    HLAS float* GB = (HLAS float*)(lds + 32 * hl::WST);
    { float lsc[4], lsh[4], lg_[4], lb_[4];
#pragma unroll
      for (int u = 0; u < 4; ++u) { const int i = tid + 512 * u, which = i >> 10, k = i & 1023; const float* md = P.mod + (which ? 8 : R0 / SEQ) * 6144; lsc[u] = md[1024 + k]; lsh[u] = md[k]; lg_[u] = P.ln_in_g[k]; lb_[u] = P.ln_in_b[k]; }
#pragma unroll
      for (int u = 0; u < 4; ++u) { const int i = tid + 512 * u, which = i >> 10, k = i & 1023; const float sc1 = 1.f + lsc[u]; GB[which * 2048 + k] = lg_[u] * sc1; GB[which * 2048 + 1024 + k] = lb_[u] * sc1 + lsh[u]; } }
    __syncthreads();
    for (int rr = 0; rr < 16; ++rr) { const int row = R0 + rr; hl::ln_row(P.x + (size_t)row * D, GB, P.hln + (size_t)row * D, P.stats + row * 2, lane); }
    { const int crow = blockIdx.x * 8 + wid; hl::ln_row(P.ctx + (size_t)crow * D, GB + 2048, P.hc + (size_t)crow * D, nullptr, lane); }
    asm volatile("s_waitcnt vmcnt(0)" ::: "memory");
    __syncthreads();
    const int r16 = lane & 15, q = lane >> 4;
    hl::f32x4 a0 = {0.f, 0.f, 0.f, 0.f}, a1 = {0.f, 0.f, 0.f, 0.f};
    const bf16_t* arow = P.hln + (size_t)(R0 + r16) * D + 8 * q;
#pragma unroll 8
    for (int ks = 0; ks < 32; ++ks) {
        const hl::bf16x8 a = *(const hl::bf16x8*)(arow + 32 * ks);
        const hl::bf16x8 b0 = *(const HLAS hl::bf16x8*)(lds + r16 * hl::WST + (32 * ks + 8 * q) * 2), b1 = *(const HLAS hl::bf16x8*)(lds + (16 + r16) * hl::WST + (32 * ks + 8 * q) * 2);
        a0 = __builtin_amdgcn_mfma_f32_16x16x32_bf16(a, b0, a0, 0, 0, 0); a1 = __builtin_amdgcn_mfma_f32_16x16x32_bf16(a, b1, a1, 0, 0, 0);
    }
#pragma unroll
    for (int j = 0; j < 4; ++j) { float* lp = P.low + (size_t)(R0 + 4 * q + j) * 32; lp[r16] = a0[j]; lp[16 + r16] = a1[j]; }
}

namespace pg8 {
#define PG8_LAS __attribute__((address_space(3)))
typedef short bf16x8 __attribute__((ext_vector_type(8)));
typedef float f32x4 __attribute__((ext_vector_type(4)));
typedef unsigned u32x4 __attribute__((ext_vector_type(4)));
constexpr int BM = 256, BK = 64, HALF = 128, HTB = HALF * BK * 2, STAGE_BYTES = 8 * HTB, NXCD = 8, WGM = 8;
__host__ __device__ __forceinline__ int lds_byte(int r, int c) { const int st = (r >> 4) * 2 + (c >> 5), rr = r & 15, cc = c & 31, ob = rr * 64 + cc * 2; return st * 1024 + (ob ^ (((ob >> 9) & 1) << 5)); }
__host__ __device__ __forceinline__ void stage_rc(int b, int& R, int& C) { const int st = b / 1024, sb = b % 1024, swz = sb ^ (((sb >> 9) & 1) << 5); R = (st >> 1) * 16 + swz / 64; C = (st & 1) * 32 + (swz % 64) / 2; }
__host__ __device__ __forceinline__ int perm32(int rho) { const int n = rho >> 4, i = rho & 15; return 8 * (i >> 2) + 4 * n + (i & 3); }
__device__ __forceinline__ unsigned cvt_pk_bf16(float lo, float hi) { unsigned r; asm volatile("v_cvt_pk_bf16_f32 %0, %1, %2" : "=v"(r) : "v"(lo), "v"(hi)); return r; }

template <class T> struct sched_waits { static constexpr bool v = false; };
template <class T> struct epi_publishes { static constexpr bool v = false; };
struct Unit { const char* A; const char* B; const char* B2; int pm, pn, aux; };
struct GemmCfg { int lda, ldb, nt, ksplit, ldb2, ksplit2; };

__device__ __forceinline__ void static_order(int L, int nM, int nN, int& pm, int& pn) {
    const int nwg = nM * nN; int wgid = L;
    { const int q = nwg / NXCD, r = nwg % NXCD, xcd = wgid % NXCD, off = wgid / NXCD; wgid = (xcd < r ? xcd * (q + 1) : r * (q + 1) + (xcd - r) * q) + off; }
    const int nig = WGM * nN, gid = wgid / nig, fm = gid * WGM, gsz = (nM - fm) < WGM ? (nM - fm) : WGM;
    pm = fm + ((wgid % nig) % gsz); pn = (wgid % nig) / gsz;
}

template <int MODE, bool FP8, class Epi, class Sched>
__device__ __forceinline__ void gemm_phase(PG8_LAS unsigned char* lds, const GemmCfg g, const Sched& S, const Epi& E) {
    const int tid = opaque_tid(), wid = __builtin_amdgcn_readfirstlane(tid >> 6), lane = tid & 63, wr = wid >> 2, wc = wid & 3, fr = lane & 15, fq = lane >> 4;
    typedef int pg8_i32x4 __attribute__((ext_vector_type(4))); typedef int pg8_i32x8 __attribute__((ext_vector_type(8)));
    constexpr bool GATHER = MODE == 1, MIXED = MODE == 2, WAITS = MIXED || sched_waits<Sched>::v, PUBL = epi_publishes<Epi>::v; constexpr int ES = FP8 ? 1 : 2;
    const int nt = g.nt;
    unsigned voffA[2], voffB[2], voffB2[2];
#pragma unroll
    for (int i = 0; i < 2; ++i) { int R, C; stage_rc(tid * 16 + i * 8192, R, C); const int Rb = (R & ~31) + perm32(R & 31);
        voffA[i] = (unsigned)(R * g.lda * ES + 2 * C); voffB[i] = (unsigned)(Rb * g.ldb * ES + 2 * C); voffB2[i] = (unsigned)(Rb * g.ldb2 * ES + 2 * C); }
    const PG8_LAS int* gidx = (const PG8_LAS int*)(lds + STAGE_BYTES);
    unsigned vAc[2][2], vAn[2][2];
#define PG8_GIDX(ui_, vo) do { _Pragma("unroll") for (int _i = 0; _i < 2; ++_i) { int _R, _C; stage_rc(tid * 16 + _i * 8192, _R, _C); _Pragma("unroll") for (int _h = 0; _h < 2; ++_h) \
        vo[_h][_i] = (unsigned)(gidx[(ui_) * 256 + _h * 128 + _R] * g.lda * ES + 2 * _C); } } while (0)
#define PG8_STAGE_A(bufoff, base, h, nx) do { if constexpr (GATHER) { unsigned _vo[2] = {(nx) ? vAn[h][0] : vAc[h][0], (nx) ? vAn[h][1] : vAc[h][1]}; PG8_STAGE(bufoff, base, _vo); } \
        else { PG8_STAGE(bufoff, (base) + (h) * hstepA, voffA); } } while (0)
    const size_t kstep = (size_t)(BK * 2);
    const size_t hstepA = (size_t)HALF * g.lda * ES, hstepB = (size_t)HALF * g.ldb * ES, hstepB2 = (size_t)HALF * g.ldb2 * ES;
    const unsigned ldsw = (unsigned)wid * 1024u;
    const int aoff = lds_byte(wr * 64 + fr, fq * 8), boff = lds_byte(wc * 32 + fr, fq * 8);
#define PG8_SA(b, h) (((b) * 2 + (h)) * HTB)
#define PG8_SB(b, h) ((4 + (b) * 2 + (h)) * HTB)
#define PG8_STAGE(bufoff, gbase, voff) do { _Pragma("unroll") for (int _i = 0; _i < 2; ++_i) { unsigned _o = (voff)[_i]; asm volatile("" : "+v"(_o));   \
        __builtin_amdgcn_global_load_lds((const unsigned*)((const char*)(gbase) + _o), (PG8_LAS unsigned*)(lds + (bufoff) + ldsw + _i * 8192), 16, 0, 0); } } while (0)
#define PG8_LDA(dst, b, h) do { if constexpr (FP8) { _Pragma("unroll") for (int m = 0; m < 4; ++m) { dst##q[m].lo = *(const PG8_LAS pg8_i32x4*)(lds + PG8_SA(b, h) + aoff + m * 2048); dst##q[m].hi = *(const PG8_LAS pg8_i32x4*)(lds + PG8_SA(b, h) + aoff + m * 2048 + 1024); } } \
        else { _Pragma("unroll") for (int m = 0; m < 4; ++m) _Pragma("unroll") for (int k = 0; k < 2; ++k) dst[m][k] = *(const PG8_LAS bf16x8*)(lds + PG8_SA(b, h) + aoff + m * 2048 + k * 1024); } } while (0)
#define PG8_LDB(dst, b, h) do { if constexpr (FP8) { _Pragma("unroll") for (int n = 0; n < 2; ++n) { dst##q[n].lo = *(const PG8_LAS pg8_i32x4*)(lds + PG8_SB(b, h) + boff + n * 2048); dst##q[n].hi = *(const PG8_LAS pg8_i32x4*)(lds + PG8_SB(b, h) + boff + n * 2048 + 1024); } } \
        else { _Pragma("unroll") for (int n = 0; n < 2; ++n) _Pragma("unroll") for (int k = 0; k < 2; ++k) dst[n][k] = *(const PG8_LAS bf16x8*)(lds + PG8_SB(b, h) + boff + n * 2048 + k * 1024); } } while (0)
#define PG8_CAT(v) (v)
#define PG8_MMA(ai, bj, At, Bt) do { __builtin_amdgcn_s_setprio(1); \
        if constexpr (FP8) { _Pragma("unroll") for (int m = 0; m < 4; ++m) _Pragma("unroll") for (int n = 0; n < 2; ++n) \
            acc[ai][bj][m][n] = __builtin_amdgcn_mfma_scale_f32_16x16x128_f8f6f4(Bt##q[n], At##q[m], acc[ai][bj][m][n], 0, 0, 0, 0x7c7c7c7c, 0, 0x7c7c7c7c); } \
        else { _Pragma("unroll") for (int m = 0; m < 4; ++m) _Pragma("unroll") for (int n = 0; n < 2; ++n) _Pragma("unroll") for (int k = 0; k < 2; ++k) \
            acc[ai][bj][m][n] = __builtin_amdgcn_mfma_f32_16x16x32_bf16(Bt[n][k], At[m][k], acc[ai][bj][m][n], 0, 0, 0); } \
        __builtin_amdgcn_s_setprio(0); } while (0)
#define PG8_WAIT_V(n) asm volatile("s_waitcnt vmcnt(" #n ")" ::: "memory")
#define PG8_WAIT_L(n) asm volatile("s_waitcnt lgkmcnt(" #n ")" ::: "memory")
#define PG8_BAR __builtin_amdgcn_s_barrier()
#define PG8_SCHED __builtin_amdgcn_sched_barrier(0)
#define PG8_KSP(u) ((MIXED && (u).aux) ? g.ksplit2 : g.ksplit)
#define PG8_BK(u, t) ((t) < PG8_KSP(u) ? (u).B + (size_t)(t) * kstep : (u).B2 + (size_t)((t) - PG8_KSP(u)) * kstep)
#define PG8_VB2(i_) (FP8 ? (((voffB[i_] & ~1023u) >> 1) + (voffB[i_] & 1023u)) : voffB2[i_])
#define PG8_STAGE_B(bufoff, base, h, kd) do { if constexpr (MIXED) { unsigned _vb[2] = {(kd) ? PG8_VB2(0) : voffB[0], (kd) ? PG8_VB2(1) : voffB[1]}; PG8_STAGE(bufoff, (base) + (h) * ((kd) ? hstepB2 : hstepB), _vb); } \
        else { PG8_STAGE(bufoff, (base) + (h) * hstepB, voffB); } } while (0)
    Unit cur, nxt; int ui = 0; int pub_pm = -1;
    if (!S.next(0, cur)) return;
    f32x4 acc[2][2][4][2];
#pragma unroll
    for (int a = 0; a < 2; ++a)
#pragma unroll
        for (int b = 0; b < 2; ++b)
#pragma unroll
            for (int m = 0; m < 4; ++m)
#pragma unroll
                for (int n = 0; n < 2; ++n) acc[a][b][m][n] = (f32x4){0.f, 0.f, 0.f, 0.f};
    bf16x8 At[4][2], B0[2][2], B1[2][2];
    pg8_i32x8 Atq[4], B0q[2], B1q[2];
    {
        const char* cA = cur.A; const char* b0 = PG8_BK(cur, 0); const char* b1 = PG8_BK(cur, 1);
        if constexpr (WAITS) S.a_ready(cur);
        if constexpr (GATHER) { PG8_GIDX(0, vAc); }
        const int kc = cur.aux;
        PG8_STAGE_B(PG8_SB(0, 0), b0, 0, kc); PG8_STAGE_B(PG8_SB(0, 1), b0, 1, kc); PG8_STAGE_A(PG8_SA(0, 0), cA, 0, false); PG8_STAGE_A(PG8_SA(0, 1), cA, 1, false);
        if (wr == 1) PG8_BAR;
        PG8_WAIT_V(2); PG8_BAR;
        PG8_STAGE_B(PG8_SB(1, 0), b1, 0, kc); PG8_STAGE_A(PG8_SA(1, 0), cA + kstep, 0, false); PG8_STAGE_B(PG8_SB(1, 1), b1, 1, kc);
        PG8_WAIT_V(6); PG8_BAR;
    }
    for (;;) {
        const bool has_next = S.next(ui + 1, nxt);
        if (!has_next) nxt = cur;
        if constexpr (GATHER) { PG8_GIDX(has_next ? ui + 1 : ui, vAn); }
        const char* cA = cur.A;
#pragma unroll 1
        for (int t = 0; t < nt; t += 2) {
            const bool last = (t == nt - 2);
            const char* a1 = cA + (size_t)(t + 1) * kstep;
            const char* a2 = last ? nxt.A : cA + (size_t)(t + 2) * kstep;
            const char* a3 = a2 + kstep;
            const char* b2 = last ? PG8_BK(nxt, 0) : PG8_BK(cur, t + 2);
            const char* b3 = last ? PG8_BK(nxt, 1) : PG8_BK(cur, t + 3);
            const int kb = last ? nxt.aux : cur.aux;
            if constexpr (WAITS) { if (last && has_next) S.a_ready(nxt); }
            PG8_LDB(B0, 0, 0); PG8_LDB(B1, 0, 1); PG8_SCHED; PG8_LDA(At, 0, 0); PG8_STAGE_A(PG8_SA(1, 1), a1, 1, false);
            PG8_WAIT_V(8); PG8_WAIT_L(0); PG8_BAR;
            if constexpr (PUBL) { if (t == 2 && pub_pm >= 0) { if (wid == 0 && lane == 0) E.publish(pub_pm); pub_pm = -1; } }
            PG8_MMA(0, 0, At, B0); PG8_MMA(0, 1, At, B1); PG8_BAR; PG8_SCHED;
            PG8_LDA(At, 0, 1); PG8_STAGE_B(PG8_SB(0, 0), b2, 0, kb); PG8_STAGE_B(PG8_SB(0, 1), b2, 1, kb); PG8_STAGE_A(PG8_SA(0, 0), a2, 0, last);
            PG8_WAIT_V(8); PG8_WAIT_L(0); PG8_BAR; PG8_MMA(1, 0, At, B0); PG8_MMA(1, 1, At, B1); PG8_BAR; PG8_SCHED;
            PG8_LDB(B0, 1, 0); PG8_LDB(B1, 1, 1); PG8_SCHED; PG8_LDA(At, 1, 0); PG8_STAGE_A(PG8_SA(0, 1), a2, 1, last);
            PG8_WAIT_V(8); PG8_WAIT_L(0); PG8_BAR; PG8_MMA(0, 0, At, B0); PG8_MMA(0, 1, At, B1); PG8_BAR; PG8_SCHED;
            PG8_LDA(At, 1, 1); PG8_STAGE_B(PG8_SB(1, 0), b3, 0, kb); PG8_STAGE_B(PG8_SB(1, 1), b3, 1, kb); PG8_STAGE_A(PG8_SA(1, 0), a3, 0, last);
            PG8_WAIT_V(8); PG8_WAIT_L(0); PG8_BAR; PG8_MMA(1, 0, At, B0); PG8_MMA(1, 1, At, B1); PG8_BAR; PG8_SCHED;
        }
        if (wr == 0) PG8_BAR;
        E(acc, cur, wr, wc, fr, fq);
        if constexpr (PUBL) pub_pm = cur.pm;
        if (!has_next) break;
#pragma unroll
        for (int a = 0; a < 2; ++a)
#pragma unroll
            for (int b = 0; b < 2; ++b)
#pragma unroll
                for (int m = 0; m < 4; ++m)
#pragma unroll
                    for (int n = 0; n < 2; ++n) acc[a][b][m][n] = (f32x4){0.f, 0.f, 0.f, 0.f};
        cur = nxt; ++ui;
        if constexpr (GATHER) { _Pragma("unroll") for (int _h = 0; _h < 2; ++_h) _Pragma("unroll") for (int _i = 0; _i < 2; ++_i) vAc[_h][_i] = vAn[_h][_i]; }
        if (wr == 1) PG8_BAR;
    }
    PG8_WAIT_V(0);
    PG8_BAR;
    if constexpr (PUBL) { if (pub_pm >= 0 && wid == 0 && lane == 0) E.publish(pub_pm); }
#undef PG8_SA
#undef PG8_SB
#undef PG8_STAGE
#undef PG8_LDA
#undef PG8_LDB
#undef PG8_MMA
#undef PG8_CAT
#undef PG8_WAIT_V
#undef PG8_WAIT_L
#undef PG8_BAR
#undef PG8_SCHED
#undef PG8_BK
#undef PG8_KSP
#undef PG8_STAGE_B
#undef PG8_VB2
#undef PG8_GIDX
#undef PG8_STAGE_A
}

struct EpiStore {
    bf16_t* p; bf16_t* pctx; int mode;
    __device__ __forceinline__ void operator()(const f32x4 (&acc)[2][2][4][2], const Unit& u, int wr_, int wc_, int fr_, int fq_) const {
        const int t_ = opaque_tid(), wid_ = __builtin_amdgcn_readfirstlane(t_ >> 6), wr = wid_ >> 2, wc = wid_ & 3, fr = t_ & 15, fq = (t_ & 63) >> 4; (void)wr_; (void)wc_; (void)fr_; (void)fq_;
        bf16_t* base; int ldc;
        if (mode == 0) { if (u.aux) { base = pctx; ldc = 1024; } else { base = p; ldc = 3072; } } else { base = p; ldc = 1024; }
        const int row0 = u.pm * BM + wr * 64 + fr, col0 = u.pn * BM + wc * 32 + 8 * fq;
        if (mode == 0 && u.pn >= 2 && u.pn < 6) {
            const int colu = 512 + (u.pn - 2) * 128 + wc * 32 + 8 * fq;
#pragma unroll
            for (int ai = 0; ai < 2; ++ai)
#pragma unroll
                for (int m = 0; m < 4; ++m) { const f32x4 a0 = acc[ai][0][m][0], a1 = acc[ai][0][m][1], x0 = acc[ai][1][m][0], x1 = acc[ai][1][m][1];
                    u32x4 w; w.x = cvt_pk_bf16(a0[0] * x0[0], a0[1] * x0[1]); w.y = cvt_pk_bf16(a0[2] * x0[2], a0[3] * x0[3]); w.z = cvt_pk_bf16(a1[0] * x1[0], a1[1] * x1[1]); w.w = cvt_pk_bf16(a1[2] * x1[2], a1[3] * x1[3]);
                    *(u32x4*)(base + (size_t)(row0 + ai * HALF + m * 16) * ldc + colu) = w; }
            return;
        }
#pragma unroll
        for (int ai = 0; ai < 2; ++ai)
#pragma unroll
            for (int m = 0; m < 4; ++m) { bf16_t* rowp = base + (size_t)(row0 + ai * HALF + m * 16) * ldc + col0;
#pragma unroll
                for (int bj = 0; bj < 2; ++bj) { const f32x4 v0 = acc[ai][bj][m][0], v1 = acc[ai][bj][m][1];
                    u32x4 w; w.x = cvt_pk_bf16(v0[0], v0[1]); w.y = cvt_pk_bf16(v0[2], v0[3]); w.z = cvt_pk_bf16(v1[0], v1[1]); w.w = cvt_pk_bf16(v1[2], v1[3]);
                    *(u32x4*)(rowp + bj * HALF) = w; } }
    }
};
}

struct SchedG1 {
    const char* hln; const char* WinT; const char* hc; const char* WgT; int G, c;
    __device__ __forceinline__ bool next(int i, pg8::Unit& u) const {
        const int L = i * G + c;
        if (L < 1536) { int pm, pn; pg8::static_order(L, 128, 12, pm, pn); u.pm = pm; u.pn = pn; u.aux = 0; u.A = hln + (size_t)pm * 256 * 2048; u.B = WinT + (size_t)pn * 256 * 2048; u.B2 = u.B; return true; }
        return false;
    }
};
struct SchedG2 {
    const char* A; const char* Bt; int G, c;
    __device__ __forceinline__ bool next(int i, pg8::Unit& u) const {
        const int L = i * G + c; if (L >= 512) return false;
        int pm, pn; pg8::static_order(L, 128, 4, pm, pn); u.pm = pm; u.pn = pn; u.aux = 0; u.A = A + (size_t)pm * 256 * 2048; u.B = Bt + (size_t)pn * 256 * 2048; u.B2 = u.B; return true;
    }
};
__device__ __forceinline__ void cls_experts(int c, int& e_lo, int& e_hi) { const int g = c / 6, pi = c % 6; e_lo = g * 4 + (pi < 3 ? 0 : (pi < 5 ? 1 : 2)); e_hi = g * 4 + (pi < 3 ? pi + 1 : (pi < 5 ? pi - 1 : 3)); }
__device__ void phase_gemm1(const Params& P, PG8_LAS unsigned char* lds) {
    SchedG1 S{(const char*)P.hln, (const char*)P.WinT, (const char*)P.hc, (const char*)P.WgT, (int)gridDim.x, (int)blockIdx.x};
    pg8::EpiStore E{P.p, P.pctx, 0}; pg8::GemmCfg g{1024, 1024, 16, 16, 1024, 16};
    pg8::gemm_phase<0, false>(lds, g, S, E);
}
__device__ void phase_ctx_proj(const Params& P) {
    typedef short bf16x8 __attribute__((ext_vector_type(8))); typedef float f32x4 __attribute__((ext_vector_type(4)));
    const int tid = opaque_tid(), lane = tid & 63, wid = tid >> 6, r16 = lane & 15, q = lane >> 4;
    const int g = blockIdx.x >> 3, j = blockIdx.x & 7, rt = wid & 3, hf = wid >> 2;
    const bf16_t* arow = P.hc + (size_t)(g * 64 + rt * 16 + r16) * D + 8 * q;
    const bf16_t* brow[4]; bool ok[4];
#pragma unroll
    for (int u = 0; u < 4; ++u) { const int t = 7 * j + 4 * hf + u; ok[u] = (u < 4 - hf) && t < 50; const int tc = ok[u] ? t : 0;
        brow[u] = (tc < 48 ? P.WinT + (size_t)(OFF_K + 16 * tc + r16) * D : P.WgT + (size_t)(16 * (tc - 48) + r16) * D) + 8 * q; }
    f32x4 acc[4];
#pragma unroll
    for (int u = 0; u < 4; ++u) acc[u] = (f32x4){0.f, 0.f, 0.f, 0.f};
#pragma unroll 8
    for (int ks = 0; ks < 32; ++ks) { const bf16x8 a = *(const bf16x8*)(arow + 32 * ks);
#pragma unroll
        for (int u = 0; u < 4; ++u) acc[u] = __builtin_amdgcn_mfma_f32_16x16x32_bf16(a, *(const bf16x8*)(brow[u] + 32 * ks), acc[u], 0, 0, 0); }
#pragma unroll
    for (int u = 0; u < 4; ++u) if (ok[u]) { const int t = 7 * j + 4 * hf + u;
#pragma unroll
        for (int jj = 0; jj < 4; ++jj) P.pctx[(size_t)(g * 64 + rt * 16 + 4 * q + jj) * 1024 + 16 * t + r16] = f2bf(acc[u][jj]); }
}
__device__ void phase_gemm2(const Params& P, PG8_LAS unsigned char* lds) {
    SchedG2 S{(const char*)P.ymix, (const char*)P.WoutT, (int)gridDim.x, (int)blockIdx.x};
    pg8::EpiStore E{P.ybuf, nullptr, 1}; pg8::GemmCfg g{1024, 1024, 16, 16, 1024, 16};
    pg8::gemm_phase<0, false>(lds, g, S, E);
}

struct SchedUpQ {
    const char* h2qs; const char* W13Q; const int* tileinfo; int ntiles, c;
    __device__ __forceinline__ bool next(int i, pg8::Unit& u) const {
        const int x = c & 7, j = c >> 3, pm = 32 * i + 4 * (j >> 2) + (x >> 1), pn = 4 * (x & 1) + (j & 3);
        if (pm >= ntiles) return false;
        int e_lo, e_hi; cls_experts(__builtin_amdgcn_readfirstlane(tileinfo[1 + pm]), e_lo, e_hi); const int e = (pn >> 2) ? e_hi : e_lo;
        u.pm = pm; u.pn = pn; u.aux = 0; u.A = h2qs + (size_t)pm * 256 * 1024; u.B = W13Q + ((size_t)e * 1024 + (pn & 3) * 256) * 1024; u.B2 = u.B; return true;
    }
};
struct SchedDownQ {
    const char* actq; const char* W2Q; const int* tileinfo; const unsigned* cnt; int ntiles, c;
    __device__ __forceinline__ bool next(int k, pg8::Unit& u) const {
        const int x = c & 7, j = c >> 3, jj = j >> 2, rem = ntiles & 31;
        int Hx = (rem - (x >> 1) + 3) >> 2; Hx = Hx < 0 ? 0 : (Hx > 8 ? 8 : Hx);
        const int L = 8 - Hx; const bool light = jj >= Hx;
        const int pl = light ? (k == 0 ? jj - Hx : L + 8 * (k - 1) + jj) : L + 8 * k + jj;
        const int pm = 8 * pl + x, pn = j & 3;
        if (pm >= ntiles) return false;
        int e_lo, e_hi; cls_experts(__builtin_amdgcn_readfirstlane(tileinfo[1 + pm]), e_lo, e_hi);
        u.pm = pm; u.pn = pn; u.aux = 1; u.A = actq + (size_t)pm * 256 * 1024; u.B = W2Q + ((size_t)e_lo * 1024 + pn * 256) * 512; u.B2 = W2Q + ((size_t)e_hi * 1024 + pn * 256) * 512; return true;
    }
    __device__ __forceinline__ void a_ready(const pg8::Unit& u) const {
        const unsigned* p = cnt + u.pm; unsigned sp = 0;
        while (__hip_atomic_load(p, __ATOMIC_RELAXED, __HIP_MEMORY_SCOPE_AGENT) < 8u) { __builtin_amdgcn_s_sleep(4); if (++sp > (1u << 22)) break; }
    }
};
namespace pg8 { template <> struct sched_waits<SchedDownQ> { static constexpr bool v = true; }; }
namespace pg8 {
struct EpiUpQ {
    unsigned char* act; const float* cws; unsigned* cnt;
    __device__ __forceinline__ void publish(int pm) const { __hip_atomic_fetch_add(cnt + pm, 1u, __ATOMIC_RELAXED, __HIP_MEMORY_SCOPE_AGENT); }
    __device__ __forceinline__ void operator()(const f32x4 (&acc)[2][2][4][2], const Unit& u, int wr, int wc, int fr, int fq) const {
        const int half = u.pn >> 2, row0 = u.pm * BM + wr * 64 + fr, col0 = half * 512 + (u.pn & 3) * 128 + wc * 32 + 8 * fq;
#pragma unroll
        for (int ai = 0; ai < 2; ++ai)
#pragma unroll
            for (int m = 0; m < 4; ++m) { const int row = row0 + ai * HALF + m * 16; const float cwv = cws[(size_t)row * 2 + half] * 8.f;
                float o[8];
#pragma unroll
                for (int n = 0; n < 2; ++n)
#pragma unroll
                    for (int j = 0; j < 4; ++j) { const float a = acc[ai][0][m][n][j], b = acc[ai][1][m][n][j]; o[n * 4 + j] = a * __builtin_amdgcn_rcpf(1.f + __expf(-a)) * b * cwv; }
                uint2 w; w.x = pack4_fp8(o[0], o[1], o[2], o[3]); w.y = pack4_fp8(o[4], o[5], o[6], o[7]);
                __hip_atomic_store((unsigned long long*)(act + (size_t)row * 1024 + col0), ((unsigned long long)w.y << 32) | w.x, __ATOMIC_RELAXED, __HIP_MEMORY_SCOPE_AGENT); }
    }
};
template <> struct epi_publishes<EpiUpQ> { static constexpr bool v = true; };
}
__device__ void phase_moe_up(const Params& P, PG8_LAS unsigned char* lds) {
    SchedUpQ S{(const char*)P.h2qs, (const char*)P.W13Q, P.tileinfo, __builtin_amdgcn_readfirstlane((int)P.ctrl[4096 + 64 * NCLS]), (int)blockIdx.x};
    pg8::EpiUpQ E{P.actq, P.cws, P.ctrl + 12288}; pg8::GemmCfg g{1024, 1024, 8, 8, 1024, 8};
    pg8::gemm_phase<0, true>(lds, g, S, E);
}
__device__ void phase_moe_down(const Params& P, PG8_LAS unsigned char* lds) {
    SchedDownQ S{(const char*)P.actq, (const char*)P.W2Q, P.tileinfo, P.ctrl + 12288, __builtin_amdgcn_readfirstlane((int)P.ctrl[4096 + 64 * NCLS]), (int)blockIdx.x};
    pg8::EpiStore E{P.moes, nullptr, 1}; pg8::GemmCfg g{1024, 512, 8, 4, 512, 4};
    pg8::gemm_phase<0, true>(lds, g, S, E);
}

__device__ __forceinline__ void unpack8(const uint4& t, float* f) {
  f[0] = __uint_as_float(t.x << 16); f[1] = __uint_as_float(t.x & 0xffff0000u); f[2] = __uint_as_float(t.y << 16); f[3] = __uint_as_float(t.y & 0xffff0000u);
  f[4] = __uint_as_float(t.z << 16); f[5] = __uint_as_float(t.z & 0xffff0000u); f[6] = __uint_as_float(t.w << 16); f[7] = __uint_as_float(t.w & 0xffff0000u);
}
__device__ __forceinline__ uint4 pack8(const float* f) { uint4 w; w.x = pack2(f[0], f[1]); w.y = pack2(f[2], f[3]); w.z = pack2(f[4], f[5]); w.w = pack2(f[6], f[7]); return w; }

namespace gla {
typedef short bf16x8 __attribute__((ext_vector_type(8)));
typedef short s16x4 __attribute__((ext_vector_type(4)));
typedef short v4i16_t __attribute__((ext_vector_type(4)));
typedef float f32x4 __attribute__((ext_vector_type(4)));
typedef float f32x2 __attribute__((ext_vector_type(2)));
typedef unsigned u32x4 __attribute__((ext_vector_type(4)));
typedef unsigned u32x2 __attribute__((ext_vector_type(2)));
#define GLAS __attribute__((address_space(3)))
typedef GLAS unsigned char* ldsp;
constexpr int VST = 288, NST = 144, KEST = 160;
constexpr int L_V = 0, L_KR = L_V + 64 * VST, L_QR = L_KR + 64 * NST, L_LW = L_QR + 64 * NST, L_PT = L_LW + 64 * 32 * 4, L_DEC = L_PT + 2 * 16 * 64 * 4,
              L_QD = L_DEC + 512, L_KINV = L_QD + 64 * NST, L_KE = L_KINV + 64 * NST, L_KE2 = L_KE + 64 * KEST, L_P = L_KE2 + 64 * KEST, L_ST = L_P + 64 * NST,
              L_RS = L_ST + 128 * NST, L_GW = L_RS + 512, L_GB = L_GW + 2 * 16 * 64 * 4, L_END = L_GB + 512;
static_assert(L_END <= 128 * 1024, "gla lds");
constexpr int L_PB0 = L_KR, L_GG = L_PB0 + 2 * 16384, L_PB1 = L_GW;
static_assert(L_GG + 512 <= L_DEC && L_PB1 + 2 * 16384 <= TIDTAB_OFF, "gla pass B lds");
__device__ __forceinline__ s16x4 trr(const GLAS unsigned char* p) { return __builtin_bit_cast(s16x4, __builtin_amdgcn_ds_read_tr16_b64_v4i16((GLAS v4i16_t*)p)); }
__device__ __forceinline__ bf16x8 tr_frag(const GLAS unsigned char* img, int stride, int k0, int col0, int lane) {
    const int q = lane >> 4, r = (lane & 15) >> 2, pp = lane & 3;
    const GLAS unsigned char* a = img + (k0 + 4 * q + r) * stride + (col0 + 4 * pp) * 2;
    const s16x4 lo = trr(a), hi = trr(a + 16 * stride);
    return (bf16x8){lo[0], lo[1], lo[2], lo[3], hi[0], hi[1], hi[2], hi[3]};
}
__device__ __forceinline__ bf16x8 nat_frag(const GLAS unsigned char* img, int stride, int row0, int k0, int lane) {
    return *(const GLAS bf16x8*)(img + (row0 + (lane & 15)) * stride + (k0 + 8 * (lane >> 4)) * 2);
}
__device__ __forceinline__ bf16x8 natp_frag(const GLAS unsigned char* img, int stride, int row0, int k0, int lane) {
    const GLAS unsigned char* a = img + (row0 + (lane & 15)) * stride + (k0 + 4 * (lane >> 4)) * 2;
    const s16x4 lo = *(const GLAS s16x4*)a, hi = *(const GLAS s16x4*)(a + 32);
    return (bf16x8){lo[0], lo[1], lo[2], lo[3], hi[0], hi[1], hi[2], hi[3]};
}
#define GMFMA(a, b, c) __builtin_amdgcn_mfma_f32_16x16x32_bf16(a, b, c, 0, 0, 0)

struct Src { const bf16_t* pp; int ld, qoff, koff, voff; const float* low; int lowbf; };

struct ChunkRegs { u32x4 k, q, v0, v1; f32x4 lw; };
__device__ __forceinline__ void chunk_load(ChunkRegs& cr, const Src& s, size_t row0, int h, bool withq, int tid) {
    { const int r = tid >> 3, c8 = (tid & 7) * 8; const bf16_t* pr = s.pp + (row0 + r) * s.ld;
      cr.k = *(const u32x4*)(pr + s.koff + h * 64 + c8);
      if (withq) cr.q = *(const u32x4*)(pr + s.qoff + h * 64 + c8); }
    { const int r = tid >> 4, c8 = (tid & 15) * 8; cr.v0 = *(const u32x4*)(s.pp + (row0 + r) * s.ld + s.voff + h * 128 + c8); cr.v1 = *(const u32x4*)(s.pp + (row0 + 32 + r) * s.ld + s.voff + h * 128 + c8); }
    { const int r = tid >> 3, c4 = (tid & 7) * 4;
      if (s.lowbf) { const uint2 t = *(const uint2*)(s.pp + (row0 + r) * s.ld + 768 + c4);
        cr.lw = (f32x4){__uint_as_float(t.x << 16), __uint_as_float(t.x & 0xffff0000u), __uint_as_float(t.y << 16), __uint_as_float(t.y & 0xffff0000u)}; }
      else cr.lw = *(const f32x4*)(s.low + (row0 + r) * 32 + c4); }
}
__device__ __forceinline__ void chunk_store(ldsp lds, const ChunkRegs& cr, bool withq, int tid) {
    { const int r = tid >> 3, c8 = (tid & 7) * 8; *(GLAS u32x4*)(lds + L_KR + r * NST + c8 * 2) = cr.k; if (withq) *(GLAS u32x4*)(lds + L_QR + r * NST + c8 * 2) = cr.q; }
    { const int r = tid >> 4, c8 = (tid & 15) * 8; *(GLAS u32x4*)(lds + L_V + r * VST + c8 * 2) = cr.v0; *(GLAS u32x4*)(lds + L_V + (32 + r) * VST + c8 * 2) = cr.v1; }
    { const int r = tid >> 3, c4 = (tid & 7) * 4; *(GLAS f32x4*)(lds + L_LW + (r * 32 + c4) * 4) = cr.lw; }
}
__device__ __forceinline__ void gate_scan(ldsp lds, int dir, int dp, int part, float (&c)[4][2]) {
    float z[4][2];
    { const f32x2 bb = *(const GLAS f32x2*)(lds + L_GB + (dir * 64 + 2 * dp) * 4);
#pragma unroll
      for (int rr = 0; rr < 4; ++rr) { z[rr][0] = bb[0]; z[rr][1] = bb[1]; } }
#pragma unroll
    for (int r4 = 0; r4 < 4; ++r4) {
        f32x2 wv[4];
#pragma unroll
        for (int r = 0; r < 4; ++r) wv[r] = *(const GLAS f32x2*)(lds + L_GW + ((dir * 16 + 4 * r4 + r) * 64 + 2 * dp) * 4);
#pragma unroll
        for (int rr = 0; rr < 4; ++rr) { const f32x4 l = *(const GLAS f32x4*)(lds + L_LW + ((4 * part + rr) * 32 + dir * 16 + 4 * r4) * 4);
#pragma unroll
            for (int r = 0; r < 4; ++r) { z[rr][0] += l[r] * wv[r][0]; z[rr][1] += l[r] * wv[r][1]; } }
    }
    float g[4][2];
#pragma unroll
    for (int rr = 0; rr < 4; ++rr) { g[rr][0] = logsigmoid_fast(z[rr][0]) * (1.f / 16.f); g[rr][1] = logsigmoid_fast(z[rr][1]) * (1.f / 16.f); }
#pragma unroll
    for (int e = 0; e < 2; ++e) {
        const float a0 = g[0][e], a1 = a0 + g[1][e], a2 = a1 + g[2][e], a3 = a2 + g[3][e];
        c[0][e] = dir ? a3 : a0; c[1][e] = dir ? a3 - a0 : a1; c[2][e] = dir ? a3 - a1 : a2; c[3][e] = dir ? a3 - a2 : a3;
    }
}
__device__ __forceinline__ void stage_gate_w(const Params& P, ldsp lds, int h, int tid) {
#pragma unroll
    for (int i = 0; i < 4; ++i) { const int idx = tid + 512 * i, dir = idx >> 10, r = (idx >> 6) & 15, d = idx & 63;
        *(GLAS float*)(lds + L_GW + idx * 4) = (dir ? P.gw_b : P.gw_f)[r * 256 + h * 64 + d]; }
    if (tid < 128) *(GLAS float*)(lds + L_GB + tid * 4) = ((tid >> 6) ? P.gb_b : P.gb_f)[h * 64 + (tid & 63)];
}

__device__ void pass_a(const Params& P, ldsp lds) {
    const int tid = opaque_tid(), lane = tid & 63, wid = tid >> 6, dp = tid & 31, part = tid >> 5;
    const int dt = wid & 3, eh = wid >> 2, q = lane >> 4, c16 = lane & 15;
    for (int item = blockIdx.x; item < 256 + 128; item += gridDim.x) {
        const bool isctx = item >= 256;
        int b, h, seg, nch; Src s; size_t rowbase;
        if (!isctx) { b = item >> 5; h = (item >> 3) & 3; seg = item & 7; nch = 8; s = Src{P.p, NP, OFF_Q, OFF_K, OFF_V, P.low, 0}; rowbase = (size_t)b * SEQ + seg * 512; }
        else { const int j = item - 256; b = j >> 4; h = (j >> 2) & 3; seg = 0; nch = 1; s = Src{P.pctx, 1024, 0, 0, 256, P.low, 1}; rowbase = (size_t)b * CTXL + (j & 3) * 64; }
        __syncthreads(); stage_gate_w(P, lds, h, tid);
        f32x4 Sf[4], Sb[4];
#pragma unroll
        for (int n = 0; n < 4; ++n) { Sf[n] = (f32x4){0.f, 0.f, 0.f, 0.f}; Sb[n] = (f32x4){0.f, 0.f, 0.f, 0.f}; }
        float LPb[2] = {0.f, 0.f}, LPf[2] = {0.f, 0.f};
        const bool wq = !isctx;
        ChunkRegs cr; chunk_load(cr, s, rowbase, h, wq, tid);
        for (int n = 0; n < nch; ++n) {
            __syncthreads();
            chunk_store(lds, cr, wq, tid);
            if (n + 1 < nch) chunk_load(cr, s, rowbase + (n + 1) * 64, h, wq, tid);
            __syncthreads();
            float cf[4][2], cb[4][2];
            gate_scan(lds, 0, dp, part, cf); gate_scan(lds, 1, dp, part, cb);
            GLAS float* PT = (GLAS float*)(lds + L_PT);
            *(GLAS f32x2*)(PT + part * 64 + 2 * dp) = (f32x2){cf[3][0], cf[3][1]};
            *(GLAS f32x2*)(PT + 1024 + part * 64 + 2 * dp) = (f32x2){cb[0][0], cb[0][1]};
            __syncthreads();
            float offf[2] = {0.f, 0.f}, totf[2] = {0.f, 0.f}, offb[2] = {0.f, 0.f}, totb[2] = {0.f, 0.f};
#pragma unroll 4
            for (int pq = 0; pq < 16; ++pq) { const f32x2 a = *(const GLAS f32x2*)(PT + pq * 64 + 2 * dp), bq = *(const GLAS f32x2*)(PT + 1024 + pq * 64 + 2 * dp);
                totf[0] += a[0]; totf[1] += a[1]; totb[0] += bq[0]; totb[1] += bq[1];
                const float mf = (pq < part) ? 1.f : 0.f, mb = (pq > part) ? 1.f : 0.f; offf[0] += mf * a[0]; offf[1] += mf * a[1]; offb[0] += mb * bq[0]; offb[1] += mb * bq[1]; }
            const float etf0 = __expf(totf[0]), etf1 = __expf(totf[1]), etb0 = __expf(totb[0]), etb1 = __expf(totb[1]), elp0 = __expf(LPb[0]), elp1 = __expf(LPb[1]);
#pragma unroll
            for (int rr = 0; rr < 4; ++rr) { const int i = 4 * part + rr;
                const unsigned kk = *(const GLAS unsigned*)(lds + L_KR + i * NST + 4 * dp);
                const float k0 = __uint_as_float(kk << 16), k1 = __uint_as_float(kk & 0xffff0000u);
                const float egf0 = __expf(cf[rr][0] + offf[0]), egf1 = __expf(cf[rr][1] + offf[1]), egb0 = __expf(cb[rr][0] + offb[0]), egb1 = __expf(cb[rr][1] + offb[1]);
                const float eif0 = __builtin_amdgcn_rcpf(egf0), eif1 = __builtin_amdgcn_rcpf(egf1), eib0 = __builtin_amdgcn_rcpf(egb0), eib1 = __builtin_amdgcn_rcpf(egb1);
                const float kef0 = k0 * (etf0 * eif0), kef1 = k1 * (etf1 * eif1), keb0 = k0 * (etb0 * eib0), keb1 = k1 * (etb1 * eib1);
                *(GLAS unsigned*)(lds + L_KE + i * KEST + 4 * dp) = pack2(kef0, kef1);
                *(GLAS unsigned*)(lds + L_KE2 + i * KEST + 4 * dp) = pack2(keb0 * elp0, keb1 * elp1);
                if (wq) {
                    const unsigned qq = *(const GLAS unsigned*)(lds + L_QR + i * NST + 4 * dp);
                    const float q0 = __uint_as_float(qq << 16) * 0.125f, q1 = __uint_as_float(qq & 0xffff0000u) * 0.125f;
                    const size_t o0 = (rowbase + n * 64 + i) * 256 + h * 64 + 2 * dp, o1 = o0 + (size_t)NTOK * 256;
                    *(unsigned*)(P.gqd + o0) = pack2(q0 * egf0, q1 * egf1); *(unsigned*)(P.gkinv + o0) = pack2(k0 * eif0, k1 * eif1);
                    *(unsigned*)(P.gqd + o1) = pack2(q0 * egb0, q1 * egb1); *(unsigned*)(P.gkinv + o1) = pack2(k0 * eib0, k1 * eib1); } }
            if (part == 0) { *(GLAS f32x2*)(lds + L_DEC + 8 * dp) = (f32x2){etf0, etf1};
                if (wq) { const size_t ch = (rowbase >> 6) + n; *(float2*)(P.gdec + (ch * 4 + h) * 64 + 2 * dp) = (float2){etf0, etf1}; *(float2*)(P.gdec + ((512 + ch) * 4 + h) * 64 + 2 * dp) = (float2){etb0, etb1}; } }
            LPb[0] += totb[0]; LPb[1] += totb[1]; LPf[0] += totf[0]; LPf[1] += totf[1];
            __syncthreads();
            const f32x4 dec = *(const GLAS f32x4*)(lds + L_DEC + (16 * dt + 4 * q) * 4);
#pragma unroll
            for (int nn = 0; nn < 4; ++nn) Sf[nn] = Sf[nn] * dec;
#pragma unroll
            for (int ks = 0; ks < 2; ++ks) {
                const bf16x8 af = tr_frag(lds + L_KE, KEST, 32 * ks, 16 * dt, lane), ab = tr_frag(lds + L_KE2, KEST, 32 * ks, 16 * dt, lane);
#pragma unroll
                for (int nn = 0; nn < 4; ++nn) { const bf16x8 bv = tr_frag(lds + L_V, VST, 32 * ks, 64 * eh + 16 * nn, lane); Sf[nn] = GMFMA(af, bv, Sf[nn]); Sb[nn] = GMFMA(ab, bv, Sb[nn]); }
            }
        }
        float* Uf; float* Ub;
        if (!isctx) { Uf = P.Useg + (size_t)(item * 2) * 8192; Ub = Uf + 8192; }
        else { Uf = P.ctxS + (size_t)((item - 256) * 2) * 8192; Ub = Uf + 8192; }
#pragma unroll
        for (int nn = 0; nn < 4; ++nn) { *(f32x4*)(Uf + tid * 16 + 4 * nn) = Sf[nn]; *(f32x4*)(Ub + tid * 16 + 4 * nn) = Sb[nn]; }
        if (part == 0) { float* Dg = isctx ? P.ctxS + (size_t)256 * 8192 + (size_t)((item - 256) * 2) * 64 : P.Dseg + (size_t)(item * 2) * 64;
            *(float2*)(Dg + 2 * dp) = (float2){__expf(LPf[0]), __expf(LPf[1])}; *(float2*)(Dg + 64 + 2 * dp) = (float2){__expf(LPb[0]), __expf(LPb[1])}; }
    }
}

struct ChunkB { u32x4 qd, kinv, v0, v1; f32x4 dec; };
__device__ __forceinline__ void chunkb_load(ChunkB& cr, const Params& P, int dir, size_t row0, int h, int tid) {
    { const int r = tid >> 3, c8 = (tid & 7) * 8; const size_t o = ((size_t)dir * NTOK + row0 + r) * 256 + h * 64 + c8;
      cr.qd = *(const u32x4*)(P.gqd + o); cr.kinv = *(const u32x4*)(P.gkinv + o); }
    { const int r = tid >> 4, c8 = (tid & 15) * 8; cr.v0 = *(const u32x4*)(P.p + (row0 + r) * NP + OFF_V + h * 128 + c8); cr.v1 = *(const u32x4*)(P.p + (row0 + 32 + r) * NP + OFF_V + h * 128 + c8); }
    if (tid < 16) cr.dec = *(const f32x4*)(P.gdec + (((size_t)dir * 512 + (row0 >> 6)) * 4 + h) * 64 + 4 * tid);
}
__device__ __forceinline__ void chunkb_store(ldsp lds, const ChunkB& cr, int tid) {
    { const int r = tid >> 3, c8 = (tid & 7) * 8; *(GLAS u32x4*)(lds + L_QD + r * NST + c8 * 2) = cr.qd; *(GLAS u32x4*)(lds + L_KE + r * KEST + c8 * 2) = cr.kinv; }
    { const int r = tid >> 4, c8 = (tid & 15) * 8; *(GLAS u32x4*)(lds + L_V + r * VST + c8 * 2) = cr.v0; *(GLAS u32x4*)(lds + L_V + (32 + r) * VST + c8 * 2) = cr.v1; }
    if (tid < 16) *(GLAS f32x4*)(lds + L_DEC + 16 * tid) = cr.dec;
}
__device__ __forceinline__ void fold_state(const Params& P, f32x4 (&S)[4], int item, int dir, int tid, int dt, int q) {
    const int b = item >> 5, h = (item >> 3) & 3, seg = item & 7;
    {
        f32x4 u[4][4], dd[4];
#pragma unroll
        for (int ff = 0; ff < 4; ++ff) { const int cc = dir ? 3 - ff : ff, e = (((b * 4 + h) * 4 + cc) * 2 + dir);
            const float* U = P.ctxS + (size_t)e * 8192 + tid * 16;
            dd[ff] = *(const f32x4*)(P.ctxS + (size_t)256 * 8192 + (size_t)e * 64 + 16 * dt + 4 * q);
#pragma unroll
            for (int nn = 0; nn < 4; ++nn) u[ff][nn] = *(const f32x4*)(U + 4 * nn); }
#pragma unroll
        for (int nn = 0; nn < 4; ++nn) S[nn] = u[0][nn];
#pragma unroll
        for (int ff = 1; ff < 4; ++ff)
#pragma unroll
            for (int nn = 0; nn < 4; ++nn) S[nn] = dd[ff] * S[nn] + u[ff][nn]; }
    const int nfold = dir ? 7 - seg : seg;
    for (int f0 = 0; f0 < nfold; f0 += 4) { f32x4 u[4][4], dd[4];
#pragma unroll
        for (int ff = 0; ff < 4; ++ff) { const int f = min(f0 + ff, nfold - 1), sp = dir ? 7 - f : f, it2 = (item & ~7) + sp;
            const float* U = P.Useg + (size_t)(it2 * 2 + dir) * 8192 + tid * 16;
            dd[ff] = *(const f32x4*)(P.Dseg + (size_t)(it2 * 2 + dir) * 64 + 16 * dt + 4 * q);
#pragma unroll
            for (int nn = 0; nn < 4; ++nn) u[ff][nn] = *(const f32x4*)(U + 4 * nn); }
#pragma unroll
        for (int ff = 0; ff < 4; ++ff) { const bool v = f0 + ff < nfold; const f32x4 one = (f32x4){1.f, 1.f, 1.f, 1.f}, zero = (f32x4){0.f, 0.f, 0.f, 0.f}; const f32x4 de = v ? dd[ff] : one;
#pragma unroll
            for (int nn = 0; nn < 4; ++nn) S[nn] = de * S[nn] + (v ? u[ff][nn] : zero); } }
}
__device__ void pass_b(const Params& P, ldsp lds) {
    const int tid = opaque_tid(), lane = tid & 63, wid = tid >> 6;
    const int dt = wid & 3, eh = wid >> 2, q = lane >> 4, c16 = lane & 15, it = wid & 3;
    for (int item = blockIdx.x; item < 256; item += gridDim.x) {
        const int b = item >> 5, h = (item >> 3) & 3, seg = item & 7;
        const size_t rowbase = (size_t)b * SEQ + seg * 512;
        __syncthreads();
        if (tid < 128) *(GLAS float*)(lds + L_GG + tid * 4) = P.gla_g[tid];
        f32x4 Sd[2][4];
        fold_state(P, Sd[0], item, 0, tid, dt, q); fold_state(P, Sd[1], item, 1, tid, dt, q);
        u32x2 part[4][4];
        ChunkB cr; chunkb_load(cr, P, 0, rowbase, h, tid);
#pragma unroll
        for (int t = 0; t < 8; ++t) {
#pragma unroll
            for (int dir = 0; dir < 2; ++dir) {
                const int n = dir ? 7 - t : t;
                const bool fin = dir ? (n < 4) : (n >= 4);
                int n_o = n, nx_o = dir ? t + 1 : 7 - t;
                asm volatile("" : "+s"(n_o), "+s"(nx_o));
                const size_t row0 = rowbase + n_o * 64;
                __syncthreads();
#pragma unroll
                for (int nn = 0; nn < 4; ++nn) { u32x2 wv; wv[0] = pack2(Sd[dir][nn][0], Sd[dir][nn][1]); wv[1] = pack2(Sd[dir][nn][2], Sd[dir][nn][3]);
                    *(GLAS u32x2*)(lds + L_ST + (64 * eh + 16 * nn + c16) * NST + (16 * dt + 4 * q) * 2) = wv; }
                chunkb_store(lds, cr, tid);
                if (dir == 0) chunkb_load(cr, P, 1, rowbase + nx_o * 64, h, tid);
                else if (t < 7) chunkb_load(cr, P, 0, rowbase + nx_o * 64, h, tid);
                uint2 rvr[4];
                if (fin) {
#pragma unroll
                    for (int nn = 0; nn < 4; ++nn) rvr[nn] = *(const uint2*)(P.p + (row0 + 16 * it + c16) * NP + OFF_R + h * 128 + 64 * eh + 16 * nn + 4 * q);
                }
                __syncthreads();
#pragma unroll
                for (int t2 = 0; t2 < 2; ++t2) { const int jt = eh * 2 + t2;
                    f32x4 sc = (f32x4){0.f, 0.f, 0.f, 0.f};
#pragma unroll
                    for (int ks = 0; ks < 2; ++ks) sc = GMFMA(nat_frag(lds + L_KE, KEST, 16 * jt, 32 * ks, lane), nat_frag(lds + L_QD, NST, 16 * it, 32 * ks, lane), sc);
                    const int i = 16 * it + c16;
#pragma unroll
                    for (int j = 0; j < 4; ++j) { const int jj = 16 * jt + 4 * q + j; const bool keep = dir ? (jj >= i) : (jj <= i); if (!keep) sc[j] = 0.f; }
                    u32x2 wv; wv[0] = pack2(sc[0], sc[1]); wv[1] = pack2(sc[2], sc[3]);
                    *(GLAS u32x2*)(lds + L_P + i * NST + (16 * jt + 4 * q) * 2) = wv; }
                __syncthreads();
                f32x4 o[4];
#pragma unroll
                for (int nn = 0; nn < 4; ++nn) o[nn] = (f32x4){0.f, 0.f, 0.f, 0.f};
#pragma unroll
                for (int ks = 0; ks < 2; ++ks) {
                    const bf16x8 pb = natp_frag(lds + L_P, NST, 16 * it, 32 * ks, lane), qb = nat_frag(lds + L_QD, NST, 16 * it, 32 * ks, lane);
#pragma unroll
                    for (int nn = 0; nn < 4; ++nn) { o[nn] = GMFMA(tr_frag(lds + L_V, VST, 32 * ks, 64 * eh + 16 * nn, lane), pb, o[nn]);
                        o[nn] = GMFMA(nat_frag(lds + L_ST, NST, 64 * eh + 16 * nn, 32 * ks, lane), qb, o[nn]); }
                }
                { const f32x4 dec = *(const GLAS f32x4*)(lds + L_DEC + (16 * dt + 4 * q) * 4);
#pragma unroll
                  for (int ks = 0; ks < 2; ++ks) { const bf16x8 af = tr_frag(lds + L_KE, KEST, 32 * ks, 16 * dt, lane);
#pragma unroll
                    for (int nn = 0; nn < 4; ++nn) Sd[dir][nn] = GMFMA(af, tr_frag(lds + L_V, VST, 32 * ks, 64 * eh + 16 * nn, lane), Sd[dir][nn]); }
#pragma unroll
                  for (int nn = 0; nn < 4; ++nn) Sd[dir][nn] = Sd[dir][nn] * dec; }
                if (!fin) {
#pragma unroll
                    for (int nn = 0; nn < 4; ++nn) { u32x2 wv; wv[0] = pack2(o[nn][0], o[nn][1]); wv[1] = pack2(o[nn][2], o[nn][3]);
                        if (n < 4) part[n & 3][nn] = wv; else *(GLAS u32x2*)(lds + (n < 6 ? L_PB0 + (n - 4) * 16384 : L_PB1 + (n - 6) * 16384) + nn * 4096 + tid * 8) = wv; }
                } else {
                    float ss = 0.f;
#pragma unroll
                    for (int nn = 0; nn < 4; ++nn) { const u32x2 pv = n < 4 ? part[n & 3][nn] : *(const GLAS u32x2*)(lds + (n < 6 ? L_PB0 + (n - 4) * 16384 : L_PB1 + (n - 6) * 16384) + nn * 4096 + tid * 8);
                        o[nn][0] += __uint_as_float(pv[0] << 16); o[nn][1] += __uint_as_float(pv[0] & 0xffff0000u); o[nn][2] += __uint_as_float(pv[1] << 16); o[nn][3] += __uint_as_float(pv[1] & 0xffff0000u);
                        ss += o[nn][0] * o[nn][0] + o[nn][1] * o[nn][1] + o[nn][2] * o[nn][2] + o[nn][3] * o[nn][3]; }
                    ss += __shfl_xor(ss, 16); ss += __shfl_xor(ss, 32);
                    GLAS float* RS = (GLAS float*)(lds + L_RS);
                    if (q == 0) RS[eh * 64 + 16 * it + c16] = ss;
                    __syncthreads();
                    const float tot2 = RS[16 * it + c16] + RS[64 + 16 * it + c16];
                    const float rs = rsqrtf(tot2 * (1.f / 128.f) + 1e-6f);
                    const size_t tok = row0 + 16 * it + c16;
#pragma unroll
                    for (int nn = 0; nn < 4; ++nn) { const int e = 64 * eh + 16 * nn + 4 * q;
                        const uint2 rv = rvr[nn];
                        const f32x4 gg = *(const GLAS f32x4*)(lds + L_GG + e * 4);
                        const float r0 = __uint_as_float(rv.x << 16), r1 = __uint_as_float(rv.x & 0xffff0000u), r2 = __uint_as_float(rv.y << 16), r3 = __uint_as_float(rv.y & 0xffff0000u);
                        uint2 wv; wv.x = pack2(o[nn][0] * rs * gg[0] * siluf(r0), o[nn][1] * rs * gg[1] * siluf(r1)); wv.y = pack2(o[nn][2] * rs * gg[2] * siluf(r2), o[nn][3] * rs * gg[3] * siluf(r3));
                        *(uint2*)(P.ymix + tok * D + 512 + h * 128 + e) = wv; }
                }
            }
        }
    }
}
}

__device__ void phase_conv(const Params& P) {
  typedef unsigned cu32x4 __attribute__((ext_vector_type(4)));
  const int tid_ = opaque_tid(); const int lane = tid_ & 63, wl = blockIdx.x * 8 + (tid_ >> 6);
  const int ch = lane * 8;
  float cw0[8], cw1[8], cw2[8], cb[8];
#pragma unroll
  for (int j = 0; j < 8; ++j) { cw0[j] = P.conv_w[ch + j]; cw1[j] = P.conv_w[512 + ch + j]; cw2[j] = P.conv_w[1024 + ch + j]; cb[j] = P.conv_b[ch + j]; }
#pragma unroll 1
  for (int task = wl; task < 4096; task += 2048) {
    const int tok0 = task * 8, gx0 = tok0 & 63;
    const bool hl = gx0 > 0, hr = gx0 < 56;
    const bf16_t* pr = P.p + (size_t)tok0 * NP;
    cu32x4 ru[10], rb[8];
#pragma unroll
    for (int t = 0; t < 10; ++t) { const int dtk = (t == 0) ? (hl ? -1 : 0) : ((t == 9) ? (hr ? 8 : 7) : t - 1);
      ru[t] = *(const cu32x4*)(pr + (ptrdiff_t)dtk * NP + OFF_AC + ch); }
#pragma unroll
    for (int t = 0; t < 8; ++t) rb[t] = *(const cu32x4*)(pr + (size_t)t * NP + OFF_AB + ch);
    float um[8], u0[8];
#pragma unroll
    for (int w = 0; w < 4; ++w) { const unsigned a0 = ru[0][w], a1 = ru[1][w];
      um[2 * w] = hl ? __uint_as_float(a0 << 16) : 0.f; um[2 * w + 1] = hl ? __uint_as_float(a0 & 0xffff0000u) : 0.f;
      u0[2 * w] = __uint_as_float(a1 << 16); u0[2 * w + 1] = __uint_as_float(a1 & 0xffff0000u); }
#pragma unroll
    for (int i = 0; i < 8; ++i) {
      const bool hn = (i < 7) || hr;
      float up[8], ya[8];
#pragma unroll
      for (int w = 0; w < 4; ++w) { const unsigned a = ru[i + 2][w];
        up[2 * w] = hn ? __uint_as_float(a << 16) : 0.f; up[2 * w + 1] = hn ? __uint_as_float(a & 0xffff0000u) : 0.f; }
#pragma unroll
      for (int w = 0; w < 4; ++w) { const unsigned bv = rb[i][w]; const float b0 = __uint_as_float(bv << 16), b1 = __uint_as_float(bv & 0xffff0000u);
        ya[2 * w] = b0 * (um[2 * w] * cw0[2 * w] + u0[2 * w] * cw1[2 * w] + up[2 * w] * cw2[2 * w] + cb[2 * w]);
        ya[2 * w + 1] = b1 * (um[2 * w + 1] * cw0[2 * w + 1] + u0[2 * w + 1] * cw1[2 * w + 1] + up[2 * w + 1] * cw2[2 * w + 1] + cb[2 * w + 1]); }
#pragma unroll
      for (int j = 0; j < 8; ++j) { um[j] = u0[j]; u0[j] = up[j]; }
      *(uint4*)(P.ymix + (size_t)(tok0 + i) * D + ch) = pack8(ya);
    }
  }
}

struct Ln1In { float4 x[4]; uint2 y[4]; float mean0, rstd0; };
__device__ __forceinline__ void ln1_load(const Params& P, int tok, int lane, Ln1In& in) {
#pragma unroll
    for (int j = 0; j < 4; ++j) { const int k = j * 256 + lane * 4; in.x[j] = *(const float4*)(P.x + (size_t)tok * D + k); in.y[j] = *(const uint2*)(P.ybuf + (size_t)tok * D + k); }
    in.mean0 = P.stats[tok * 2]; in.rstd0 = P.stats[tok * 2 + 1];
}
__device__ __forceinline__ void ln1_row(const Params& P, int tok, int lane, const Ln1In& in, const float* PR) {
    typedef float f32x4 __attribute__((ext_vector_type(4)));
    const float mean0 = in.mean0, rstd0 = in.rstd0;
    float v[16];
#pragma unroll
    for (int j = 0; j < 4; ++j) {
      const int k = j * 256 + lane * 4;
      const float4 xv = in.x[j]; const uint2 yv = in.y[j];
      const f32x4 g = *(const f32x4*)(PR + k), bb = *(const f32x4*)(PR + 1024 + k), g1 = *(const f32x4*)(PR + 2048 + k);
      v[4 * j] = (xv.x - mean0) * rstd0 * g[0] + bb[0] + g1[0] * __uint_as_float(yv.x << 16);
      v[4 * j + 1] = (xv.y - mean0) * rstd0 * g[1] + bb[1] + g1[1] * __uint_as_float(yv.x & 0xffff0000u);
      v[4 * j + 2] = (xv.z - mean0) * rstd0 * g[2] + bb[2] + g1[2] * __uint_as_float(yv.y << 16);
      v[4 * j + 3] = (xv.w - mean0) * rstd0 * g[3] + bb[3] + g1[3] * __uint_as_float(yv.y & 0xffff0000u);
    }
    float s = 0.f;
#pragma unroll
    for (int j = 0; j < 16; ++j) s += v[j];
    const float mean = wave_sum(s) * (1.f / 1024.f);
    float q = 0.f;
#pragma unroll
    for (int j = 0; j < 16; ++j) { const float dd = v[j] - mean; q += dd * dd; }
    const float rstd = rsqrtf(wave_sum(q) * (1.f / 1024.f) + 1e-5f);
#pragma unroll
    for (int j = 0; j < 4; ++j) {
      const int k = j * 256 + lane * 4;
      const f32x4 g = *(const f32x4*)(PR + 3072 + k), bb = *(const f32x4*)(PR + 4096 + k), sc = *(const f32x4*)(PR + 5120 + k), sh = *(const f32x4*)(PR + 6144 + k);
      const float x0 = (v[4 * j] - mean) * rstd * g[0] + bb[0], x1v = (v[4 * j + 1] - mean) * rstd * g[1] + bb[1], x2 = (v[4 * j + 2] - mean) * rstd * g[2] + bb[2], x3 = (v[4 * j + 3] - mean) * rstd * g[3] + bb[3];
      uint2 w; w.x = pack2(x0, x1v); w.y = pack2(x2, x3); *(uint2*)(P.x1 + (size_t)tok * D + k) = w;
      const float hh0 = x0 * sc[0] + sh[0], hh1 = x1v * sc[1] + sh[1], hh2 = x2 * sc[2] + sh[2], hh3 = x3 * sc[3] + sh[3];
      *(unsigned*)(P.h2q + (size_t)tok * D + k) = pack4_fp8(hh0 * 8.f, hh1 * 8.f, hh2 * 8.f, hh3 * 8.f);
    }
}
__device__ __forceinline__ void route_token(const Params& P, const float (&lg)[20], int* hcnt, int& c_out, int& rank_out, float& wlo_out, float& whi_out) {
    const float g0 = lg[0] + P.bgr[0], g1 = lg[1] + P.bgr[1], g2 = lg[2] + P.bgr[2], g3 = lg[3] + P.bgr[3];
    int gi = 0; float gm = g0;
    if (g1 > gm) { gm = g1; gi = 1; } if (g2 > gm) { gm = g2; gi = 2; } if (g3 > gm) { gm = g3; gi = 3; }
    const float pg = 1.f / (__expf(g0 - gm) + __expf(g1 - gm) + __expf(g2 - gm) + __expf(g3 - gm));
    float e[4];
#pragma unroll
    for (int n = 0; n < 4; ++n) e[n] = (gi == 0 ? lg[4 + n] : (gi == 1 ? lg[8 + n] : (gi == 2 ? lg[12 + n] : lg[16 + n]))) + P.ber[gi * 4 + n];
    int i1 = 0; float m1 = e[0];
    if (e[1] > m1) { m1 = e[1]; i1 = 1; } if (e[2] > m1) { m1 = e[2]; i1 = 2; } if (e[3] > m1) { m1 = e[3]; i1 = 3; }
    int i2 = -1; float m2 = -3.0e38f;
#pragma unroll
    for (int n = 0; n < 4; ++n) if (n != i1 && (i2 < 0 || e[n] > m2)) { m2 = e[n]; i2 = n; }
    const float ex2 = __expf(m2 - m1);
    const float w1 = 1.f / (1.f + ex2), w2 = ex2 / (1.f + ex2);
    const int lo = i1 < i2 ? i1 : i2, hi = i1 < i2 ? i2 : i1;
    const float wlo = (i1 < i2 ? w1 : w2) * pg, whi = (i1 < i2 ? w2 : w1) * pg;
    const int pidx = lo == 0 ? hi - 1 : (lo == 1 ? hi + 1 : 5);
    const int c = gi * 6 + pidx;
    c_out = c; wlo_out = wlo; whi_out = whi;
    rank_out = atomicAdd(&hcnt[c], 1);
}
__device__ void phase_ln1_router(const Params& P, float* ldsf) {
  typedef short bf16x8 __attribute__((ext_vector_type(8))); typedef float f32x4 __attribute__((ext_vector_type(4)));
  constexpr int WST = 2064;
  unsigned char* lds = (unsigned char*)ldsf;
  float* LG = (float*)(lds + 20 * WST);
  int* hcnt = (int*)(lds + 20 * WST + 8 * 16 * 32 * 4);
  float* PR = (float*)(lds + 20 * WST + 8 * 16 * 32 * 4 + 128);
  const int tid = opaque_tid(), lane = tid & 63, wid = tid >> 6;
  { const float* md = P.mod + ((blockIdx.x * 128) / SEQ) * 6144;
    for (int k = tid; k < 1024; k += 512) { PR[k] = ALPHA * P.ln_in_g[k]; PR[1024 + k] = ALPHA * P.ln_in_b[k]; PR[2048 + k] = md[2048 + k]; PR[3072 + k] = P.ln1_g[k]; PR[4096 + k] = P.ln1_b[k];
      PR[5120 + k] = 1.f + md[4096 + k]; PR[6144 + k] = md[3072 + k]; } }
  float* BS = PR + 7 * 1024;
  int* tcls = (int*)(BS + 192); int* trank = tcls + 128; int* tpos = trank + 128; int* cbase = tpos + 128; float* tw = (float*)(cbase + 32);
  { const float* md = P.mod + ((blockIdx.x * 128) / SEQ) * 6144;
    typedef float lf4 __attribute__((ext_vector_type(4)));
    lf4 wl[10]; float scl[10];
#pragma unroll
    for (int u = 0; u < 10; ++u) { const int i = tid + 512 * u, k = i / 5, c4 = i % 5; wl[u] = c4 == 0 ? *(const lf4*)(P.wgr + k * 4) : *(const lf4*)(P.wer + k * 16 + (c4 - 1) * 4); scl[u] = md[4096 + k]; }
#pragma unroll
    for (int u = 0; u < 10; ++u) {
      const int i = tid + 512 * u, k = i / 5, c4 = i % 5; const float4 t = make_float4(wl[u][0], wl[u][1], wl[u][2], wl[u][3]);
      const float sc = 1.f + scl[u];
      *(bf16_t*)(lds + (c4 * 4 + 0) * WST + k * 2) = f2bf(t.x * sc); *(bf16_t*)(lds + (c4 * 4 + 1) * WST + k * 2) = f2bf(t.y * sc);
      *(bf16_t*)(lds + (c4 * 4 + 2) * WST + k * 2) = f2bf(t.z * sc); *(bf16_t*)(lds + (c4 * 4 + 3) * WST + k * 2) = f2bf(t.w * sc); }
    float bp[20];
#pragma unroll
    for (int n = 0; n < 20; ++n) bp[n] = 0.f;
#pragma unroll
    for (int kk = 0; kk < 2; ++kk) { const int k = tid + 512 * kk; const float sh = md[3072 + k];
      const float4 g4 = *(const float4*)(P.wgr + k * 4); bp[0] += sh * g4.x; bp[1] += sh * g4.y; bp[2] += sh * g4.z; bp[3] += sh * g4.w;
#pragma unroll
      for (int c4 = 0; c4 < 4; ++c4) { const float4 e4 = *(const float4*)(P.wer + k * 16 + c4 * 4); bp[4 + 4 * c4] += sh * e4.x; bp[5 + 4 * c4] += sh * e4.y; bp[6 + 4 * c4] += sh * e4.z; bp[7 + 4 * c4] += sh * e4.w; } }
#pragma unroll
    for (int n = 0; n < 20; ++n) { const float t = wave_sum(bp[n]); if (lane == 0) BS[wid * 20 + n] = t; } }
  if (tid < NCLS) hcnt[tid] = 0;
  const int tokb = blockIdx.x * 128 + wid * 16;
  Ln1In inA, inB;
  ln1_load(P, tokb, lane, inA); ln1_load(P, tokb + 1, lane, inB);
  __syncthreads();
#pragma unroll 1
  for (int it = 0; it < 8; ++it) {
    const int tok0 = tokb + it * 2;
    const Ln1In cA = inA, cB = inB;
    if (it < 7) { ln1_load(P, tok0 + 2, lane, inA); ln1_load(P, tok0 + 3, lane, inB); }
    ln1_row(P, tok0, lane, cA, PR); ln1_row(P, tok0 + 1, lane, cB, PR);
  }
  asm volatile("s_waitcnt vmcnt(0)" ::: "memory");
  __syncthreads();
  const int r16 = lane & 15, q = lane >> 4;
  f32x4 a0 = {0.f, 0.f, 0.f, 0.f}, a1 = {0.f, 0.f, 0.f, 0.f};
  const bf16_t* arow = P.x1 + (size_t)(tokb + r16) * D + 8 * q;
  const unsigned char* b0p = lds + r16 * WST + 16 * q; const unsigned char* b1p = lds + (r16 < 4 ? 16 + r16 : 19) * WST + 16 * q;
#pragma unroll 8
  for (int ks = 0; ks < 32; ++ks) {
    const bf16x8 a = *(const bf16x8*)(arow + 32 * ks);
    a0 = __builtin_amdgcn_mfma_f32_16x16x32_bf16(a, *(const bf16x8*)(b0p + 64 * ks), a0, 0, 0, 0);
    a1 = __builtin_amdgcn_mfma_f32_16x16x32_bf16(a, *(const bf16x8*)(b1p + 64 * ks), a1, 0, 0, 0);
  }
  float* lgw = LG + wid * 512;
#pragma unroll
  for (int j = 0; j < 4; ++j) { lgw[(4 * q + j) * 32 + r16] = a0[j]; if (r16 < 4) lgw[(4 * q + j) * 32 + 16 + r16] = a1[j]; }
  __syncthreads();
  if (lane < 16) {
    float lg[20];
#pragma unroll
    for (int n4 = 0; n4 < 5; ++n4) { const float4 t = *(const float4*)(lgw + lane * 32 + 4 * n4); lg[4 * n4] = t.x; lg[4 * n4 + 1] = t.y; lg[4 * n4 + 2] = t.z; lg[4 * n4 + 3] = t.w; }
#pragma unroll
    for (int n = 0; n < 20; ++n) { float bsum = 0.f;
#pragma unroll
      for (int w8 = 0; w8 < 8; ++w8) bsum += BS[w8 * 20 + n];
      lg[n] += bsum; }
    int c, rk; float w0, w1; route_token(P, lg, hcnt, c, rk, w0, w1);
    const int ti = wid * 16 + lane; tcls[ti] = c; trank[ti] = rk; tw[2 * ti] = w0; tw[2 * ti + 1] = w1;
  }
  __syncthreads();
  unsigned* ctl = P.ctrl;
  if (tid < NCLS) { const int n = hcnt[tid]; unsigned base = 0u;
    if (n > 0) { base = __hip_atomic_fetch_add(ctl + 4096 + 64 * tid, (unsigned)n, __ATOMIC_RELAXED, __HIP_MEMORY_SCOPE_AGENT);
      for (unsigned k = (base + 255u) >> 8; (k << 8) < base + (unsigned)n; ++k) { const unsigned id = __hip_atomic_fetch_add(ctl + 4096 + 64 * NCLS, 1u, __ATOMIC_RELAXED, __HIP_MEMORY_SCOPE_AGENT);
        P.tileinfo[1 + id] = tid; __hip_atomic_store(ctl + 8192 + tid * 128 + k, id + 1u, __ATOMIC_RELAXED, __HIP_MEMORY_SCOPE_AGENT); } }
    cbase[tid] = (int)base; }
  __syncthreads();
  if (tid < 128) { const int c = tcls[tid]; const unsigned slot = (unsigned)(cbase[c] + trank[tid]), k = slot >> 8; unsigned* pe = ctl + 8192 + c * 128 + k; unsigned pt, sp = 0;
    while ((pt = __hip_atomic_load(pe, __ATOMIC_RELAXED, __HIP_MEMORY_SCOPE_AGENT)) == 0u) { __builtin_amdgcn_s_sleep(1); if (++sp > (1u << 24)) { pt = 1u; break; } }
    const int pos = (int)((pt - 1u) * 256u + (slot & 255u)); tpos[tid] = pos;
    P.perm[blockIdx.x * 128 + tid] = pos; P.cws[(size_t)pos * 2] = tw[2 * tid]; P.cws[(size_t)pos * 2 + 1] = tw[2 * tid + 1]; }
  __syncthreads();
  { typedef unsigned cu32x4 __attribute__((ext_vector_type(4))); cu32x4 t[16];
#pragma unroll
    for (int r = 0; r < 16; ++r) t[r] = *(const cu32x4*)(P.h2q + (size_t)(tokb + r) * D + lane * 16);
#pragma unroll
    for (int r = 0; r < 16; ++r) *(cu32x4*)(P.h2qs + (size_t)tpos[wid * 16 + r] * D + lane * 16) = t[r]; }
}

__device__ void phase_moe_sort(const Params& P, int* lds) {
  int* H = lds;
  int* tot = lds + 256 * NCLS;
  int* cstart = tot + NCLS;
  int* base = cstart + 32;
  int* mycls = base + NCLS;
  int* mypos = mycls + 128;
  const int tid = opaque_tid(), b = blockIdx.x;
  { int hv[12];
#pragma unroll
    for (int u = 0; u < 12; ++u) hv[u] = P.hist[tid + 512 * u];
#pragma unroll
    for (int u = 0; u < 12; ++u) H[tid + 512 * u] = hv[u]; }
  if (tid < 128) mycls[tid] = P.cls[b * 128 + tid];
  __syncthreads();
  if (tid < NCLS) { int t = 0, pre = 0; for (int bb = 0; bb < 256; ++bb) { if (bb == b) pre = t; t += H[bb * NCLS + tid]; } tot[tid] = t; base[tid] = pre; }
  __syncthreads();
  if (tid == 0) { int s = 0; for (int c = 0; c < NCLS; ++c) { cstart[c] = s; s += (tot[c] + 255) / 256 * 256; } cstart[NCLS] = s; }
  __syncthreads();
  if (tid < 128) { const int c = mycls[tid]; int r = 0; for (int j = 0; j < tid; ++j) r += (mycls[j] == c) ? 1 : 0; const int pos = cstart[c] + base[c] + r; mypos[tid] = pos;
    P.perm[b * 128 + tid] = pos; P.sidx[pos] = b * 128 + tid; P.cws[(size_t)pos * 2] = P.cw[(b * 128 + tid) * 2]; P.cws[(size_t)pos * 2 + 1] = P.cw[(b * 128 + tid) * 2 + 1]; }
  __syncthreads();
  { typedef unsigned su32x4 __attribute__((ext_vector_type(4))); su32x4 t[16];
#pragma unroll
    for (int i = 0; i < 16; ++i) { const int idx = tid + 512 * i, r = idx >> 6, cc = idx & 63; t[i] = *(const su32x4*)(P.h2q + (size_t)(b * 128 + r) * D + cc * 16); }
#pragma unroll
    for (int i = 0; i < 16; ++i) { const int idx = tid + 512 * i, r = idx >> 6, cc = idx & 63; *(su32x4*)(P.h2qs + (size_t)mypos[r] * D + cc * 16) = t[i]; } }
  if (b < NCLS) {
    const int r0 = cstart[b] + tot[b], r1 = cstart[b + 1];
    for (int i = tid; i < (r1 - r0) * 64; i += blockDim.x) *(uint4*)(P.h2qs + (size_t)(r0 + i / 64) * D + (i % 64) * 16) = make_uint4(0, 0, 0, 0);
    for (int i = tid; i < (r1 - r0); i += blockDim.x) { P.sidx[r0 + i] = 0; P.cws[(size_t)(r0 + i) * 2] = 0.f; P.cws[(size_t)(r0 + i) * 2 + 1] = 0.f; }
  }
  if (b == 0) {
    const int nt = cstart[NCLS] / 256;
    if (tid == 0) P.tileinfo[0] = nt;
    for (int t = tid; t < nt; t += blockDim.x) { int c = 0; while (c < NCLS - 1 && t * 256 >= cstart[c + 1]) ++c; P.tileinfo[1 + t] = c; }
  }
}

struct FinIn { uint2 x[4], m[4]; };
__device__ __forceinline__ void fin_load(const Params& P, int tok, int pos, int lane, FinIn& in) {
#pragma unroll
  for (int j = 0; j < 4; ++j) { const int k = j * 256 + lane * 4; in.x[j] = *(const uint2*)(P.x1 + (size_t)tok * D + k); in.m[j] = *(const uint2*)(P.moes + (size_t)pos * D + k); }
}
__device__ __forceinline__ void fin_row(const Params& P, int tok, int lane, const FinIn& in, const float4 (&g2)[4], const float4 (&lg)[4], const float4 (&lb)[4]) {
  float v[16];
#pragma unroll
  for (int j = 0; j < 4; ++j) {
    const uint2 xv = in.x[j], mv = in.m[j];
    v[4 * j] = ALPHA * __uint_as_float(xv.x << 16) + g2[j].x * __uint_as_float(mv.x << 16);
    v[4 * j + 1] = ALPHA * __uint_as_float(xv.x & 0xffff0000u) + g2[j].y * __uint_as_float(mv.x & 0xffff0000u);
    v[4 * j + 2] = ALPHA * __uint_as_float(xv.y << 16) + g2[j].z * __uint_as_float(mv.y << 16);
    v[4 * j + 3] = ALPHA * __uint_as_float(xv.y & 0xffff0000u) + g2[j].w * __uint_as_float(mv.y & 0xffff0000u);
  }
  float s = 0.f;
#pragma unroll
  for (int j = 0; j < 16; ++j) s += v[j];
  const float mean = wave_sum(s) * (1.f / 1024.f);
  float q = 0.f;
#pragma unroll
  for (int j = 0; j < 16; ++j) { const float dd = v[j] - mean; q += dd * dd; }
  const float rstd = rsqrtf(wave_sum(q) * (1.f / 1024.f) + 1e-5f);
#pragma unroll
  for (int j = 0; j < 4; ++j) {
    float4 o;
    o.x = (v[4 * j] - mean) * rstd * lg[j].x + lb[j].x; o.y = (v[4 * j + 1] - mean) * rstd * lg[j].y + lb[j].y;
    o.z = (v[4 * j + 2] - mean) * rstd * lg[j].z + lb[j].z; o.w = (v[4 * j + 3] - mean) * rstd * lg[j].w + lb[j].w;
    *(float4*)(P.out + (size_t)tok * D + j * 256 + lane * 4) = o;
  }
}
__device__ void phase_final(const Params& P) {
  const int tid_ = opaque_tid(); const int lane = tid_ & 63, wv = (blockIdx.x * blockDim.x + tid_) >> 6;
  const int tok0 = wv * 16;
  const float* md = P.mod + (tok0 / SEQ) * 6144;
  float4 g2[4], lg[4], lb[4];
#pragma unroll
  for (int j = 0; j < 4; ++j) { const int k = j * 256 + lane * 4; g2[j] = *(const float4*)(md + 5120 + k); lg[j] = *(const float4*)(P.ln2_g + k); lb[j] = *(const float4*)(P.ln2_b + k); }
  const int posl = P.perm[tok0 + (lane & 15)];
  FinIn inA, inB;
  fin_load(P, tok0, __shfl(posl, 0), lane, inA); fin_load(P, tok0 + 1, __shfl(posl, 1), lane, inB);
#pragma unroll 1
  for (int i = 0; i < 16; i += 2) {
    FinIn cA = inA, cB = inB;
    if (i + 2 < 16) { fin_load(P, tok0 + i + 2, __shfl(posl, i + 2), lane, inA); fin_load(P, tok0 + i + 3, __shfl(posl, i + 3), lane, inB); }
    fin_row(P, tok0 + i, lane, cA, g2, lg, lb); fin_row(P, tok0 + i + 1, lane, cB, g2, lg, lb);
  }
}

extern __shared__ __attribute__((aligned(16))) unsigned char dyn_lds[];

#define XB_TMO      128
#define XB_XCNT(j)  (256  + 64 * (j))
#define XB_XSUB(j)  (1280 + 64 * (j))
#define XB_XGEN(j)  (2304 + 64 * (j))
#define XB_TOP      3328
#define XB_TOPGEN   3392
#define XCD_BAR_WORDS 3456
#define XB_SPIN_CAP (1u << 22)
#define XLAS __attribute__((address_space(3)))
__device__ __forceinline__ unsigned xb_ld(unsigned* p)              { return __hip_atomic_load(p, __ATOMIC_RELAXED, __HIP_MEMORY_SCOPE_AGENT); }
__device__ __forceinline__ unsigned xb_add(unsigned* p, unsigned v) { return __hip_atomic_fetch_add(p, v, __ATOMIC_RELAXED, __HIP_MEMORY_SCOPE_AGENT); }
__device__ __forceinline__ unsigned xb_xcc_id() { return (unsigned)__builtin_amdgcn_s_getreg((3 << 11) | 20) & 0xFu; }
#define XB_SPIN(cond, bar) do { unsigned _sp = 0; while (cond) { __builtin_amdgcn_s_sleep(1); \
    if ((++_sp & 255u) == 0u) { if (xb_ld(&(bar)[XB_TMO])) break; if (_sp > XB_SPIN_CAP) { atomicAdd(&(bar)[XB_TMO], 1u); break; } } } } while (0)
struct XcdBarrier { unsigned* bar; unsigned x; volatile XLAS unsigned* st; };
__device__ __forceinline__ XcdBarrier xcd_barrier_post(unsigned* bar, volatile XLAS unsigned* st) {
    XcdBarrier b; b.bar = bar; b.x = xb_xcc_id(); b.st = st;
    if (threadIdx.x == 0) (void)xb_add(&bar[XB_XCNT(b.x)], 1u);
    return b;
}
__device__ __forceinline__ void xcd_barrier_complete(unsigned* bar, unsigned x, unsigned& nloc, unsigned& nx) {
    const unsigned G = gridDim.x * gridDim.y * gridDim.z;
    unsigned sum, cnt, mine, sp = 0u;
    for (;;) {
        sum = 0u; cnt = 0u; mine = 0u;
#pragma unroll
        for (unsigned j = 0; j < 16; ++j) { const unsigned c = xb_ld(&bar[XB_XCNT(j)]); sum += c; cnt += (c > 0u) ? 1u : 0u; mine = (j == x) ? c : mine; }
        if (sum == G) break;
        __builtin_amdgcn_s_sleep(1);
        if ((++sp & 255u) == 0u) { if (xb_ld(&bar[XB_TMO])) break; if (sp > XB_SPIN_CAP) { atomicAdd(&bar[XB_TMO], 1u); break; } }
    }
    nloc = mine > 0u ? mine : 1u; nx = cnt > 0u ? cnt : 1u;
}
__device__ __forceinline__ void xcd_barrier(const XcdBarrier& b) {
    asm volatile("s_waitcnt vmcnt(0)" ::: "memory");
    __syncthreads();
    if (opaque_tid() == 0) {
        unsigned* bar = b.bar;
        __builtin_amdgcn_s_waitcnt(0);
        unsigned nloc = b.st[0], nx = b.st[1];
        if (nloc == 0u) { xcd_barrier_complete(bar, b.x, nloc, nx); b.st[0] = nloc; b.st[1] = nx; }
        const unsigned old = xb_add(&bar[XB_XSUB(b.x)], 1u);
        const unsigned gen = old / nloc;
        if (old + 1u == (gen + 1u) * nloc) {
            __builtin_amdgcn_fence(__ATOMIC_RELEASE, "agent");
            asm volatile("s_waitcnt vmcnt(0)" ::: "memory");
            const unsigned og = xb_add(&bar[XB_TOP], 1u);
            const unsigned tg = og / nx;
            if (og + 1u == (tg + 1u) * nx) xb_add(&bar[XB_TOPGEN], 1u);
            else XB_SPIN(xb_ld(&bar[XB_TOPGEN]) == tg, bar);
            __builtin_amdgcn_fence(__ATOMIC_ACQUIRE, "agent");
            xb_add(&bar[XB_XGEN(b.x)], 1u);
            asm volatile("s_waitcnt vmcnt(0)" ::: "memory");
        } else {
            XB_SPIN(xb_ld(&bar[XB_XGEN(b.x)]) == gen, bar);
            __builtin_amdgcn_fence(__ATOMIC_ACQUIRE, "agent");
            asm volatile("s_waitcnt vmcnt(0)" ::: "memory");
        }
    }
    __syncthreads();
}

#ifndef REP_PRE
#define REP_PRE 1
#endif
#ifndef REP_HLN
#define REP_HLN 1
#endif
#ifndef REP_GEMM
#define REP_GEMM 1
#endif
#ifndef REP_GLAA
#define REP_GLAA 1
#endif
#ifndef REP_GLAB
#define REP_GLAB 1
#endif
#ifndef REP_CONV
#define REP_CONV 1
#endif
#ifndef REP_LN1
#define REP_LN1 1
#endif
#ifndef REP_SORT
#define REP_SORT 1
#endif
#ifndef REP_FIN
#define REP_FIN 1
#endif
#ifndef REP_BAR
#define REP_BAR 1
#endif
#define RUN_1(x) do { x; __syncthreads(); } while (0)
#define RUN_2(x) do { x; __syncthreads(); x; __syncthreads(); } while (0)
#define RUN_3(x) do { x; __syncthreads(); x; __syncthreads(); x; __syncthreads(); } while (0)
#define RUN__(n, x) RUN_##n(x)
#define RUN(n, x) RUN__(n, x)
#define GBAR() do { for (int _r = 0; _r < REP_BAR; ++_r) { XcdBarrier _b; _b.bar = P.ctrl; _b.x = xb_xcc_id(); _b.st = (volatile XLAS unsigned*)((XLAS unsigned char*)dyn_lds + MEGA_LDS - 16); xcd_barrier(_b); } } while (0)
__global__ __launch_bounds__(512, 2) void mega(Params P) {
  XLAS unsigned* stw = (XLAS unsigned*)((XLAS unsigned char*)dyn_lds + MEGA_LDS - 16);
  if (threadIdx.x < 4) stw[threadIdx.x] = 0u;
  if ((threadIdx.x & 63) == 0) { const unsigned hw = (unsigned)__builtin_amdgcn_s_getreg((6 << 11) | 4) & 63u; *(XLAS int*)((XLAS unsigned char*)dyn_lds + TIDTAB_OFF + hw * 4) = (int)(threadIdx.x >> 6); }
  __syncthreads();
  (void)xcd_barrier_post(P.ctrl, (volatile XLAS unsigned*)stw);
  RUN(REP_PRE, phase_pre(P, (float*)dyn_lds));
  GBAR();
  RUN(REP_HLN, phase_hln(P, (HLAS unsigned char*)dyn_lds));
  GBAR();
  RUN(REP_GEMM, phase_gemm1(P, (PG8_LAS unsigned char*)dyn_lds); phase_ctx_proj(P));
  GBAR();
  for (int stage = 0; stage < 2; ++stage) {
    if (((stage ^ (int)(blockIdx.x >> 3)) & 1) == 0) { RUN(REP_GLAA, gla::pass_a(P, (gla::ldsp)dyn_lds)); }
    else { RUN(REP_CONV, phase_conv(P)); }
  }
  GBAR();
  for (int stage = 0; stage < 2; ++stage) {
    if (((stage ^ (int)(blockIdx.x >> 3)) & 1) == 0) { RUN(REP_GLAB, gla::pass_b(P, (gla::ldsp)dyn_lds)); }
    else { phase_cvx(P, (float*)dyn_lds); }
    __syncthreads();
  }
  GBAR();
  RUN(REP_GEMM, phase_gemm2(P, (PG8_LAS unsigned char*)dyn_lds));
  GBAR();
  RUN(REP_LN1, phase_ln1_router(P, (float*)dyn_lds));
  GBAR();
  RUN(REP_GEMM, phase_moe_up(P, (PG8_LAS unsigned char*)dyn_lds));
  RUN(REP_GEMM, phase_moe_down(P, (PG8_LAS unsigned char*)dyn_lds));
  GBAR();
  RUN(REP_FIN, phase_final(P));
}

static inline size_t al256(size_t v) { return (v + 255) & ~(size_t)255; }

extern "C" void kernel_launch(void* const* d_in, const int* in_sizes, int n_in, void* d_out, int out_size, void* d_ws, size_t ws_size, hipStream_t stream) {
  Params P{};
  const float* const* in = (const float* const*)d_in;
  P.x = in[0]; P.c = in[1]; P.ctx = in[2]; P.c_ctx = in[3]; P.ln_in_g = in[4]; P.ln_in_b = in[5]; P.w_ada = in[6]; P.b_ada = in[7]; P.w_in = in[8];
  P.conv_w = in[9]; P.conv_b = in[10]; P.gw_f = in[11]; P.gb_f = in[12]; P.gw_b = in[13]; P.gb_b = in[14]; P.gla_g = in[15]; P.w_out = in[16];
  P.ln1_g = in[17]; P.ln1_b = in[18]; P.wgr = in[19]; P.bgr = in[20]; P.wer = in[21]; P.ber = in[22]; P.w1 = in[23]; P.w3 = in[24]; P.w2 = in[25];
  P.ln2_g = in[26]; P.ln2_b = in[27];
  P.out = (float*)d_out;
  unsigned char* w = (unsigned char*)d_ws; size_t off = 0;
  auto take = [&](size_t bytes) { unsigned char* r = w + off; off = al256(off + bytes); return r; };
  P.ctrl = (unsigned*)take(65536);
  P.mod = (float*)take(9 * 6144 * 4);
  P.WinT = (bf16_t*)take((size_t)3072 * 1024 * 2);
  P.WgT = (bf16_t*)take((size_t)256 * 1024 * 2);
  P.WoutT = (bf16_t*)take((size_t)1024 * 1024 * 2);
  P.W13Q = (unsigned char*)take((size_t)16 * 1024 * 1024);
  P.W2Q = (unsigned char*)take((size_t)16 * 1024 * 512);
  P.h2q = (unsigned char*)take((size_t)NTOK * D);
  P.h2qs = (unsigned char*)take((size_t)MOE_ROWS * D);
  P.actq = (unsigned char*)take((size_t)MOE_ROWS * D);
  P.gqd = (bf16_t*)P.h2q; P.gkinv = P.gqd + (size_t)2 * NTOK * 256; P.gke = P.gkinv + (size_t)2 * NTOK * 256;
  P.hc = (bf16_t*)take((size_t)NCTX * D * 2);
  P.stats = (float*)take((size_t)NTOK * 2 * 4);
  P.low = (float*)take((size_t)(NTOK + NCTX) * 32 * 4);
  P.pctx = (bf16_t*)take((size_t)NCTX * 1024 * 2);
  P.cls = (int*)take((size_t)NTOK * 4);
  P.cw = (float*)take((size_t)NTOK * 2 * 4);
  P.hist = (int*)take(256 * NCLS * 4);
  P.perm = (int*)take((size_t)NTOK * 4);
  P.sidx = (int*)take((size_t)MOE_ROWS * 4);
  P.tileinfo = (int*)take(1024);
  P.cws = (float*)take((size_t)MOE_ROWS * 2 * 4);
  P.gdec = (float*)take((size_t)2 * 512 * 4 * 64 * 4);
  P.Useg = (float*)take((size_t)512 * 8192 * 4);
  P.Dseg = (float*)take((size_t)512 * 64 * 4);
  P.hln = (bf16_t*)take((size_t)NTOK * D * 2); P.ymix = P.hln;
  P.p = (bf16_t*)take((size_t)NTOK * NP * 2);
  P.ybuf = P.p; P.x1 = P.p + (size_t)NTOK * D; P.h2 = P.p + (size_t)2 * NTOK * D;
  P.h2s = (bf16_t*)take((size_t)MOE_ROWS * D * 2); P.moes = P.h2s; P.opart = P.h2s; P.ctxS = (float*)P.h2s;
  if (off > ws_size) { fprintf(stderr, "workspace too small: need %zu have %zu\n", off, ws_size); return; }
  static bool said = false; if (!said) { said = true; fprintf(stderr, "workspace: need %zu have %zu\n", off, ws_size); }

  static int ready = 0;
  if (!ready) {
    if (hipFuncSetAttribute((const void*)mega, hipFuncAttributeMaxDynamicSharedMemorySize, MEGA_LDS) != hipSuccess) { fprintf(stderr, "hipFuncSetAttribute failed\n"); ready = -1; return; }
    int dev = 0, cus = 0, per_cu = 0;
    (void)hipGetDevice(&dev); (void)hipDeviceGetAttribute(&cus, hipDeviceAttributeMultiprocessorCount, dev);
    (void)hipOccupancyMaxActiveBlocksPerMultiprocessor(&per_cu, (const void*)mega, 512, MEGA_LDS);
    if (cus < 256 || per_cu < 1) { fprintf(stderr, "mega: needs 256 CUs with one resident block each (cus %d, per_cu %d)\n", cus, per_cu); ready = -1; return; }
    ready = 1;
  }
  if (ready < 0) return;
  (void)hipMemsetAsync(P.ctrl, 0, 65536, stream);
  void* args[] = {&P};
  hipError_t e = hipLaunchCooperativeKernel((const void*)mega, dim3(256), dim3(512), args, MEGA_LDS, stream);
  if (e != hipSuccess) fprintf(stderr, "cooperative launch failed: %s\n", hipGetErrorString(e));
}
```

```cpp
#include <hip/hip_runtime.h>
#include <stdint.h>
#include <stdio.h>

typedef unsigned short bf16_t;
constexpr int D = 1024, NB = 8, SEQ = 4096, NTOK = NB * SEQ, CTXL = 256, NCTX = NB * CTXL;
constexpr int DPROJ = 3104, NP = 3072;
constexpr int OFF_AB = 0, OFF_AC = 512, OFF_AX = 1024, OFF_Q = 1536, OFF_K = 1792, OFF_V = 2048, OFF_R = 2560;
constexpr int NCLS = 24, MOE_ROWS = NTOK + NCLS * 256, MOE_TILES = MOE_ROWS / 256;
constexpr float ALPHA = 1.189207115002721f;

struct Params {
  const float *x, *c, *ctx, *c_ctx, *ln_in_g, *ln_in_b, *w_ada, *b_ada, *w_in, *conv_w, *conv_b, *gw_f, *gb_f, *gw_b, *gb_b, *gla_g, *w_out,
      *ln1_g, *ln1_b, *wgr, *bgr, *wer, *ber, *w1, *w3, *w2, *ln2_g, *ln2_b;
  float* out;
  unsigned* ctrl;
  float* mod;
  bf16_t* WinT;
  bf16_t* WgT;
  bf16_t* WoutT;
  unsigned char* W13Q;
  unsigned char* W2Q;
  unsigned char* h2q;
  unsigned char* h2qs;
  unsigned char* actq;
  bf16_t* hln;
  bf16_t* hc;
  float* stats;
  float* low;
  bf16_t* p;
  bf16_t* pctx;
  float* ctxS;
  bf16_t* ymix;
  bf16_t* ybuf;
  bf16_t* x1;
  bf16_t* h2;
  int* cls;
  float* cw;
  int* hist;
  int* perm;
  int* sidx;
  int* tileinfo;
  float* cws;
  bf16_t* h2s;
  bf16_t* act;
  bf16_t* moes;
  bf16_t* gqd;
  bf16_t* gkinv;
  bf16_t* gke;
  float* gdec;
  float* Useg;
  float* Dseg;
  bf16_t* opart;
  float* o_f;
  float* o_b;
};

constexpr int MEGA_LDS = 160 * 1024, TIDTAB_OFF = MEGA_LDS - 16 - 256;
__device__ __forceinline__ int opaque_tid() {
  const unsigned hw = (unsigned)__builtin_amdgcn_s_getreg((6 << 11) | 4) & 63u;
  int lane; asm volatile("v_mbcnt_lo_u32_b32 %0, -1, 0\n\tv_mbcnt_hi_u32_b32 %0, -1, %0" : "=v"(lane));
  int wid = *(const __attribute__((address_space(3))) int*)(TIDTAB_OFF + hw * 4);
  wid = __builtin_amdgcn_readfirstlane(wid);
  int t = wid * 64 + lane; asm volatile("" : "+v"(t)); return t;
}
__device__ __forceinline__ float bf2f(bf16_t v) { return __uint_as_float(((unsigned)v) << 16); }
__device__ __forceinline__ bf16_t f2bf(float f) { return __builtin_bit_cast(bf16_t, (__bf16)f); }
typedef __bf16 bf16v2_t __attribute__((ext_vector_type(2)));
typedef float f32v2_t __attribute__((ext_vector_type(2)));
__device__ __forceinline__ unsigned pack2(float a, float b) { const f32v2_t v = {a, b}; return __builtin_bit_cast(unsigned, __builtin_convertvector(v, bf16v2_t)); }
__device__ __forceinline__ unsigned pack4_fp8(float a, float b, float c, float d) {
  a = __builtin_amdgcn_fmed3f(a, -448.f, 448.f); b = __builtin_amdgcn_fmed3f(b, -448.f, 448.f); c = __builtin_amdgcn_fmed3f(c, -448.f, 448.f); d = __builtin_amdgcn_fmed3f(d, -448.f, 448.f);
  unsigned w = 0; w = __builtin_amdgcn_cvt_pk_fp8_f32(a, b, w, false); w = __builtin_amdgcn_cvt_pk_fp8_f32(c, d, w, true); return w;
}
__device__ __forceinline__ float wave_sum(float v) {
#define DPP_ADD_(ctrl, rmask) v += __int_as_float(__builtin_amdgcn_update_dpp(0, __float_as_int(v), ctrl, rmask, 0xF, true))
  DPP_ADD_(0xB1, 0xF); DPP_ADD_(0x4E, 0xF); DPP_ADD_(0x141, 0xF); DPP_ADD_(0x140, 0xF); DPP_ADD_(0x142, 0xA); DPP_ADD_(0x143, 0xC);
#undef DPP_ADD_
  return __int_as_float(__builtin_amdgcn_readlane(__float_as_int(v), 63));
}
__device__ __forceinline__ float siluf(float v) { return v * __builtin_amdgcn_rcpf(1.f + __expf(-v)); }
__device__ __forceinline__ float logsigmoidf(float z) { return fminf(z, 0.f) - log1pf(__expf(-fabsf(z))); }
__device__ __forceinline__ float logsigmoid_fast(float z) { return fminf(z, 0.f) - 0.6931471806f * __builtin_amdgcn_logf(1.f + __builtin_amdgcn_exp2f(-1.4426950409f * fabsf(z))); }

__device__ __forceinline__ int rowmap(int n, int mode) { return mode == 0 ? n : ((n >> 7) * 256 + (mode == 2 ? 128 : 0) + (n & 127)); }
struct CvJob { const float* src; bf16_t* dst; int ld_src, k0, n0, nvalid, nbase, ldd, mode, q8; };
__device__ __forceinline__ void cv_decode(const Params& P, int ti, CvJob& j) {
  j.nvalid = 64; j.nbase = 0; j.mode = 0; j.q8 = 0;
  if (ti < 384) { const int kt = ti % 8, nt = ti / 8; j.src = P.w_in; j.ld_src = DPROJ; j.k0 = kt * 128; j.n0 = nt * 64; j.dst = P.WinT; j.ldd = 1024;
    if (j.n0 >= OFF_AC && j.n0 < OFF_AX + 512) { const int isx = j.n0 >= OFF_AX, c = j.n0 - (isx ? OFF_AX : OFF_AC); j.nbase = j.n0 - ((2 + (c >> 7)) * 256 + isx * 128 + (c & 127)); } }
  else if (ti < 392) { const int kt = ti - 384; j.src = P.w_in; j.ld_src = DPROJ; j.k0 = kt * 128; j.n0 = 3072; j.nvalid = 32; j.nbase = 3072; j.dst = P.WgT; j.ldd = 1024; }
  else if (ti < 520) { const int t = ti - 392, kt = t % 8, nt = t / 8; j.src = P.w_out; j.ld_src = 1024; j.k0 = kt * 128; j.n0 = nt * 64; j.dst = P.WoutT; j.ldd = 1024; }
  else if (ti < 2568) { const int t = ti - 520, e = t / 128, r = t % 128, which = r / 64, r2 = r % 64, kt = r2 % 8, nt = r2 / 8;
    j.src = (which ? P.w3 : P.w1) + (size_t)e * 1024 * 512; j.ld_src = 512; j.k0 = kt * 128; j.n0 = nt * 64; j.dst = (bf16_t*)(P.W13Q + (size_t)e * 1024 * 1024); j.ldd = 1024; j.mode = 1 + which; j.q8 = 1; }
  else { const int t = ti - 2568, e = t / 64, r = t % 64, kt = r % 4, nt = r / 4; j.src = P.w2 + (size_t)e * 512 * 1024; j.ld_src = 1024; j.k0 = kt * 128; j.n0 = nt * 64; j.dst = (bf16_t*)(P.W2Q + (size_t)e * 1024 * 512); j.ldd = 512; j.q8 = 1; }
}
typedef float cvf4 __attribute__((ext_vector_type(4)));
__device__ __forceinline__ void cv_load(const CvJob& j, int tid, cvf4 (&r)[4]) {
  if (j.q8) { const int kq = (tid >> 2) & 31, n4 = 4 * ((tid & 3) + 4 * (tid >> 7)); const float* p = j.src + (size_t)(j.k0 + 4 * kq) * j.ld_src + j.n0 + n4;
#pragma unroll
    for (int i = 0; i < 4; ++i) r[i] = *(const cvf4*)(p + (size_t)i * j.ld_src);
    return; }
  const int kp = (tid >> 2) & 63;
#pragma unroll
  for (int i = 0; i < 2; ++i) { const int n4 = 4 * ((tid & 3) + 4 * ((tid >> 8) & 1) + 8 * i);
    if (n4 < j.nvalid) { const float* p = j.src + (size_t)(j.k0 + 2 * kp) * j.ld_src + j.n0 + n4; r[2 * i] = *(const cvf4*)p; r[2 * i + 1] = *(const cvf4*)(p + j.ld_src); } else { r[2 * i] = (cvf4){0.f, 0.f, 0.f, 0.f}; r[2 * i + 1] = r[2 * i]; } }
}
__device__ __forceinline__ void cv_to_lds(const CvJob& j, int tid, const cvf4 (&r)[4], bf16_t* T) {
  if (j.q8) { const int kq = (tid >> 2) & 31, n4 = 4 * ((tid & 3) + 4 * (tid >> 7)); unsigned* t = (unsigned*)((unsigned char*)T + n4 * 144 + 4 * kq);
#pragma unroll
    for (int c = 0; c < 4; ++c) t[36 * c] = pack4_fp8(r[0][c] * 8.f, r[1][c] * 8.f, r[2][c] * 8.f, r[3][c] * 8.f);
    return; }
  const int kp = (tid >> 2) & 63;
#pragma unroll
  for (int i = 0; i < 2; ++i) { const int n4 = 4 * ((tid & 3) + 4 * ((tid >> 8) & 1) + 8 * i);
    if (n4 < j.nvalid) { unsigned* t = (unsigned*)(T + n4 * 136 + 2 * kp);
      t[0] = pack2(r[2 * i][0], r[2 * i + 1][0]); t[68] = pack2(r[2 * i][1], r[2 * i + 1][1]); t[136] = pack2(r[2 * i][2], r[2 * i + 1][2]); t[204] = pack2(r[2 * i][3], r[2 * i + 1][3]); } }
}
__device__ __forceinline__ void cv_store(const CvJob& j, int tid, const bf16_t* T) {
  if (j.q8) { const int n = tid >> 3, kc = (tid & 7) * 16;
    *(uint4*)((unsigned char*)j.dst + (size_t)rowmap(j.n0 + n, j.mode) * j.ldd + j.k0 + kc) = *(const uint4*)((const unsigned char*)T + n * 144 + kc); return; }
#pragma unroll
  for (int i = 0; i < 2; ++i) { const int cidx = tid + 512 * i, n = cidx / 16, kc = (cidx % 16) * 8;
    if (n < j.nvalid) *(uint4*)(j.dst + (size_t)rowmap(j.n0 - j.nbase + n, j.mode) * j.ldd + j.k0 + kc) = *(const uint4*)(T + n * 136 + kc); }
}
__device__ void phase_pre(const Params& P, float* lds) {
  float* s = lds; float* red = lds + 9 * 1024;
  const int tid = opaque_tid();
  const int cg = tid % 6, kg = tid / 6, g0 = blockIdx.x * 6;
  cvf4 w[13];
  if (kg < 85) {
#pragma unroll
    for (int i = 0; i < 13; ++i) { const int k = kg + 85 * i; w[i] = (k < 1024) ? *(const cvf4*)(P.w_ada + (size_t)k * 6144 + (size_t)(g0 + cg) * 4) : (cvf4){0.f, 0.f, 0.f, 0.f}; }
  } else {
#pragma unroll
    for (int i = 0; i < 13; ++i) w[i] = (cvf4){0.f, 0.f, 0.f, 0.f};
  }
  CvJob job; cvf4 r[4]; int ti = blockIdx.x;
  cv_decode(P, ti, job); cv_load(job, tid, r);
  for (int i = tid; i < 9 * 1024; i += 512) { const float v = (i < 8 * 1024) ? P.c[i] : P.c_ctx[i - 8192]; s[i] = siluf(v); }
  __syncthreads();
  if (kg < 85) {
    float a[9][4];
#pragma unroll
    for (int rr = 0; rr < 9; ++rr) { a[rr][0] = a[rr][1] = a[rr][2] = a[rr][3] = 0.f; }
#pragma unroll
    for (int i = 0; i < 13; ++i) { const int k = kg + 85 * i; if (k < 1024) {
#pragma unroll
        for (int rr = 0; rr < 9; ++rr) { const float sv = s[rr * 1024 + k]; a[rr][0] += sv * w[i][0]; a[rr][1] += sv * w[i][1]; a[rr][2] += sv * w[i][2]; a[rr][3] += sv * w[i][3]; } } }
#pragma unroll
    for (int rr = 0; rr < 9; ++rr)
#pragma unroll
      for (int jj = 0; jj < 4; ++jj) red[kg * 216 + rr * 24 + cg * 4 + jj] = a[rr][jj];
  }
  __syncthreads();
  if (tid < 216) { float t = 0.f; for (int kk = 0; kk < 85; ++kk) t += red[kk * 216 + tid]; const int rr = tid / 24, cc = tid % 24, col = g0 * 4 + cc; P.mod[rr * 6144 + col] = t + P.b_ada[col]; }
  __syncthreads();
  bf16_t* T = (bf16_t*)lds;
  while (ti < 520) {
    cv_to_lds(job, tid, r, T);
    const int tn = ti + gridDim.x;
    CvJob nj = job; cvf4 rn[4] = {r[0], r[1], r[2], r[3]};
    if (tn < 520) { cv_decode(P, tn, nj); cv_load(nj, tid, rn); }
    __syncthreads();
    cv_store(job, tid, T);
    __syncthreads();
    job = nj; r[0] = rn[0]; r[1] = rn[1]; r[2] = rn[2]; r[3] = rn[3];
    ti = tn;
  }
  uint4* z = (uint4*)(P.WgT + 32 * 1024);
  for (int i = blockIdx.x * 512 + tid; i < 224 * 1024 / 8; i += gridDim.x * 512) z[i] = make_uint4(0, 0, 0, 0);
}

__device__ void phase_cvx(const Params& P, float* lds) {
  const int tid = opaque_tid();
  bf16_t* T = (bf16_t*)lds;
  int ti = 520 + blockIdx.x;
  CvJob job; cvf4 r[4];
  cv_decode(P, ti, job); cv_load(job, tid, r);
  __syncthreads();
  while (ti < 3592) {
    cv_to_lds(job, tid, r, T);
    const int tn = ti + gridDim.x;
    CvJob nj = job; cvf4 rn[4] = {r[0], r[1], r[2], r[3]};
    if (tn < 3592) { cv_decode(P, tn, nj); cv_load(nj, tid, rn); }
    __syncthreads();
    cv_store(job, tid, T);
    __syncthreads();
    job = nj; r[0] = rn[0]; r[1] = rn[1]; r[2] = rn[2]; r[3] = rn[3];
    ti = tn;
  }
}

namespace hl {
typedef short bf16x8 __attribute__((ext_vector_type(8)));
typedef float f32x4 __attribute__((ext_vector_type(4)));
typedef unsigned u32x4 __attribute__((ext_vector_type(4)));
#define HLAS __attribute__((address_space(3)))
constexpr int WST = 2064;
__device__ __forceinline__ void ln_row(const float* src, const HLAS float* GB, bf16_t* dst, float* stats, int lane) {
    float v[16];
#pragma unroll
    for (int j = 0; j < 4; ++j) { const f32x4 t = __builtin_nontemporal_load((const f32x4*)(src + j * 256 + lane * 4)); v[4 * j] = t[0]; v[4 * j + 1] = t[1]; v[4 * j + 2] = t[2]; v[4 * j + 3] = t[3]; }
    float s = 0.f;
#pragma unroll
    for (int j = 0; j < 16; ++j) s += v[j];
    const float mean = wave_sum(s) * (1.f / 1024.f);
    float q = 0.f;
#pragma unroll
    for (int j = 0; j < 16; ++j) { const float d = v[j] - mean; q += d * d; }
    const float rstd = rsqrtf(wave_sum(q) * (1.f / 1024.f) + 1e-5f);
    if (stats && lane == 0) { stats[0] = mean; stats[1] = rstd; }
#pragma unroll
    for (int j = 0; j < 4; ++j) {
        const int k = j * 256 + lane * 4;
        const f32x4 g = *(const HLAS f32x4*)(GB + k), bb = *(const HLAS f32x4*)(GB + 1024 + k);
        const float h0 = (v[4 * j] - mean) * rstd * g[0] + bb[0], h1 = (v[4 * j + 1] - mean) * rstd * g[1] + bb[1];
        const float h2 = (v[4 * j + 2] - mean) * rstd * g[2] + bb[2], h3 = (v[4 * j + 3] - mean) * rstd * g[3] + bb[3];
        uint2 w; w.x = pack2(h0, h1); w.y = pack2(h2, h3); *(uint2*)(dst + k) = w;
    }
}
}
__device__ void phase_hln(const Params& P, HLAS unsigned char* lds) {
    const int tid = opaque_tid(), lane = tid & 63, wid = tid >> 6;
    { hl::u32x4 wt[8];
#pragma unroll
      for (int u = 0; u < 8; ++u) { const int i = tid + 512 * u, n = i >> 7, c = i & 127; wt[u] = *(const hl::u32x4*)(P.WgT + (size_t)n * 1024 + c * 8); }
#pragma unroll
      for (int u = 0; u < 8; ++u) { const int i = tid + 512 * u, n = i >> 7, c = i & 127; *(HLAS hl::u32x4*)(lds + n * hl::WST + c * 16) = wt[u]; } }
    const int R0 = blockIdx.x * 128 + wid * 16;
    HLAS float* GB = (HLAS float*)(lds + 32 * hl::WST);
    { float lsc[4], lsh[4], lg_[4], lb_[4];
#pragma unroll
      for (int u = 0; u < 4; ++u) { const int i = tid + 512 * u, which = i >> 10, k = i & 1023; const float* md = P.mod + (which ? 8 : R0 / SEQ) * 6144; lsc[u] = md[1024 + k]; lsh[u] = md[k]; lg_[u] = P.ln_in_g[k]; lb_[u] = P.ln_in_b[k]; }
#pragma unroll
      for (int u = 0; u < 4; ++u) { const int i = tid + 512 * u, which = i >> 10, k = i & 1023; const float sc1 = 1.f + lsc[u]; GB[which * 2048 + k] = lg_[u] * sc1; GB[which * 2048 + 1024 + k] = lb_[u] * sc1 + lsh[u]; } }
    __syncthreads();
    for (int rr = 0; rr < 16; ++rr) { const int row = R0 + rr; hl::ln_row(P.x + (size_t)row * D, GB, P.hln + (size_t)row * D, P.stats + row * 2, lane); }
    { const int crow = blockIdx.x * 8 + wid; hl::ln_row(P.ctx + (size_t)crow * D, GB + 2048, P.hc + (size_t)crow * D, nullptr, lane); }
    asm volatile("s_waitcnt vmcnt(0)" ::: "memory");
    __syncthreads();
    const int r16 = lane & 15, q = lane >> 4;
    hl::f32x4 a0 = {0.f, 0.f, 0.f, 0.f}, a1 = {0.f, 0.f, 0.f, 0.f};
    const bf16_t* arow = P.hln + (size_t)(R0 + r16) * D + 8 * q;
#pragma unroll 8
    for (int ks = 0; ks < 32; ++ks) {
        const hl::bf16x8 a = *(const hl::bf16x8*)(arow + 32 * ks);
        const hl::bf16x8 b0 = *(const HLAS hl::bf16x8*)(lds + r16 * hl::WST + (32 * ks + 8 * q) * 2), b1 = *(const HLAS hl::bf16x8*)(lds + (16 + r16) * hl::WST + (32 * ks + 8 * q) * 2);
        a0 = __builtin_amdgcn_mfma_f32_16x16x32_bf16(a, b0, a0, 0, 0, 0); a1 = __builtin_amdgcn_mfma_f32_16x16x32_bf16(a, b1, a1, 0, 0, 0);
    }
#pragma unroll
    for (int j = 0; j < 4; ++j) { float* lp = P.low + (size_t)(R0 + 4 * q + j) * 32; lp[r16] = a0[j]; lp[16 + r16] = a1[j]; }
}

namespace pg8 {
#define PG8_LAS __attribute__((address_space(3)))
typedef short bf16x8 __attribute__((ext_vector_type(8)));
typedef float f32x4 __attribute__((ext_vector_type(4)));
typedef unsigned u32x4 __attribute__((ext_vector_type(4)));
constexpr int BM = 256, BK = 64, HALF = 128, HTB = HALF * BK * 2, STAGE_BYTES = 8 * HTB, NXCD = 8, WGM = 8;
__host__ __device__ __forceinline__ int lds_byte(int r, int c) { const int st = (r >> 4) * 2 + (c >> 5), rr = r & 15, cc = c & 31, ob = rr * 64 + cc * 2; return st * 1024 + (ob ^ (((ob >> 9) & 1) << 5)); }
__host__ __device__ __forceinline__ void stage_rc(int b, int& R, int& C) { const int st = b / 1024, sb = b % 1024, swz = sb ^ (((sb >> 9) & 1) << 5); R = (st >> 1) * 16 + swz / 64; C = (st & 1) * 32 + (swz % 64) / 2; }
__host__ __device__ __forceinline__ int perm32(int rho) { const int n = rho >> 4, i = rho & 15; return 8 * (i >> 2) + 4 * n + (i & 3); }
__device__ __forceinline__ unsigned cvt_pk_bf16(float lo, float hi) { unsigned r; asm volatile("v_cvt_pk_bf16_f32 %0, %1, %2" : "=v"(r) : "v"(lo), "v"(hi)); return r; }

template <class T> struct sched_waits { static constexpr bool v = false; };
template <class T> struct epi_publishes { static constexpr bool v = false; };
struct Unit { const char* A; const char* B; const char* B2; int pm, pn, aux; };
struct GemmCfg { int lda, ldb, nt, ksplit, ldb2, ksplit2; };

__device__ __forceinline__ void static_order(int L, int nM, int nN, int& pm, int& pn) {
    const int nwg = nM * nN; int wgid = L;
    { const int q = nwg / NXCD, r = nwg % NXCD, xcd = wgid % NXCD, off = wgid / NXCD; wgid = (xcd < r ? xcd * (q + 1) : r * (q + 1) + (xcd - r) * q) + off; }
    const int nig = WGM * nN, gid = wgid / nig, fm = gid * WGM, gsz = (nM - fm) < WGM ? (nM - fm) : WGM;
    pm = fm + ((wgid % nig) % gsz); pn = (wgid % nig) / gsz;
}

template <int MODE, bool FP8, class Epi, class Sched>
__device__ __forceinline__ void gemm_phase(PG8_LAS unsigned char* lds, const GemmCfg g, const Sched& S, const Epi& E) {
    const int tid = opaque_tid(), wid = __builtin_amdgcn_readfirstlane(tid >> 6), lane = tid & 63, wr = wid >> 2, wc = wid & 3, fr = lane & 15, fq = lane >> 4;
    typedef int pg8_i32x4 __attribute__((ext_vector_type(4))); typedef int pg8_i32x8 __attribute__((ext_vector_type(8)));
    constexpr bool GATHER = MODE == 1, MIXED = MODE == 2, WAITS = MIXED || sched_waits<Sched>::v, PUBL = epi_publishes<Epi>::v; constexpr int ES = FP8 ? 1 : 2;
    const int nt = g.nt;
    unsigned voffA[2], voffB[2], voffB2[2];
#pragma unroll
    for (int i = 0; i < 2; ++i) { int R, C; stage_rc(tid * 16 + i * 8192, R, C); const int Rb = (R & ~31) + perm32(R & 31);
        voffA[i] = (unsigned)(R * g.lda * ES + 2 * C); voffB[i] = (unsigned)(Rb * g.ldb * ES + 2 * C); voffB2[i] = (unsigned)(Rb * g.ldb2 * ES + 2 * C); }
    const PG8_LAS int* gidx = (const PG8_LAS int*)(lds + STAGE_BYTES);
    unsigned vAc[2][2], vAn[2][2];
#define PG8_GIDX(ui_, vo) do { _Pragma("unroll") for (int _i = 0; _i < 2; ++_i) { int _R, _C; stage_rc(tid * 16 + _i * 8192, _R, _C); _Pragma("unroll") for (int _h = 0; _h < 2; ++_h) \
        vo[_h][_i] = (unsigned)(gidx[(ui_) * 256 + _h * 128 + _R] * g.lda * ES + 2 * _C); } } while (0)
#define PG8_STAGE_A(bufoff, base, h, nx) do { if constexpr (GATHER) { unsigned _vo[2] = {(nx) ? vAn[h][0] : vAc[h][0], (nx) ? vAn[h][1] : vAc[h][1]}; PG8_STAGE(bufoff, base, _vo); } \
        else { PG8_STAGE(bufoff, (base) + (h) * hstepA, voffA); } } while (0)
    const size_t kstep = (size_t)(BK * 2);
    const size_t hstepA = (size_t)HALF * g.lda * ES, hstepB = (size_t)HALF * g.ldb * ES, hstepB2 = (size_t)HALF * g.ldb2 * ES;
    const unsigned ldsw = (unsigned)wid * 1024u;
    const int aoff = lds_byte(wr * 64 + fr, fq * 8), boff = lds_byte(wc * 32 + fr, fq * 8);
#define PG8_SA(b, h) (((b) * 2 + (h)) * HTB)
#define PG8_SB(b, h) ((4 + (b) * 2 + (h)) * HTB)
#define PG8_STAGE(bufoff, gbase, voff) do { _Pragma("unroll") for (int _i = 0; _i < 2; ++_i) { unsigned _o = (voff)[_i]; asm volatile("" : "+v"(_o));   \
        __builtin_amdgcn_global_load_lds((const unsigned*)((const char*)(gbase) + _o), (PG8_LAS unsigned*)(lds + (bufoff) + ldsw + _i * 8192), 16, 0, 0); } } while (0)
#define PG8_LDA(dst, b, h) do { if constexpr (FP8) { _Pragma("unroll") for (int m = 0; m < 4; ++m) { dst##q[m].lo = *(const PG8_LAS pg8_i32x4*)(lds + PG8_SA(b, h) + aoff + m * 2048); dst##q[m].hi = *(const PG8_LAS pg8_i32x4*)(lds + PG8_SA(b, h) + aoff + m * 2048 + 1024); } } \
        else { _Pragma("unroll") for (int m = 0; m < 4; ++m) _Pragma("unroll") for (int k = 0; k < 2; ++k) dst[m][k] = *(const PG8_LAS bf16x8*)(lds + PG8_SA(b, h) + aoff + m * 2048 + k * 1024); } } while (0)
#define PG8_LDB(dst, b, h) do { if constexpr (FP8) { _Pragma("unroll") for (int n = 0; n < 2; ++n) { dst##q[n].lo = *(const PG8_LAS pg8_i32x4*)(lds + PG8_SB(b, h) + boff + n * 2048); dst##q[n].hi = *(const PG8_LAS pg8_i32x4*)(lds + PG8_SB(b, h) + boff + n * 2048 + 1024); } } \
        else { _Pragma("unroll") for (int n = 0; n < 2; ++n) _Pragma("unroll") for (int k = 0; k < 2; ++k) dst[n][k] = *(const PG8_LAS bf16x8*)(lds + PG8_SB(b, h) + boff + n * 2048 + k * 1024); } } while (0)
#define PG8_CAT(v) (v)
#define PG8_MMA(ai, bj, At, Bt) do { __builtin_amdgcn_s_setprio(1); \
        if constexpr (FP8) { _Pragma("unroll") for (int m = 0; m < 4; ++m) _Pragma("unroll") for (int n = 0; n < 2; ++n) \
            acc[ai][bj][m][n] = __builtin_amdgcn_mfma_scale_f32_16x16x128_f8f6f4(Bt##q[n], At##q[m], acc[ai][bj][m][n], 0, 0, 0, 0x7c7c7c7c, 0, 0x7c7c7c7c); } \
        else { _Pragma("unroll") for (int m = 0; m < 4; ++m) _Pragma("unroll") for (int n = 0; n < 2; ++n) _Pragma("unroll") for (int k = 0; k < 2; ++k) \
            acc[ai][bj][m][n] = __builtin_amdgcn_mfma_f32_16x16x32_bf16(Bt[n][k], At[m][k], acc[ai][bj][m][n], 0, 0, 0); } \
        __builtin_amdgcn_s_setprio(0); } while (0)
#define PG8_WAIT_V(n) asm volatile("s_waitcnt vmcnt(" #n ")" ::: "memory")
#define PG8_WAIT_L(n) asm volatile("s_waitcnt lgkmcnt(" #n ")" ::: "memory")
#define PG8_BAR __builtin_amdgcn_s_barrier()
#define PG8_SCHED __builtin_amdgcn_sched_barrier(0)
#define PG8_KSP(u) ((MIXED && (u).aux) ? g.ksplit2 : g.ksplit)
#define PG8_BK(u, t) ((t) < PG8_KSP(u) ? (u).B + (size_t)(t) * kstep : (u).B2 + (size_t)((t) - PG8_KSP(u)) * kstep)
#define PG8_VB2(i_) (FP8 ? (((voffB[i_] & ~1023u) >> 1) + (voffB[i_] & 1023u)) : voffB2[i_])
#define PG8_STAGE_B(bufoff, base, h, kd) do { if constexpr (MIXED) { unsigned _vb[2] = {(kd) ? PG8_VB2(0) : voffB[0], (kd) ? PG8_VB2(1) : voffB[1]}; PG8_STAGE(bufoff, (base) + (h) * ((kd) ? hstepB2 : hstepB), _vb); } \
        else { PG8_STAGE(bufoff, (base) + (h) * hstepB, voffB); } } while (0)
    Unit cur, nxt; int ui = 0; int pub_pm = -1;
    if (!S.next(0, cur)) return;
    f32x4 acc[2][2][4][2];
#pragma unroll
    for (int a = 0; a < 2; ++a)
#pragma unroll
        for (int b = 0; b < 2; ++b)
#pragma unroll
            for (int m = 0; m < 4; ++m)
#pragma unroll
                for (int n = 0; n < 2; ++n) acc[a][b][m][n] = (f32x4){0.f, 0.f, 0.f, 0.f};
    bf16x8 At[4][2], B0[2][2], B1[2][2];
    pg8_i32x8 Atq[4], B0q[2], B1q[2];
    {
        const char* cA = cur.A; const char* b0 = PG8_BK(cur, 0); const char* b1 = PG8_BK(cur, 1);
        if constexpr (WAITS) S.a_ready(cur);
        if constexpr (GATHER) { PG8_GIDX(0, vAc); }
        const int kc = cur.aux;
        PG8_STAGE_B(PG8_SB(0, 0), b0, 0, kc); PG8_STAGE_B(PG8_SB(0, 1), b0, 1, kc); PG8_STAGE_A(PG8_SA(0, 0), cA, 0, false); PG8_STAGE_A(PG8_SA(0, 1), cA, 1, false);
        if (wr == 1) PG8_BAR;
        PG8_WAIT_V(2); PG8_BAR;
        PG8_STAGE_B(PG8_SB(1, 0), b1, 0, kc); PG8_STAGE_A(PG8_SA(1, 0), cA + kstep, 0, false); PG8_STAGE_B(PG8_SB(1, 1), b1, 1, kc);
        PG8_WAIT_V(6); PG8_BAR;
    }
    for (;;) {
        const bool has_next = S.next(ui + 1, nxt);
        if (!has_next) nxt = cur;
        if constexpr (GATHER) { PG8_GIDX(has_next ? ui + 1 : ui, vAn); }
        const char* cA = cur.A;
#pragma unroll 1
        for (int t = 0; t < nt; t += 2) {
            const bool last = (t == nt - 2);
            const char* a1 = cA + (size_t)(t + 1) * kstep;
            const char* a2 = last ? nxt.A : cA + (size_t)(t + 2) * kstep;
            const char* a3 = a2 + kstep;
            const char* b2 = last ? PG8_BK(nxt, 0) : PG8_BK(cur, t + 2);
            const char* b3 = last ? PG8_BK(nxt, 1) : PG8_BK(cur, t + 3);
            const int kb = last ? nxt.aux : cur.aux;
            if constexpr (WAITS) { if (last && has_next) S.a_ready(nxt); }
            PG8_LDB(B0, 0, 0); PG8_LDB(B1, 0, 1); PG8_SCHED; PG8_LDA(At, 0, 0); PG8_STAGE_A(PG8_SA(1, 1), a1, 1, false);
            PG8_WAIT_V(8); PG8_WAIT_L(0); PG8_BAR;
            if constexpr (PUBL) { if (t == 2 && pub_pm >= 0) { if (wid == 0 && lane == 0) E.publish(pub_pm); pub_pm = -1; } }
            PG8_MMA(0, 0, At, B0); PG8_MMA(0, 1, At, B1); PG8_BAR; PG8_SCHED;
            PG8_LDA(At, 0, 1); PG8_STAGE_B(PG8_SB(0, 0), b2, 0, kb); PG8_STAGE_B(PG8_SB(0, 1), b2, 1, kb); PG8_STAGE_A(PG8_SA(0, 0), a2, 0, last);
            PG8_WAIT_V(8); PG8_WAIT_L(0); PG8_BAR; PG8_MMA(1, 0, At, B0); PG8_MMA(1, 1, At, B1); PG8_BAR; PG8_SCHED;
            PG8_LDB(B0, 1, 0); PG8_LDB(B1, 1, 1); PG8_SCHED; PG8_LDA(At, 1, 0); PG8_STAGE_A(PG8_SA(0, 1), a2, 1, last);
            PG8_WAIT_V(8); PG8_WAIT_L(0); PG8_BAR; PG8_MMA(0, 0, At, B0); PG8_MMA(0, 1, At, B1); PG8_BAR; PG8_SCHED;
            PG8_LDA(At, 1, 1); PG8_STAGE_B(PG8_SB(1, 0), b3, 0, kb); PG8_STAGE_B(PG8_SB(1, 1), b3, 1, kb); PG8_STAGE_A(PG8_SA(1, 0), a3, 0, last);
            PG8_WAIT_V(8); PG8_WAIT_L(0); PG8_BAR; PG8_MMA(1, 0, At, B0); PG8_MMA(1, 1, At, B1); PG8_BAR; PG8_SCHED;
        }
        if (wr == 0) PG8_BAR;
        E(acc, cur, wr, wc, fr, fq);
        if constexpr (PUBL) pub_pm = cur.pm;
        if (!has_next) break;
#pragma unroll
        for (int a = 0; a < 2; ++a)
#pragma unroll
            for (int b = 0; b < 2; ++b)
#pragma unroll
                for (int m = 0; m < 4; ++m)
#pragma unroll
                    for (int n = 0; n < 2; ++n) acc[a][b][m][n] = (f32x4){0.f, 0.f, 0.f, 0.f};
        cur = nxt; ++ui;
        if constexpr (GATHER) { _Pragma("unroll") for (int _h = 0; _h < 2; ++_h) _Pragma("unroll") for (int _i = 0; _i < 2; ++_i) vAc[_h][_i] = vAn[_h][_i]; }
        if (wr == 1) PG8_BAR;
    }
    PG8_WAIT_V(0);
    PG8_BAR;
    if constexpr (PUBL) { if (pub_pm >= 0 && wid == 0 && lane == 0) E.publish(pub_pm); }
#undef PG8_SA
#undef PG8_SB
#undef PG8_STAGE
#undef PG8_LDA
#undef PG8_LDB
#undef PG8_MMA
#undef PG8_CAT
#undef PG8_WAIT_V
#undef PG8_WAIT_L
#undef PG8_BAR
#undef PG8_SCHED
#undef PG8_BK
#undef PG8_KSP
#undef PG8_STAGE_B
#undef PG8_VB2
#undef PG8_GIDX
#undef PG8_STAGE_A
}

struct EpiStore {
    bf16_t* p; bf16_t* pctx; int mode;
    __device__ __forceinline__ void operator()(const f32x4 (&acc)[2][2][4][2], const Unit& u, int wr_, int wc_, int fr_, int fq_) const {
        const int t_ = opaque_tid(), wid_ = __builtin_amdgcn_readfirstlane(t_ >> 6), wr = wid_ >> 2, wc = wid_ & 3, fr = t_ & 15, fq = (t_ & 63) >> 4; (void)wr_; (void)wc_; (void)fr_; (void)fq_;
        bf16_t* base; int ldc;
        if (mode == 0) { if (u.aux) { base = pctx; ldc = 1024; } else { base = p; ldc = 3072; } } else { base = p; ldc = 1024; }
        const int row0 = u.pm * BM + wr * 64 + fr, col0 = u.pn * BM + wc * 32 + 8 * fq;
        if (mode == 0 && u.pn >= 2 && u.pn < 6) {
            const int colu = 512 + (u.pn - 2) * 128 + wc * 32 + 8 * fq;
#pragma unroll
            for (int ai = 0; ai < 2; ++ai)
#pragma unroll
                for (int m = 0; m < 4; ++m) { const f32x4 a0 = acc[ai][0][m][0], a1 = acc[ai][0][m][1], x0 = acc[ai][1][m][0], x1 = acc[ai][1][m][1];
                    u32x4 w; w.x = cvt_pk_bf16(a0[0] * x0[0], a0[1] * x0[1]); w.y = cvt_pk_bf16(a0[2] * x0[2], a0[3] * x0[3]); w.z = cvt_pk_bf16(a1[0] * x1[0], a1[1] * x1[1]); w.w = cvt_pk_bf16(a1[2] * x1[2], a1[3] * x1[3]);
                    *(u32x4*)(base + (size_t)(row0 + ai * HALF + m * 16) * ldc + colu) = w; }
            return;
        }
#pragma unroll
        for (int ai = 0; ai < 2; ++ai)
#pragma unroll
            for (int m = 0; m < 4; ++m) { bf16_t* rowp = base + (size_t)(row0 + ai * HALF + m * 16) * ldc + col0;
#pragma unroll
                for (int bj = 0; bj < 2; ++bj) { const f32x4 v0 = acc[ai][bj][m][0], v1 = acc[ai][bj][m][1];
                    u32x4 w; w.x = cvt_pk_bf16(v0[0], v0[1]); w.y = cvt_pk_bf16(v0[2], v0[3]); w.z = cvt_pk_bf16(v1[0], v1[1]); w.w = cvt_pk_bf16(v1[2], v1[3]);
                    *(u32x4*)(rowp + bj * HALF) = w; } }
    }
};
}

struct SchedG1 {
    const char* hln; const char* WinT; const char* hc; const char* WgT; int G, c;
    __device__ __forceinline__ bool next(int i, pg8::Unit& u) const {
        const int L = i * G + c;
        if (L < 1536) { int pm, pn; pg8::static_order(L, 128, 12, pm, pn); u.pm = pm; u.pn = pn; u.aux = 0; u.A = hln + (size_t)pm * 256 * 2048; u.B = WinT + (size_t)pn * 256 * 2048; u.B2 = u.B; return true; }
        return false;
    }
};
struct SchedG2 {
    const char* A; const char* Bt; int G, c;
    __device__ __forceinline__ bool next(int i, pg8::Unit& u) const {
        const int L = i * G + c; if (L >= 512) return false;
        int pm, pn; pg8::static_order(L, 128, 4, pm, pn); u.pm = pm; u.pn = pn; u.aux = 0; u.A = A + (size_t)pm * 256 * 2048; u.B = Bt + (size_t)pn * 256 * 2048; u.B2 = u.B; return true;
    }
};
__device__ __forceinline__ void cls_experts(int c, int& e_lo, int& e_hi) { const int g = c / 6, pi = c % 6; e_lo = g * 4 + (pi < 3 ? 0 : (pi < 5 ? 1 : 2)); e_hi = g * 4 + (pi < 3 ? pi + 1 : (pi < 5 ? pi - 1 : 3)); }
__device__ void phase_gemm1(const Params& P, PG8_LAS unsigned char* lds) {
    SchedG1 S{(const char*)P.hln, (const char*)P.WinT, (const char*)P.hc, (const char*)P.WgT, (int)gridDim.x, (int)blockIdx.x};
    pg8::EpiStore E{P.p, P.pctx, 0}; pg8::GemmCfg g{1024, 1024, 16, 16, 1024, 16};
    pg8::gemm_phase<0, false>(lds, g, S, E);
}
__device__ void phase_ctx_proj(const Params& P) {
    typedef short bf16x8 __attribute__((ext_vector_type(8))); typedef float f32x4 __attribute__((ext_vector_type(4)));
    const int tid = opaque_tid(), lane = tid & 63, wid = tid >> 6, r16 = lane & 15, q = lane >> 4;
    const int g = blockIdx.x >> 3, j = blockIdx.x & 7, rt = wid & 3, hf = wid >> 2;
    const bf16_t* arow = P.hc + (size_t)(g * 64 + rt * 16 + r16) * D + 8 * q;
    const bf16_t* brow[4]; bool ok[4];
#pragma unroll
    for (int u = 0; u < 4; ++u) { const int t = 7 * j + 4 * hf + u; ok[u] = (u < 4 - hf) && t < 50; const int tc = ok[u] ? t : 0;
        brow[u] = (tc < 48 ? P.WinT + (size_t)(OFF_K + 16 * tc + r16) * D : P.WgT + (size_t)(16 * (tc - 48) + r16) * D) + 8 * q; }
    f32x4 acc[4];
#pragma unroll
    for (int u = 0; u < 4; ++u) acc[u] = (f32x4){0.f, 0.f, 0.f, 0.f};
#pragma unroll 8
    for (int ks = 0; ks < 32; ++ks) { const bf16x8 a = *(const bf16x8*)(arow + 32 * ks);
#pragma unroll
        for (int u = 0; u < 4; ++u) acc[u] = __builtin_amdgcn_mfma_f32_16x16x32_bf16(a, *(const bf16x8*)(brow[u] + 32 * ks), acc[u], 0, 0, 0); }
#pragma unroll
    for (int u = 0; u < 4; ++u) if (ok[u]) { const int t = 7 * j + 4 * hf + u;
#pragma unroll
        for (int jj = 0; jj < 4; ++jj) P.pctx[(size_t)(g * 64 + rt * 16 + 4 * q + jj) * 1024 + 16 * t + r16] = f2bf(acc[u][jj]); }
}
__device__ void phase_gemm2(const Params& P, PG8_LAS unsigned char* lds) {
    SchedG2 S{(const char*)P.ymix, (const char*)P.WoutT, (int)gridDim.x, (int)blockIdx.x};
    pg8::EpiStore E{P.ybuf, nullptr, 1}; pg8::GemmCfg g{1024, 1024, 16, 16, 1024, 16};
    pg8::gemm_phase<0, false>(lds, g, S, E);
}

struct SchedUpQ {
    const char* h2qs; const char* W13Q; const int* tileinfo; int ntiles, c;
    __device__ __forceinline__ bool next(int i, pg8::Unit& u) const {
        const int x = c & 7, j = c >> 3, pm = 32 * i + 4 * (j >> 2) + (x >> 1), pn = 4 * (x & 1) + (j & 3);
        if (pm >= ntiles) return false;
        int e_lo, e_hi; cls_experts(__builtin_amdgcn_readfirstlane(tileinfo[1 + pm]), e_lo, e_hi); const int e = (pn >> 2) ? e_hi : e_lo;
        u.pm = pm; u.pn = pn; u.aux = 0; u.A = h2qs + (size_t)pm * 256 * 1024; u.B = W13Q + ((size_t)e * 1024 + (pn & 3) * 256) * 1024; u.B2 = u.B; return true;
    }
};
struct SchedDownQ {
    const char* actq; const char* W2Q; const int* tileinfo; const unsigned* cnt; int ntiles, c;
    __device__ __forceinline__ bool next(int k, pg8::Unit& u) const {
        const int x = c & 7, j = c >> 3, jj = j >> 2, rem = ntiles & 31;
        int Hx = (rem - (x >> 1) + 3) >> 2; Hx = Hx < 0 ? 0 : (Hx > 8 ? 8 : Hx);
        const int L = 8 - Hx; const bool light = jj >= Hx;
        const int pl = light ? (k == 0 ? jj - Hx : L + 8 * (k - 1) + jj) : L + 8 * k + jj;
        const int pm = 8 * pl + x, pn = j & 3;
        if (pm >= ntiles) return false;
        int e_lo, e_hi; cls_experts(__builtin_amdgcn_readfirstlane(tileinfo[1 + pm]), e_lo, e_hi);
        u.pm = pm; u.pn = pn; u.aux = 1; u.A = actq + (size_t)pm * 256 * 1024; u.B = W2Q + ((size_t)e_lo * 1024 + pn * 256) * 512; u.B2 = W2Q + ((size_t)e_hi * 1024 + pn * 256) * 512; return true;
    }
    __device__ __forceinline__ void a_ready(const pg8::Unit& u) const {
        const unsigned* p = cnt + u.pm; unsigned sp = 0;
        while (__hip_atomic_load(p, __ATOMIC_RELAXED, __HIP_MEMORY_SCOPE_AGENT) < 8u) { __builtin_amdgcn_s_sleep(4); if (++sp > (1u << 22)) break; }
    }
};
namespace pg8 { template <> struct sched_waits<SchedDownQ> { static constexpr bool v = true; }; }
namespace pg8 {
struct EpiUpQ {
    unsigned char* act; const float* cws; unsigned* cnt;
    __device__ __forceinline__ void publish(int pm) const { __hip_atomic_fetch_add(cnt + pm, 1u, __ATOMIC_RELAXED, __HIP_MEMORY_SCOPE_AGENT); }
    __device__ __forceinline__ void operator()(const f32x4 (&acc)[2][2][4][2], const Unit& u, int wr, int wc, int fr, int fq) const {
        const int half = u.pn >> 2, row0 = u.pm * BM + wr * 64 + fr, col0 = half * 512 + (u.pn & 3) * 128 + wc * 32 + 8 * fq;
#pragma unroll
        for (int ai = 0; ai < 2; ++ai)
#pragma unroll
            for (int m = 0; m < 4; ++m) { const int row = row0 + ai * HALF + m * 16; const float cwv = cws[(size_t)row * 2 + half] * 8.f;
                float o[8];
#pragma unroll
                for (int n = 0; n < 2; ++n)
#pragma unroll
                    for (int j = 0; j < 4; ++j) { const float a = acc[ai][0][m][n][j], b = acc[ai][1][m][n][j]; o[n * 4 + j] = a * __builtin_amdgcn_rcpf(1.f + __expf(-a)) * b * cwv; }
                uint2 w; w.x = pack4_fp8(o[0], o[1], o[2], o[3]); w.y = pack4_fp8(o[4], o[5], o[6], o[7]);
                __hip_atomic_store((unsigned long long*)(act + (size_t)row * 1024 + col0), ((unsigned long long)w.y << 32) | w.x, __ATOMIC_RELAXED, __HIP_MEMORY_SCOPE_AGENT); }
    }
};
template <> struct epi_publishes<EpiUpQ> { static constexpr bool v = true; };
}
__device__ void phase_moe_up(const Params& P, PG8_LAS unsigned char* lds) {
    SchedUpQ S{(const char*)P.h2qs, (const char*)P.W13Q, P.tileinfo, __builtin_amdgcn_readfirstlane((int)P.ctrl[4096 + 64 * NCLS]), (int)blockIdx.x};
    pg8::EpiUpQ E{P.actq, P.cws, P.ctrl + 12288}; pg8::GemmCfg g{1024, 1024, 8, 8, 1024, 8};
    pg8::gemm_phase<0, true>(lds, g, S, E);
}
__device__ void phase_moe_down(const Params& P, PG8_LAS unsigned char* lds) {
    SchedDownQ S{(const char*)P.actq, (const char*)P.W2Q, P.tileinfo, P.ctrl + 12288, __builtin_amdgcn_readfirstlane((int)P.ctrl[4096 + 64 * NCLS]), (int)blockIdx.x};
    pg8::EpiStore E{P.moes, nullptr, 1}; pg8::GemmCfg g{1024, 512, 8, 4, 512, 4};
    pg8::gemm_phase<0, true>(lds, g, S, E);
}

__device__ __forceinline__ void unpack8(const uint4& t, float* f) {
  f[0] = __uint_as_float(t.x << 16); f[1] = __uint_as_float(t.x & 0xffff0000u); f[2] = __uint_as_float(t.y << 16); f[3] = __uint_as_float(t.y & 0xffff0000u);
  f[4] = __uint_as_float(t.z << 16); f[5] = __uint_as_float(t.z & 0xffff0000u); f[6] = __uint_as_float(t.w << 16); f[7] = __uint_as_float(t.w & 0xffff0000u);
}
__device__ __forceinline__ uint4 pack8(const float* f) { uint4 w; w.x = pack2(f[0], f[1]); w.y = pack2(f[2], f[3]); w.z = pack2(f[4], f[5]); w.w = pack2(f[6], f[7]); return w; }

namespace gla {
typedef short bf16x8 __attribute__((ext_vector_type(8)));
typedef short s16x4 __attribute__((ext_vector_type(4)));
typedef short v4i16_t __attribute__((ext_vector_type(4)));
typedef float f32x4 __attribute__((ext_vector_type(4)));
typedef float f32x2 __attribute__((ext_vector_type(2)));
typedef unsigned u32x4 __attribute__((ext_vector_type(4)));
typedef unsigned u32x2 __attribute__((ext_vector_type(2)));
#define GLAS __attribute__((address_space(3)))
typedef GLAS unsigned char* ldsp;
constexpr int VST = 288, NST = 144, KEST = 160;
constexpr int L_V = 0, L_KR = L_V + 64 * VST, L_QR = L_KR + 64 * NST, L_LW = L_QR + 64 * NST, L_PT = L_LW + 64 * 32 * 4, L_DEC = L_PT + 2 * 16 * 64 * 4,
              L_QD = L_DEC + 512, L_KINV = L_QD + 64 * NST, L_KE = L_KINV + 64 * NST, L_KE2 = L_KE + 64 * KEST, L_P = L_KE2 + 64 * KEST, L_ST = L_P + 64 * NST,
              L_RS = L_ST + 128 * NST, L_GW = L_RS + 512, L_GB = L_GW + 2 * 16 * 64 * 4, L_END = L_GB + 512;
static_assert(L_END <= 128 * 1024, "gla lds");
constexpr int L_PB0 = L_KR, L_GG = L_PB0 + 2 * 16384, L_PB1 = L_GW;
static_assert(L_GG + 512 <= L_DEC && L_PB1 + 2 * 16384 <= TIDTAB_OFF, "gla pass B lds");
__device__ __forceinline__ s16x4 trr(const GLAS unsigned char* p) { return __builtin_bit_cast(s16x4, __builtin_amdgcn_ds_read_tr16_b64_v4i16((GLAS v4i16_t*)p)); }
__device__ __forceinline__ bf16x8 tr_frag(const GLAS unsigned char* img, int stride, int k0, int col0, int lane) {
    const int q = lane >> 4, r = (lane & 15) >> 2, pp = lane & 3;
    const GLAS unsigned char* a = img + (k0 + 4 * q + r) * stride + (col0 + 4 * pp) * 2;
    const s16x4 lo = trr(a), hi = trr(a + 16 * stride);
    return (bf16x8){lo[0], lo[1], lo[2], lo[3], hi[0], hi[1], hi[2], hi[3]};
}
__device__ __forceinline__ bf16x8 nat_frag(const GLAS unsigned char* img, int stride, int row0, int k0, int lane) {
    return *(const GLAS bf16x8*)(img + (row0 + (lane & 15)) * stride + (k0 + 8 * (lane >> 4)) * 2);
}
__device__ __forceinline__ bf16x8 natp_frag(const GLAS unsigned char* img, int stride, int row0, int k0, int lane) {
    const GLAS unsigned char* a = img + (row0 + (lane & 15)) * stride + (k0 + 4 * (lane >> 4)) * 2;
    const s16x4 lo = *(const GLAS s16x4*)a, hi = *(const GLAS s16x4*)(a + 32);
    return (bf16x8){lo[0], lo[1], lo[2], lo[3], hi[0], hi[1], hi[2], hi[3]};
}
#define GMFMA(a, b, c) __builtin_amdgcn_mfma_f32_16x16x32_bf16(a, b, c, 0, 0, 0)

struct Src { const bf16_t* pp; int ld, qoff, koff, voff; const float* low; int lowbf; };

struct ChunkRegs { u32x4 k, q, v0, v1; f32x4 lw; };
__device__ __forceinline__ void chunk_load(ChunkRegs& cr, const Src& s, size_t row0, int h, bool withq, int tid) {
    { const int r = tid >> 3, c8 = (tid & 7) * 8; const bf16_t* pr = s.pp + (row0 + r) * s.ld;
      cr.k = *(const u32x4*)(pr + s.koff + h * 64 + c8);
      if (withq) cr.q = *(const u32x4*)(pr + s.qoff + h * 64 + c8); }
    { const int r = tid >> 4, c8 = (tid & 15) * 8; cr.v0 = *(const u32x4*)(s.pp + (row0 + r) * s.ld + s.voff + h * 128 + c8); cr.v1 = *(const u32x4*)(s.pp + (row0 + 32 + r) * s.ld + s.voff + h * 128 + c8); }
    { const int r = tid >> 3, c4 = (tid & 7) * 4;
      if (s.lowbf) { const uint2 t = *(const uint2*)(s.pp + (row0 + r) * s.ld + 768 + c4);
        cr.lw = (f32x4){__uint_as_float(t.x << 16), __uint_as_float(t.x & 0xffff0000u), __uint_as_float(t.y << 16), __uint_as_float(t.y & 0xffff0000u)}; }
      else cr.lw = *(const f32x4*)(s.low + (row0 + r) * 32 + c4); }
}
__device__ __forceinline__ void chunk_store(ldsp lds, const ChunkRegs& cr, bool withq, int tid) {
    { const int r = tid >> 3, c8 = (tid & 7) * 8; *(GLAS u32x4*)(lds + L_KR + r * NST + c8 * 2) = cr.k; if (withq) *(GLAS u32x4*)(lds + L_QR + r * NST + c8 * 2) = cr.q; }
    { const int r = tid >> 4, c8 = (tid & 15) * 8; *(GLAS u32x4*)(lds + L_V + r * VST + c8 * 2) = cr.v0; *(GLAS u32x4*)(lds + L_V + (32 + r) * VST + c8 * 2) = cr.v1; }
    { const int r = tid >> 3, c4 = (tid & 7) * 4; *(GLAS f32x4*)(lds + L_LW + (r * 32 + c4) * 4) = cr.lw; }
}
__device__ __forceinline__ void gate_scan(ldsp lds, int dir, int dp, int part, float (&c)[4][2]) {
    float z[4][2];
    { const f32x2 bb = *(const GLAS f32x2*)(lds + L_GB + (dir * 64 + 2 * dp) * 4);
#pragma unroll
      for (int rr = 0; rr < 4; ++rr) { z[rr][0] = bb[0]; z[rr][1] = bb[1]; } }
#pragma unroll
    for (int r4 = 0; r4 < 4; ++r4) {
        f32x2 wv[4];
#pragma unroll
        for (int r = 0; r < 4; ++r) wv[r] = *(const GLAS f32x2*)(lds + L_GW + ((dir * 16 + 4 * r4 + r) * 64 + 2 * dp) * 4);
#pragma unroll
        for (int rr = 0; rr < 4; ++rr) { const f32x4 l = *(const GLAS f32x4*)(lds + L_LW + ((4 * part + rr) * 32 + dir * 16 + 4 * r4) * 4);
#pragma unroll
            for (int r = 0; r < 4; ++r) { z[rr][0] += l[r] * wv[r][0]; z[rr][1] += l[r] * wv[r][1]; } }
    }
    float g[4][2];
#pragma unroll
    for (int rr = 0; rr < 4; ++rr) { g[rr][0] = logsigmoid_fast(z[rr][0]) * (1.f / 16.f); g[rr][1] = logsigmoid_fast(z[rr][1]) * (1.f / 16.f); }
#pragma unroll
    for (int e = 0; e < 2; ++e) {
        const float a0 = g[0][e], a1 = a0 + g[1][e], a2 = a1 + g[2][e], a3 = a2 + g[3][e];
        c[0][e] = dir ? a3 : a0; c[1][e] = dir ? a3 - a0 : a1; c[2][e] = dir ? a3 - a1 : a2; c[3][e] = dir ? a3 - a2 : a3;
    }
}
__device__ __forceinline__ void stage_gate_w(const Params& P, ldsp lds, int h, int tid) {
#pragma unroll
    for (int i = 0; i < 4; ++i) { const int idx = tid + 512 * i, dir = idx >> 10, r = (idx >> 6) & 15, d = idx & 63;
        *(GLAS float*)(lds + L_GW + idx * 4) = (dir ? P.gw_b : P.gw_f)[r * 256 + h * 64 + d]; }
    if (tid < 128) *(GLAS float*)(lds + L_GB + tid * 4) = ((tid >> 6) ? P.gb_b : P.gb_f)[h * 64 + (tid & 63)];
}

__device__ void pass_a(const Params& P, ldsp lds) {
    const int tid = opaque_tid(), lane = tid & 63, wid = tid >> 6, dp = tid & 31, part = tid >> 5;
    const int dt = wid & 3, eh = wid >> 2, q = lane >> 4, c16 = lane & 15;
    for (int item = blockIdx.x; item < 256 + 128; item += gridDim.x) {
        const bool isctx = item >= 256;
        int b, h, seg, nch; Src s; size_t rowbase;
        if (!isctx) { b = item >> 5; h = (item >> 3) & 3; seg = item & 7; nch = 8; s = Src{P.p, NP, OFF_Q, OFF_K, OFF_V, P.low, 0}; rowbase = (size_t)b * SEQ + seg * 512; }
        else { const int j = item - 256; b = j >> 4; h = (j >> 2) & 3; seg = 0; nch = 1; s = Src{P.pctx, 1024, 0, 0, 256, P.low, 1}; rowbase = (size_t)b * CTXL + (j & 3) * 64; }
        __syncthreads(); stage_gate_w(P, lds, h, tid);
        f32x4 Sf[4], Sb[4];
#pragma unroll
        for (int n = 0; n < 4; ++n) { Sf[n] = (f32x4){0.f, 0.f, 0.f, 0.f}; Sb[n] = (f32x4){0.f, 0.f, 0.f, 0.f}; }
        float LPb[2] = {0.f, 0.f}, LPf[2] = {0.f, 0.f};
        const bool wq = !isctx;
        ChunkRegs cr; chunk_load(cr, s, rowbase, h, wq, tid);
        for (int n = 0; n < nch; ++n) {
            __syncthreads();
            chunk_store(lds, cr, wq, tid);
            if (n + 1 < nch) chunk_load(cr, s, rowbase + (n + 1) * 64, h, wq, tid);
            __syncthreads();
            float cf[4][2], cb[4][2];
            gate_scan(lds, 0, dp, part, cf); gate_scan(lds, 1, dp, part, cb);
            GLAS float* PT = (GLAS float*)(lds + L_PT);
            *(GLAS f32x2*)(PT + part * 64 + 2 * dp) = (f32x2){cf[3][0], cf[3][1]};
            *(GLAS f32x2*)(PT + 1024 + part * 64 + 2 * dp) = (f32x2){cb[0][0], cb[0][1]};
            __syncthreads();
            float offf[2] = {0.f, 0.f}, totf[2] = {0.f, 0.f}, offb[2] = {0.f, 0.f}, totb[2] = {0.f, 0.f};
#pragma unroll 4
            for (int pq = 0; pq < 16; ++pq) { const f32x2 a = *(const GLAS f32x2*)(PT + pq * 64 + 2 * dp), bq = *(const GLAS f32x2*)(PT + 1024 + pq * 64 + 2 * dp);
                totf[0] += a[0]; totf[1] += a[1]; totb[0] += bq[0]; totb[1] += bq[1];
                const float mf = (pq < part) ? 1.f : 0.f, mb = (pq > part) ? 1.f : 0.f; offf[0] += mf * a[0]; offf[1] += mf * a[1]; offb[0] += mb * bq[0]; offb[1] += mb * bq[1]; }
            const float etf0 = __expf(totf[0]), etf1 = __expf(totf[1]), etb0 = __expf(totb[0]), etb1 = __expf(totb[1]), elp0 = __expf(LPb[0]), elp1 = __expf(LPb[1]);
#pragma unroll
            for (int rr = 0; rr < 4; ++rr) { const int i = 4 * part + rr;
                const unsigned kk = *(const GLAS unsigned*)(lds + L_KR + i * NST + 4 * dp);
                const float k0 = __uint_as_float(kk << 16), k1 = __uint_as_float(kk & 0xffff0000u);
                const float egf0 = __expf(cf[rr][0] + offf[0]), egf1 = __expf(cf[rr][1] + offf[1]), egb0 = __expf(cb[rr][0] + offb[0]), egb1 = __expf(cb[rr][1] + offb[1]);
                const float eif0 = __builtin_amdgcn_rcpf(egf0), eif1 = __builtin_amdgcn_rcpf(egf1), eib0 = __builtin_amdgcn_rcpf(egb0), eib1 = __builtin_amdgcn_rcpf(egb1);
                const float kef0 = k0 * (etf0 * eif0), kef1 = k1 * (etf1 * eif1), keb0 = k0 * (etb0 * eib0), keb1 = k1 * (etb1 * eib1);
                *(GLAS unsigned*)(lds + L_KE + i * KEST + 4 * dp) = pack2(kef0, kef1);
                *(GLAS unsigned*)(lds + L_KE2 + i * KEST + 4 * dp) = pack2(keb0 * elp0, keb1 * elp1);
                if (wq) {
                    const unsigned qq = *(const GLAS unsigned*)(lds + L_QR + i * NST + 4 * dp);
                    const float q0 = __uint_as_float(qq << 16) * 0.125f, q1 = __uint_as_float(qq & 0xffff0000u) * 0.125f;
                    const size_t o0 = (rowbase + n * 64 + i) * 256 + h * 64 + 2 * dp, o1 = o0 + (size_t)NTOK * 256;
                    *(unsigned*)(P.gqd + o0) = pack2(q0 * egf0, q1 * egf1); *(unsigned*)(P.gkinv + o0) = pack2(k0 * eif0, k1 * eif1);
                    *(unsigned*)(P.gqd + o1) = pack2(q0 * egb0, q1 * egb1); *(unsigned*)(P.gkinv + o1) = pack2(k0 * eib0, k1 * eib1); } }
            if (part == 0) { *(GLAS f32x2*)(lds + L_DEC + 8 * dp) = (f32x2){etf0, etf1};
                if (wq) { const size_t ch = (rowbase >> 6) + n; *(float2*)(P.gdec + (ch * 4 + h) * 64 + 2 * dp) = (float2){etf0, etf1}; *(float2*)(P.gdec + ((512 + ch) * 4 + h) * 64 + 2 * dp) = (float2){etb0, etb1}; } }
            LPb[0] += totb[0]; LPb[1] += totb[1]; LPf[0] += totf[0]; LPf[1] += totf[1];
            __syncthreads();
            const f32x4 dec = *(const GLAS f32x4*)(lds + L_DEC + (16 * dt + 4 * q) * 4);
#pragma unroll
            for (int nn = 0; nn < 4; ++nn) Sf[nn] = Sf[nn] * dec;
#pragma unroll
            for (int ks = 0; ks < 2; ++ks) {
                const bf16x8 af = tr_frag(lds + L_KE, KEST, 32 * ks, 16 * dt, lane), ab = tr_frag(lds + L_KE2, KEST, 32 * ks, 16 * dt, lane);
#pragma unroll
                for (int nn = 0; nn < 4; ++nn) { const bf16x8 bv = tr_frag(lds + L_V, VST, 32 * ks, 64 * eh + 16 * nn, lane); Sf[nn] = GMFMA(af, bv, Sf[nn]); Sb[nn] = GMFMA(ab, bv, Sb[nn]); }
            }
        }
        float* Uf; float* Ub;
        if (!isctx) { Uf = P.Useg + (size_t)(item * 2) * 8192; Ub = Uf + 8192; }
        else { Uf = P.ctxS + (size_t)((item - 256) * 2) * 8192; Ub = Uf + 8192; }
#pragma unroll
        for (int nn = 0; nn < 4; ++nn) { *(f32x4*)(Uf + tid * 16 + 4 * nn) = Sf[nn]; *(f32x4*)(Ub + tid * 16 + 4 * nn) = Sb[nn]; }
        if (part == 0) { float* Dg = isctx ? P.ctxS + (size_t)256 * 8192 + (size_t)((item - 256) * 2) * 64 : P.Dseg + (size_t)(item * 2) * 64;
            *(float2*)(Dg + 2 * dp) = (float2){__expf(LPf[0]), __expf(LPf[1])}; *(float2*)(Dg + 64 + 2 * dp) = (float2){__expf(LPb[0]), __expf(LPb[1])}; }
    }
}

struct ChunkB { u32x4 qd, kinv, v0, v1; f32x4 dec; };
__device__ __forceinline__ void chunkb_load(ChunkB& cr, const Params& P, int dir, size_t row0, int h, int tid) {
    { const int r = tid >> 3, c8 = (tid & 7) * 8; const size_t o = ((size_t)dir * NTOK + row0 + r) * 256 + h * 64 + c8;
      cr.qd = *(const u32x4*)(P.gqd + o); cr.kinv = *(const u32x4*)(P.gkinv + o); }
    { const int r = tid >> 4, c8 = (tid & 15) * 8; cr.v0 = *(const u32x4*)(P.p + (row0 + r) * NP + OFF_V + h * 128 + c8); cr.v1 = *(const u32x4*)(P.p + (row0 + 32 + r) * NP + OFF_V + h * 128 + c8); }
    if (tid < 16) cr.dec = *(const f32x4*)(P.gdec + (((size_t)dir * 512 + (row0 >> 6)) * 4 + h) * 64 + 4 * tid);
}
__device__ __forceinline__ void chunkb_store(ldsp lds, const ChunkB& cr, int tid) {
    { const int r = tid >> 3, c8 = (tid & 7) * 8; *(GLAS u32x4*)(lds + L_QD + r * NST + c8 * 2) = cr.qd; *(GLAS u32x4*)(lds + L_KE + r * KEST + c8 * 2) = cr.kinv; }
    { const int r = tid >> 4, c8 = (tid & 15) * 8; *(GLAS u32x4*)(lds + L_V + r * VST + c8 * 2) = cr.v0; *(GLAS u32x4*)(lds + L_V + (32 + r) * VST + c8 * 2) = cr.v1; }
    if (tid < 16) *(GLAS f32x4*)(lds + L_DEC + 16 * tid) = cr.dec;
}
__device__ __forceinline__ void fold_state(const Params& P, f32x4 (&S)[4], int item, int dir, int tid, int dt, int q) {
    const int b = item >> 5, h = (item >> 3) & 3, seg = item & 7;
    {
        f32x4 u[4][4], dd[4];
#pragma unroll
        for (int ff = 0; ff < 4; ++ff) { const int cc = dir ? 3 - ff : ff, e = (((b * 4 + h) * 4 + cc) * 2 + dir);
            const float* U = P.ctxS + (size_t)e * 8192 + tid * 16;
            dd[ff] = *(const f32x4*)(P.ctxS + (size_t)256 * 8192 + (size_t)e * 64 + 16 * dt + 4 * q);
#pragma unroll
            for (int nn = 0; nn < 4; ++nn) u[ff][nn] = *(const f32x4*)(U + 4 * nn); }
#pragma unroll
        for (int nn = 0; nn < 4; ++nn) S[nn] = u[0][nn];
#pragma unroll
        for (int ff = 1; ff < 4; ++ff)
#pragma unroll
            for (int nn = 0; nn < 4; ++nn) S[nn] = dd[ff] * S[nn] + u[ff][nn]; }
    const int nfold = dir ? 7 - seg : seg;
    for (int f0 = 0; f0 < nfold; f0 += 4) { f32x4 u[4][4], dd[4];
#pragma unroll
        for (int ff = 0; ff < 4; ++ff) { const int f = min(f0 + ff, nfold - 1), sp = dir ? 7 - f : f, it2 = (item & ~7) + sp;
            const float* U = P.Useg + (size_t)(it2 * 2 + dir) * 8192 + tid * 16;
            dd[ff] = *(const f32x4*)(P.Dseg + (size_t)(it2 * 2 + dir) * 64 + 16 * dt + 4 * q);
#pragma unroll
            for (int nn = 0; nn < 4; ++nn) u[ff][nn] = *(const f32x4*)(U + 4 * nn); }
#pragma unroll
        for (int ff = 0; ff < 4; ++ff) { const bool v = f0 + ff < nfold; const f32x4 one = (f32x4){1.f, 1.f, 1.f, 1.f}, zero = (f32x4){0.f, 0.f, 0.f, 0.f}; const f32x4 de = v ? dd[ff] : one;
#pragma unroll
            for (int nn = 0; nn < 4; ++nn) S[nn] = de * S[nn] + (v ? u[ff][nn] : zero); } }
}
__device__ void pass_b(const Params& P, ldsp lds) {
    const int tid = opaque_tid(), lane = tid & 63, wid = tid >> 6;
    const int dt = wid & 3, eh = wid >> 2, q = lane >> 4, c16 = lane & 15, it = wid & 3;
    for (int item = blockIdx.x; item < 256; item += gridDim.x) {
        const int b = item >> 5, h = (item >> 3) & 3, seg = item & 7;
        const size_t rowbase = (size_t)b * SEQ + seg * 512;
        __syncthreads();
        if (tid < 128) *(GLAS float*)(lds + L_GG + tid * 4) = P.gla_g[tid];
        f32x4 Sd[2][4];
        fold_state(P, Sd[0], item, 0, tid, dt, q); fold_state(P, Sd[1], item, 1, tid, dt, q);
        u32x2 part[4][4];
        ChunkB cr; chunkb_load(cr, P, 0, rowbase, h, tid);
#pragma unroll
        for (int t = 0; t < 8; ++t) {
#pragma unroll
            for (int dir = 0; dir < 2; ++dir) {
                const int n = dir ? 7 - t : t;
                const bool fin = dir ? (n < 4) : (n >= 4);
                int n_o = n, nx_o = dir ? t + 1 : 7 - t;
                asm volatile("" : "+s"(n_o), "+s"(nx_o));
                const size_t row0 = rowbase + n_o * 64;
                __syncthreads();
#pragma unroll
                for (int nn = 0; nn < 4; ++nn) { u32x2 wv; wv[0] = pack2(Sd[dir][nn][0], Sd[dir][nn][1]); wv[1] = pack2(Sd[dir][nn][2], Sd[dir][nn][3]);
                    *(GLAS u32x2*)(lds + L_ST + (64 * eh + 16 * nn + c16) * NST + (16 * dt + 4 * q) * 2) = wv; }
                chunkb_store(lds, cr, tid);
                if (dir == 0) chunkb_load(cr, P, 1, rowbase + nx_o * 64, h, tid);
                else if (t < 7) chunkb_load(cr, P, 0, rowbase + nx_o * 64, h, tid);
                uint2 rvr[4];
                if (fin) {
#pragma unroll
                    for (int nn = 0; nn < 4; ++nn) rvr[nn] = *(const uint2*)(P.p + (row0 + 16 * it + c16) * NP + OFF_R + h * 128 + 64 * eh + 16 * nn + 4 * q);
                }
                __syncthreads();
#pragma unroll
                for (int t2 = 0; t2 < 2; ++t2) { const int jt = eh * 2 + t2;
                    f32x4 sc = (f32x4){0.f, 0.f, 0.f, 0.f};
#pragma unroll
                    for (int ks = 0; ks < 2; ++ks) sc = GMFMA(nat_frag(lds + L_KE, KEST, 16 * jt, 32 * ks, lane), nat_frag(lds + L_QD, NST, 16 * it, 32 * ks, lane), sc);
                    const int i = 16 * it + c16;
#pragma unroll
                    for (int j = 0; j < 4; ++j) { const int jj = 16 * jt + 4 * q + j; const bool keep = dir ? (jj >= i) : (jj <= i); if (!keep) sc[j] = 0.f; }
                    u32x2 wv; wv[0] = pack2(sc[0], sc[1]); wv[1] = pack2(sc[2], sc[3]);
                    *(GLAS u32x2*)(lds + L_P + i * NST + (16 * jt + 4 * q) * 2) = wv; }
                __syncthreads();
                f32x4 o[4];
#pragma unroll
                for (int nn = 0; nn < 4; ++nn) o[nn] = (f32x4){0.f, 0.f, 0.f, 0.f};
#pragma unroll
                for (int ks = 0; ks < 2; ++ks) {
                    const bf16x8 pb = natp_frag(lds + L_P, NST, 16 * it, 32 * ks, lane), qb = nat_frag(lds + L_QD, NST, 16 * it, 32 * ks, lane);
#pragma unroll
                    for (int nn = 0; nn < 4; ++nn) { o[nn] = GMFMA(tr_frag(lds + L_V, VST, 32 * ks, 64 * eh + 16 * nn, lane), pb, o[nn]);
                        o[nn] = GMFMA(nat_frag(lds + L_ST, NST, 64 * eh + 16 * nn, 32 * ks, lane), qb, o[nn]); }
                }
                { const f32x4 dec = *(const GLAS f32x4*)(lds + L_DEC + (16 * dt + 4 * q) * 4);
#pragma unroll
                  for (int ks = 0; ks < 2; ++ks) { const bf16x8 af = tr_frag(lds + L_KE, KEST, 32 * ks, 16 * dt, lane);
#pragma unroll
                    for (int nn = 0; nn < 4; ++nn) Sd[dir][nn] = GMFMA(af, tr_frag(lds + L_V, VST, 32 * ks, 64 * eh + 16 * nn, lane), Sd[dir][nn]); }
#pragma unroll
                  for (int nn = 0; nn < 4; ++nn) Sd[dir][nn] = Sd[dir][nn] * dec; }
                if (!fin) {
#pragma unroll
                    for (int nn = 0; nn < 4; ++nn) { u32x2 wv; wv[0] = pack2(o[nn][0], o[nn][1]); wv[1] = pack2(o[nn][2], o[nn][3]);
                        if (n < 4) part[n & 3][nn] = wv; else *(GLAS u32x2*)(lds + (n < 6 ? L_PB0 + (n - 4) * 16384 : L_PB1 + (n - 6) * 16384) + nn * 4096 + tid * 8) = wv; }
                } else {
                    float ss = 0.f;
#pragma unroll
                    for (int nn = 0; nn < 4; ++nn) { const u32x2 pv = n < 4 ? part[n & 3][nn] : *(const GLAS u32x2*)(lds + (n < 6 ? L_PB0 + (n - 4) * 16384 : L_PB1 + (n - 6) * 16384) + nn * 4096 + tid * 8);
                        o[nn][0] += __uint_as_float(pv[0] << 16); o[nn][1] += __uint_as_float(pv[0] & 0xffff0000u); o[nn][2] += __uint_as_float(pv[1] << 16); o[nn][3] += __uint_as_float(pv[1] & 0xffff0000u);
                        ss += o[nn][0] * o[nn][0] + o[nn][1] * o[nn][1] + o[nn][2] * o[nn][2] + o[nn][3] * o[nn][3]; }
                    ss += __shfl_xor(ss, 16); ss += __shfl_xor(ss, 32);
                    GLAS float* RS = (GLAS float*)(lds + L_RS);
                    if (q == 0) RS[eh * 64 + 16 * it + c16] = ss;
                    __syncthreads();
                    const float tot2 = RS[16 * it + c16] + RS[64 + 16 * it + c16];
                    const float rs = rsqrtf(tot2 * (1.f / 128.f) + 1e-6f);
                    const size_t tok = row0 + 16 * it + c16;
#pragma unroll
                    for (int nn = 0; nn < 4; ++nn) { const int e = 64 * eh + 16 * nn + 4 * q;
                        const uint2 rv = rvr[nn];
                        const f32x4 gg = *(const GLAS f32x4*)(lds + L_GG + e * 4);
                        const float r0 = __uint_as_float(rv.x << 16), r1 = __uint_as_float(rv.x & 0xffff0000u), r2 = __uint_as_float(rv.y << 16), r3 = __uint_as_float(rv.y & 0xffff0000u);
                        uint2 wv; wv.x = pack2(o[nn][0] * rs * gg[0] * siluf(r0), o[nn][1] * rs * gg[1] * siluf(r1)); wv.y = pack2(o[nn][2] * rs * gg[2] * siluf(r2), o[nn][3] * rs * gg[3] * siluf(r3));
                        *(uint2*)(P.ymix + tok * D + 512 + h * 128 + e) = wv; }
                }
            }
        }
    }
}
}

__device__ void phase_conv(const Params& P) {
  typedef unsigned cu32x4 __attribute__((ext_vector_type(4)));
  const int tid_ = opaque_tid(); const int lane = tid_ & 63, wl = blockIdx.x * 8 + (tid_ >> 6);
  const int ch = lane * 8;
  float cw0[8], cw1[8], cw2[8], cb[8];
#pragma unroll
  for (int j = 0; j < 8; ++j) { cw0[j] = P.conv_w[ch + j]; cw1[j] = P.conv_w[512 + ch + j]; cw2[j] = P.conv_w[1024 + ch + j]; cb[j] = P.conv_b[ch + j]; }
#pragma unroll 1
  for (int task = wl; task < 4096; task += 2048) {
    const int tok0 = task * 8, gx0 = tok0 & 63;
    const bool hl = gx0 > 0, hr = gx0 < 56;
    const bf16_t* pr = P.p + (size_t)tok0 * NP;
    cu32x4 ru[10], rb[8];
#pragma unroll
    for (int t = 0; t < 10; ++t) { const int dtk = (t == 0) ? (hl ? -1 : 0) : ((t == 9) ? (hr ? 8 : 7) : t - 1);
      ru[t] = *(const cu32x4*)(pr + (ptrdiff_t)dtk * NP + OFF_AC + ch); }
#pragma unroll
    for (int t = 0; t < 8; ++t) rb[t] = *(const cu32x4*)(pr + (size_t)t * NP + OFF_AB + ch);
    float um[8], u0[8];
#pragma unroll
    for (int w = 0; w < 4; ++w) { const unsigned a0 = ru[0][w], a1 = ru[1][w];
      um[2 * w] = hl ? __uint_as_float(a0 << 16) : 0.f; um[2 * w + 1] = hl ? __uint_as_float(a0 & 0xffff0000u) : 0.f;
      u0[2 * w] = __uint_as_float(a1 << 16); u0[2 * w + 1] = __uint_as_float(a1 & 0xffff0000u); }
#pragma unroll
    for (int i = 0; i < 8; ++i) {
      const bool hn = (i < 7) || hr;
      float up[8], ya[8];
#pragma unroll
      for (int w = 0; w < 4; ++w) { const unsigned a = ru[i + 2][w];
        up[2 * w] = hn ? __uint_as_float(a << 16) : 0.f; up[2 * w + 1] = hn ? __uint_as_float(a & 0xffff0000u) : 0.f; }
#pragma unroll
      for (int w = 0; w < 4; ++w) { const unsigned bv = rb[i][w]; const float b0 = __uint_as_float(bv << 16), b1 = __uint_as_float(bv & 0xffff0000u);
        ya[2 * w] = b0 * (um[2 * w] * cw0[2 * w] + u0[2 * w] * cw1[2 * w] + up[2 * w] * cw2[2 * w] + cb[2 * w]);
        ya[2 * w + 1] = b1 * (um[2 * w + 1] * cw0[2 * w + 1] + u0[2 * w + 1] * cw1[2 * w + 1] + up[2 * w + 1] * cw2[2 * w + 1] + cb[2 * w + 1]); }
#pragma unroll
      for (int j = 0; j < 8; ++j) { um[j] = u0[j]; u0[j] = up[j]; }
      *(uint4*)(P.ymix + (size_t)(tok0 + i) * D + ch) = pack8(ya);
    }
  }
}

struct Ln1In { float4 x[4]; uint2 y[4]; float mean0, rstd0; };
__device__ __forceinline__ void ln1_load(const Params& P, int tok, int lane, Ln1In& in) {
#pragma unroll
    for (int j = 0; j < 4; ++j) { const int k = j * 256 + lane * 4; in.x[j] = *(const float4*)(P.x + (size_t)tok * D + k); in.y[j] = *(const uint2*)(P.ybuf + (size_t)tok * D + k); }
    in.mean0 = P.stats[tok * 2]; in.rstd0 = P.stats[tok * 2 + 1];
}
__device__ __forceinline__ void ln1_row(const Params& P, int tok, int lane, const Ln1In& in, const float* PR) {
    typedef float f32x4 __attribute__((ext_vector_type(4)));
    const float mean0 = in.mean0, rstd0 = in.rstd0;
    float v[16];
#pragma unroll
    for (int j = 0; j < 4; ++j) {
      const int k = j * 256 + lane * 4;
      const float4 xv = in.x[j]; const uint2 yv = in.y[j];
      const f32x4 g = *(const f32x4*)(PR + k), bb = *(const f32x4*)(PR + 1024 + k), g1 = *(const f32x4*)(PR + 2048 + k);
      v[4 * j] = (xv.x - mean0) * rstd0 * g[0] + bb[0] + g1[0] * __uint_as_float(yv.x << 16);
      v[4 * j + 1] = (xv.y - mean0) * rstd0 * g[1] + bb[1] + g1[1] * __uint_as_float(yv.x & 0xffff0000u);
      v[4 * j + 2] = (xv.z - mean0) * rstd0 * g[2] + bb[2] + g1[2] * __uint_as_float(yv.y << 16);
      v[4 * j + 3] = (xv.w - mean0) * rstd0 * g[3] + bb[3] + g1[3] * __uint_as_float(yv.y & 0xffff0000u);
    }
    float s = 0.f;
#pragma unroll
    for (int j = 0; j < 16; ++j) s += v[j];
    const float mean = wave_sum(s) * (1.f / 1024.f);
    float q = 0.f;
#pragma unroll
    for (int j = 0; j < 16; ++j) { const float dd = v[j] - mean; q += dd * dd; }
    const float rstd = rsqrtf(wave_sum(q) * (1.f / 1024.f) + 1e-5f);
#pragma unroll
    for (int j = 0; j < 4; ++j) {
      const int k = j * 256 + lane * 4;
      const f32x4 g = *(const f32x4*)(PR + 3072 + k), bb = *(const f32x4*)(PR + 4096 + k), sc = *(const f32x4*)(PR + 5120 + k), sh = *(const f32x4*)(PR + 6144 + k);
      const float x0 = (v[4 * j] - mean) * rstd * g[0] + bb[0], x1v = (v[4 * j + 1] - mean) * rstd * g[1] + bb[1], x2 = (v[4 * j + 2] - mean) * rstd * g[2] + bb[2], x3 = (v[4 * j + 3] - mean) * rstd * g[3] + bb[3];
      uint2 w; w.x = pack2(x0, x1v); w.y = pack2(x2, x3); *(uint2*)(P.x1 + (size_t)tok * D + k) = w;
      const float hh0 = x0 * sc[0] + sh[0], hh1 = x1v * sc[1] + sh[1], hh2 = x2 * sc[2] + sh[2], hh3 = x3 * sc[3] + sh[3];
      *(unsigned*)(P.h2q + (size_t)tok * D + k) = pack4_fp8(hh0 * 8.f, hh1 * 8.f, hh2 * 8.f, hh3 * 8.f);
    }
}
__device__ __forceinline__ void route_token(const Params& P, const float (&lg)[20], int* hcnt, int& c_out, int& rank_out, float& wlo_out, float& whi_out) {
    const float g0 = lg[0] + P.bgr[0], g1 = lg[1] + P.bgr[1], g2 = lg[2] + P.bgr[2], g3 = lg[3] + P.bgr[3];
    int gi = 0; float gm = g0;
    if (g1 > gm) { gm = g1; gi = 1; } if (g2 > gm) { gm = g2; gi = 2; } if (g3 > gm) { gm = g3; gi = 3; }
    const float pg = 1.f / (__expf(g0 - gm) + __expf(g1 - gm) + __expf(g2 - gm) + __expf(g3 - gm));
    float e[4];
#pragma unroll
    for (int n = 0; n < 4; ++n) e[n] = (gi == 0 ? lg[4 + n] : (gi == 1 ? lg[8 + n] : (gi == 2 ? lg[12 + n] : lg[16 + n]))) + P.ber[gi * 4 + n];
    int i1 = 0; float m1 = e[0];
    if (e[1] > m1) { m1 = e[1]; i1 = 1; } if (e[2] > m1) { m1 = e[2]; i1 = 2; } if (e[3] > m1) { m1 = e[3]; i1 = 3; }
    int i2 = -1; float m2 = -3.0e38f;
#pragma unroll
    for (int n = 0; n < 4; ++n) if (n != i1 && (i2 < 0 || e[n] > m2)) { m2 = e[n]; i2 = n; }
    const float ex2 = __expf(m2 - m1);
    const float w1 = 1.f / (1.f + ex2), w2 = ex2 / (1.f + ex2);
    const int lo = i1 < i2 ? i1 : i2, hi = i1 < i2 ? i2 : i1;
    const float wlo = (i1 < i2 ? w1 : w2) * pg, whi = (i1 < i2 ? w2 : w1) * pg;
    const int pidx = lo == 0 ? hi - 1 : (lo == 1 ? hi + 1 : 5);
    const int c = gi * 6 + pidx;
    c_out = c; wlo_out = wlo; whi_out = whi;
    rank_out = atomicAdd(&hcnt[c], 1);
}
__device__ void phase_ln1_router(const Params& P, float* ldsf) {
  typedef short bf16x8 __attribute__((ext_vector_type(8))); typedef float f32x4 __attribute__((ext_vector_type(4)));
  constexpr int WST = 2064;
  unsigned char* lds = (unsigned char*)ldsf;
  float* LG = (float*)(lds + 20 * WST);
  int* hcnt = (int*)(lds + 20 * WST + 8 * 16 * 32 * 4);
  float* PR = (float*)(lds + 20 * WST + 8 * 16 * 32 * 4 + 128);
  const int tid = opaque_tid(), lane = tid & 63, wid = tid >> 6;
  { const float* md = P.mod + ((blockIdx.x * 128) / SEQ) * 6144;
    for (int k = tid; k < 1024; k += 512) { PR[k] = ALPHA * P.ln_in_g[k]; PR[1024 + k] = ALPHA * P.ln_in_b[k]; PR[2048 + k] = md[2048 + k]; PR[3072 + k] = P.ln1_g[k]; PR[4096 + k] = P.ln1_b[k];
      PR[5120 + k] = 1.f + md[4096 + k]; PR[6144 + k] = md[3072 + k]; } }
  float* BS = PR + 7 * 1024;
  int* tcls = (int*)(BS + 192); int* trank = tcls + 128; int* tpos = trank + 128; int* cbase = tpos + 128; float* tw = (float*)(cbase + 32);
  { const float* md = P.mod + ((blockIdx.x * 128) / SEQ) * 6144;
    typedef float lf4 __attribute__((ext_vector_type(4)));
    lf4 wl[10]; float scl[10];
#pragma unroll
    for (int u = 0; u < 10; ++u) { const int i = tid + 512 * u, k = i / 5, c4 = i % 5; wl[u] = c4 == 0 ? *(const lf4*)(P.wgr + k * 4) : *(const lf4*)(P.wer + k * 16 + (c4 - 1) * 4); scl[u] = md[4096 + k]; }
#pragma unroll
    for (int u = 0; u < 10; ++u) {
      const int i = tid + 512 * u, k = i / 5, c4 = i % 5; const float4 t = make_float4(wl[u][0], wl[u][1], wl[u][2], wl[u][3]);
      const float sc = 1.f + scl[u];
      *(bf16_t*)(lds + (c4 * 4 + 0) * WST + k * 2) = f2bf(t.x * sc); *(bf16_t*)(lds + (c4 * 4 + 1) * WST + k * 2) = f2bf(t.y * sc);
      *(bf16_t*)(lds + (c4 * 4 + 2) * WST + k * 2) = f2bf(t.z * sc); *(bf16_t*)(lds + (c4 * 4 + 3) * WST + k * 2) = f2bf(t.w * sc); }
    float bp[20];
#pragma unroll
    for (int n = 0; n < 20; ++n) bp[n] = 0.f;
#pragma unroll
    for (int kk = 0; kk < 2; ++kk) { const int k = tid + 512 * kk; const float sh = md[3072 + k];
      const float4 g4 = *(const float4*)(P.wgr + k * 4); bp[0] += sh * g4.x; bp[1] += sh * g4.y; bp[2] += sh * g4.z; bp[3] += sh * g4.w;
#pragma unroll
      for (int c4 = 0; c4 < 4; ++c4) { const float4 e4 = *(const float4*)(P.wer + k * 16 + c4 * 4); bp[4 + 4 * c4] += sh * e4.x; bp[5 + 4 * c4] += sh * e4.y; bp[6 + 4 * c4] += sh * e4.z; bp[7 + 4 * c4] += sh * e4.w; } }
#pragma unroll
    for (int n = 0; n < 20; ++n) { const float t = wave_sum(bp[n]); if (lane == 0) BS[wid * 20 + n] = t; } }
  if (tid < NCLS) hcnt[tid] = 0;
  const int tokb = blockIdx.x * 128 + wid * 16;
  Ln1In inA, inB;
  ln1_load(P, tokb, lane, inA); ln1_load(P, tokb + 1, lane, inB);
  __syncthreads();
#pragma unroll 1
  for (int it = 0; it < 8; ++it) {
    const int tok0 = tokb + it * 2;
    const Ln1In cA = inA, cB = inB;
    if (it < 7) { ln1_load(P, tok0 + 2, lane, inA); ln1_load(P, tok0 + 3, lane, inB); }
    ln1_row(P, tok0, lane, cA, PR); ln1_row(P, tok0 + 1, lane, cB, PR);
  }
  asm volatile("s_waitcnt vmcnt(0)" ::: "memory");
  __syncthreads();
  const int r16 = lane & 15, q = lane >> 4;
  f32x4 a0 = {0.f, 0.f, 0.f, 0.f}, a1 = {0.f, 0.f, 0.f, 0.f};
  const bf16_t* arow = P.x1 + (size_t)(tokb + r16) * D + 8 * q;
  const unsigned char* b0p = lds + r16 * WST + 16 * q; const unsigned char* b1p = lds + (r16 < 4 ? 16 + r16 : 19) * WST + 16 * q;
#pragma unroll 8
  for (int ks = 0; ks < 32; ++ks) {
    const bf16x8 a = *(const bf16x8*)(arow + 32 * ks);
    a0 = __builtin_amdgcn_mfma_f32_16x16x32_bf16(a, *(const bf16x8*)(b0p + 64 * ks), a0, 0, 0, 0);
    a1 = __builtin_amdgcn_mfma_f32_16x16x32_bf16(a, *(const bf16x8*)(b1p + 64 * ks), a1, 0, 0, 0);
  }
  float* lgw = LG + wid * 512;
#pragma unroll
  for (int j = 0; j < 4; ++j) { lgw[(4 * q + j) * 32 + r16] = a0[j]; if (r16 < 4) lgw[(4 * q + j) * 32 + 16 + r16] = a1[j]; }
  __syncthreads();
  if (lane < 16) {
    float lg[20];
#pragma unroll
    for (int n4 = 0; n4 < 5; ++n4) { const float4 t = *(const float4*)(lgw + lane * 32 + 4 * n4); lg[4 * n4] = t.x; lg[4 * n4 + 1] = t.y; lg[4 * n4 + 2] = t.z; lg[4 * n4 + 3] = t.w; }
#pragma unroll
    for (int n = 0; n < 20; ++n) { float bsum = 0.f;
#pragma unroll
      for (int w8 = 0; w8 < 8; ++w8) bsum += BS[w8 * 20 + n];
      lg[n] += bsum; }
    int c, rk; float w0, w1; route_token(P, lg, hcnt, c, rk, w0, w1);
    const int ti = wid * 16 + lane; tcls[ti] = c; trank[ti] = rk; tw[2 * ti] = w0; tw[2 * ti + 1] = w1;
  }
  __syncthreads();
  unsigned* ctl = P.ctrl;
  if (tid < NCLS) { const int n = hcnt[tid]; unsigned base = 0u;
    if (n > 0) { base = __hip_atomic_fetch_add(ctl + 4096 + 64 * tid, (unsigned)n, __ATOMIC_RELAXED, __HIP_MEMORY_SCOPE_AGENT);
      for (unsigned k = (base + 255u) >> 8; (k << 8) < base + (unsigned)n; ++k) { const unsigned id = __hip_atomic_fetch_add(ctl + 4096 + 64 * NCLS, 1u, __ATOMIC_RELAXED, __HIP_MEMORY_SCOPE_AGENT);
        P.tileinfo[1 + id] = tid; __hip_atomic_store(ctl + 8192 + tid * 128 + k, id + 1u, __ATOMIC_RELAXED, __HIP_MEMORY_SCOPE_AGENT); } }
    cbase[tid] = (int)base; }
  __syncthreads();
  if (tid < 128) { const int c = tcls[tid]; const unsigned slot = (unsigned)(cbase[c] + trank[tid]), k = slot >> 8; unsigned* pe = ctl + 8192 + c * 128 + k; unsigned pt, sp = 0;
    while ((pt = __hip_atomic_load(pe, __ATOMIC_RELAXED, __HIP_MEMORY_SCOPE_AGENT)) == 0u) { __builtin_amdgcn_s_sleep(1); if (++sp > (1u << 24)) { pt = 1u; break; } }
    const int pos = (int)((pt - 1u) * 256u + (slot & 255u)); tpos[tid] = pos;
    P.perm[blockIdx.x * 128 + tid] = pos; P.cws[(size_t)pos * 2] = tw[2 * tid]; P.cws[(size_t)pos * 2 + 1] = tw[2 * tid + 1]; }
  __syncthreads();
  { typedef unsigned cu32x4 __attribute__((ext_vector_type(4))); cu32x4 t[16];
#pragma unroll
    for (int r = 0; r < 16; ++r) t[r] = *(const cu32x4*)(P.h2q + (size_t)(tokb + r) * D + lane * 16);
#pragma unroll
    for (int r = 0; r < 16; ++r) *(cu32x4*)(P.h2qs + (size_t)tpos[wid * 16 + r] * D + lane * 16) = t[r]; }
}

__device__ void phase_moe_sort(const Params& P, int* lds) {
  int* H = lds;
  int* tot = lds + 256 * NCLS;
  int* cstart = tot + NCLS;
  int* base = cstart + 32;
  int* mycls = base + NCLS;
  int* mypos = mycls + 128;
  const int tid = opaque_tid(), b = blockIdx.x;
  { int hv[12];
#pragma unroll
    for (int u = 0; u < 12; ++u) hv[u] = P.hist[tid + 512 * u];
#pragma unroll
    for (int u = 0; u < 12; ++u) H[tid + 512 * u] = hv[u]; }
  if (tid < 128) mycls[tid] = P.cls[b * 128 + tid];
  __syncthreads();
  if (tid < NCLS) { int t = 0, pre = 0; for (int bb = 0; bb < 256; ++bb) { if (bb == b) pre = t; t += H[bb * NCLS + tid]; } tot[tid] = t; base[tid] = pre; }
  __syncthreads();
  if (tid == 0) { int s = 0; for (int c = 0; c < NCLS; ++c) { cstart[c] = s; s += (tot[c] + 255) / 256 * 256; } cstart[NCLS] = s; }
  __syncthreads();
  if (tid < 128) { const int c = mycls[tid]; int r = 0; for (int j = 0; j < tid; ++j) r += (mycls[j] == c) ? 1 : 0; const int pos = cstart[c] + base[c] + r; mypos[tid] = pos;
    P.perm[b * 128 + tid] = pos; P.sidx[pos] = b * 128 + tid; P.cws[(size_t)pos * 2] = P.cw[(b * 128 + tid) * 2]; P.cws[(size_t)pos * 2 + 1] = P.cw[(b * 128 + tid) * 2 + 1]; }
  __syncthreads();
  { typedef unsigned su32x4 __attribute__((ext_vector_type(4))); su32x4 t[16];
#pragma unroll
    for (int i = 0; i < 16; ++i) { const int idx = tid + 512 * i, r = idx >> 6, cc = idx & 63; t[i] = *(const su32x4*)(P.h2q + (size_t)(b * 128 + r) * D + cc * 16); }
#pragma unroll
    for (int i = 0; i < 16; ++i) { const int idx = tid + 512 * i, r = idx >> 6, cc = idx & 63; *(su32x4*)(P.h2qs + (size_t)mypos[r] * D + cc * 16) = t[i]; } }
  if (b < NCLS) {
    const int r0 = cstart[b] + tot[b], r1 = cstart[b + 1];
    for (int i = tid; i < (r1 - r0) * 64; i += blockDim.x) *(uint4*)(P.h2qs + (size_t)(r0 + i / 64) * D + (i % 64) * 16) = make_uint4(0, 0, 0, 0);
    for (int i = tid; i < (r1 - r0); i += blockDim.x) { P.sidx[r0 + i] = 0; P.cws[(size_t)(r0 + i) * 2] = 0.f; P.cws[(size_t)(r0 + i) * 2 + 1] = 0.f; }
  }
  if (b == 0) {
    const int nt = cstart[NCLS] / 256;
    if (tid == 0) P.tileinfo[0] = nt;
    for (int t = tid; t < nt; t += blockDim.x) { int c = 0; while (c < NCLS - 1 && t * 256 >= cstart[c + 1]) ++c; P.tileinfo[1 + t] = c; }
  }
}

struct FinIn { uint2 x[4], m[4]; };
__device__ __forceinline__ void fin_load(const Params& P, int tok, int pos, int lane, FinIn& in) {
#pragma unroll
  for (int j = 0; j < 4; ++j) { const int k = j * 256 + lane * 4; in.x[j] = *(const uint2*)(P.x1 + (size_t)tok * D + k); in.m[j] = *(const uint2*)(P.moes + (size_t)pos * D + k); }
}
__device__ __forceinline__ void fin_row(const Params& P, int tok, int lane, const FinIn& in, const float4 (&g2)[4], const float4 (&lg)[4], const float4 (&lb)[4]) {
  float v[16];
#pragma unroll
  for (int j = 0; j < 4; ++j) {
    const uint2 xv = in.x[j], mv = in.m[j];
    v[4 * j] = ALPHA * __uint_as_float(xv.x << 16) + g2[j].x * __uint_as_float(mv.x << 16);
    v[4 * j + 1] = ALPHA * __uint_as_float(xv.x & 0xffff0000u) + g2[j].y * __uint_as_float(mv.x & 0xffff0000u);
    v[4 * j + 2] = ALPHA * __uint_as_float(xv.y << 16) + g2[j].z * __uint_as_float(mv.y << 16);
    v[4 * j + 3] = ALPHA * __uint_as_float(xv.y & 0xffff0000u) + g2[j].w * __uint_as_float(mv.y & 0xffff0000u);
  }
  float s = 0.f;
#pragma unroll
  for (int j = 0; j < 16; ++j) s += v[j];
  const float mean = wave_sum(s) * (1.f / 1024.f);
  float q = 0.f;
#pragma unroll
  for (int j = 0; j < 16; ++j) { const float dd = v[j] - mean; q += dd * dd; }
  const float rstd = rsqrtf(wave_sum(q) * (1.f / 1024.f) + 1e-5f);
#pragma unroll
  for (int j = 0; j < 4; ++j) {
    float4 o;
    o.x = (v[4 * j] - mean) * rstd * lg[j].x + lb[j].x; o.y = (v[4 * j + 1] - mean) * rstd * lg[j].y + lb[j].y;
    o.z = (v[4 * j + 2] - mean) * rstd * lg[j].z + lb[j].z; o.w = (v[4 * j + 3] - mean) * rstd * lg[j].w + lb[j].w;
    *(float4*)(P.out + (size_t)tok * D + j * 256 + lane * 4) = o;
  }
}
__device__ void phase_final(const Params& P) {
  const int tid_ = opaque_tid(); const int lane = tid_ & 63, wv = (blockIdx.x * blockDim.x + tid_) >> 6;
  const int tok0 = wv * 16;
  const float* md = P.mod + (tok0 / SEQ) * 6144;
  float4 g2[4], lg[4], lb[4];
#pragma unroll
  for (int j = 0; j < 4; ++j) { const int k = j * 256 + lane * 4; g2[j] = *(const float4*)(md + 5120 + k); lg[j] = *(const float4*)(P.ln2_g + k); lb[j] = *(const float4*)(P.ln2_b + k); }
  const int posl = P.perm[tok0 + (lane & 15)];
  FinIn inA, inB;
  fin_load(P, tok0, __shfl(posl, 0), lane, inA); fin_load(P, tok0 + 1, __shfl(posl, 1), lane, inB);
#pragma unroll 1
  for (int i = 0; i < 16; i += 2) {
    FinIn cA = inA, cB = inB;
    if (i + 2 < 16) { fin_load(P, tok0 + i + 2, __shfl(posl, i + 2), lane, inA); fin_load(P, tok0 + i + 3, __shfl(posl, i + 3), lane, inB); }
    fin_row(P, tok0 + i, lane, cA, g2, lg, lb); fin_row(P, tok0 + i + 1, lane, cB, g2, lg, lb);
  }
}

extern __shared__ __attribute__((aligned(16))) unsigned char dyn_lds[];

#define XB_TMO      128
#define XB_XCNT(j)  (256  + 64 * (j))
#define XB_XSUB(j)  (1280 + 64 * (j))
#define XB_XGEN(j)  (2304 + 64 * (j))
#define XB_TOP      3328
#define XB_TOPGEN   3392
#define XCD_BAR_WORDS 3456
#define XB_SPIN_CAP (1u << 22)
#define XLAS __attribute__((address_space(3)))
__device__ __forceinline__ unsigned xb_ld(unsigned* p)              { return __hip_atomic_load(p, __ATOMIC_RELAXED, __HIP_MEMORY_SCOPE_AGENT); }
__device__ __forceinline__ unsigned xb_add(unsigned* p, unsigned v) { return __hip_atomic_fetch_add(p, v, __ATOMIC_RELAXED, __HIP_MEMORY_SCOPE_AGENT); }
__device__ __forceinline__ unsigned xb_xcc_id() { return (unsigned)__builtin_amdgcn_s_getreg((3 << 11) | 20) & 0xFu; }
#define XB_SPIN(cond, bar) do { unsigned _sp = 0; while (cond) { __builtin_amdgcn_s_sleep(1); \
    if ((++_sp & 255u) == 0u) { if (xb_ld(&(bar)[XB_TMO])) break; if (_sp > XB_SPIN_CAP) { atomicAdd(&(bar)[XB_TMO], 1u); break; } } } } while (0)
struct XcdBarrier { unsigned* bar; unsigned x; volatile XLAS unsigned* st; };
__device__ __forceinline__ XcdBarrier xcd_barrier_post(unsigned* bar, volatile XLAS unsigned* st) {
    XcdBarrier b; b.bar = bar; b.x = xb_xcc_id(); b.st = st;
    if (threadIdx.x == 0) (void)xb_add(&bar[XB_XCNT(b.x)], 1u);
    return b;
}
__device__ __forceinline__ void xcd_barrier_complete(unsigned* bar, unsigned x, unsigned& nloc, unsigned& nx) {
    const unsigned G = gridDim.x * gridDim.y * gridDim.z;
    unsigned sum, cnt, mine, sp = 0u;
    for (;;) {
        sum = 0u; cnt = 0u; mine = 0u;
#pragma unroll
        for (unsigned j = 0; j < 16; ++j) { const unsigned c = xb_ld(&bar[XB_XCNT(j)]); sum += c; cnt += (c > 0u) ? 1u : 0u; mine = (j == x) ? c : mine; }
        if (sum == G) break;
        __builtin_amdgcn_s_sleep(1);
        if ((++sp & 255u) == 0u) { if (xb_ld(&bar[XB_TMO])) break; if (sp > XB_SPIN_CAP) { atomicAdd(&bar[XB_TMO], 1u); break; } }
    }
    nloc = mine > 0u ? mine : 1u; nx = cnt > 0u ? cnt : 1u;
}
__device__ __forceinline__ void xcd_barrier(const XcdBarrier& b) {
    asm volatile("s_waitcnt vmcnt(0)" ::: "memory");
    __syncthreads();
    if (opaque_tid() == 0) {
        unsigned* bar = b.bar;
        __builtin_amdgcn_s_waitcnt(0);
        unsigned nloc = b.st[0], nx = b.st[1];
        if (nloc == 0u) { xcd_barrier_complete(bar, b.x, nloc, nx); b.st[0] = nloc; b.st[1] = nx; }
        const unsigned old = xb_add(&bar[XB_XSUB(b.x)], 1u);
        const unsigned gen = old / nloc;
        if (old + 1u == (gen + 1u) * nloc) {
            __builtin_amdgcn_fence(__ATOMIC_RELEASE, "agent");
            asm volatile("s_waitcnt vmcnt(0)" ::: "memory");
            const unsigned og = xb_add(&bar[XB_TOP], 1u);
            const unsigned tg = og / nx;
            if (og + 1u == (tg + 1u) * nx) xb_add(&bar[XB_TOPGEN], 1u);
            else XB_SPIN(xb_ld(&bar[XB_TOPGEN]) == tg, bar);
            __builtin_amdgcn_fence(__ATOMIC_ACQUIRE, "agent");
            xb_add(&bar[XB_XGEN(b.x)], 1u);
            asm volatile("s_waitcnt vmcnt(0)" ::: "memory");
        } else {
            XB_SPIN(xb_ld(&bar[XB_XGEN(b.x)]) == gen, bar);
            __builtin_amdgcn_fence(__ATOMIC_ACQUIRE, "agent");
            asm volatile("s_waitcnt vmcnt(0)" ::: "memory");
        }
    }
    __syncthreads();
}

#ifndef REP_PRE
#define REP_PRE 1
#endif
#ifndef REP_HLN
#define REP_HLN 1
#endif
#ifndef REP_GEMM
#define REP_GEMM 1
#endif
#ifndef REP_GLAA
#define REP_GLAA 1
#endif
#ifndef REP_GLAB
#define REP_GLAB 1
#endif
#ifndef REP_CONV
#define REP_CONV 1
#endif
#ifndef REP_LN1
#define REP_LN1 1
#endif
#ifndef REP_SORT
#define REP_SORT 1
#endif
#ifndef REP_FIN
#define REP_FIN 1
#endif
#ifndef REP_BAR
#define REP_BAR 1
#endif
#define RUN_1(x) do { x; __syncthreads(); } while (0)
#define RUN_2(x) do { x; __syncthreads(); x; __syncthreads(); } while (0)
#define RUN_3(x) do { x; __syncthreads(); x; __syncthreads(); x; __syncthreads(); } while (0)
#define RUN__(n, x) RUN_##n(x)
#define RUN(n, x) RUN__(n, x)
#define GBAR() do { for (int _r = 0; _r < REP_BAR; ++_r) { XcdBarrier _b; _b.bar = P.ctrl; _b.x = xb_xcc_id(); _b.st = (volatile XLAS unsigned*)((XLAS unsigned char*)dyn_lds + MEGA_LDS - 16); xcd_barrier(_b); } } while (0)
__global__ __launch_bounds__(512, 2) void mega(Params P) {
  XLAS unsigned* stw = (XLAS unsigned*)((XLAS unsigned char*)dyn_lds + MEGA_LDS - 16);
  if (threadIdx.x < 4) stw[threadIdx.x] = 0u;
  if ((threadIdx.x & 63) == 0) { const unsigned hw = (unsigned)__builtin_amdgcn_s_getreg((6 << 11) | 4) & 63u; *(XLAS int*)((XLAS unsigned char*)dyn_lds + TIDTAB_OFF + hw * 4) = (int)(threadIdx.x >> 6); }
  __syncthreads();
  (void)xcd_barrier_post(P.ctrl, (volatile XLAS unsigned*)stw);
  RUN(REP_PRE, phase_pre(P, (float*)dyn_lds));
  GBAR();
  RUN(REP_HLN, phase_hln(P, (HLAS unsigned char*)dyn_lds));
  GBAR();
  RUN(REP_GEMM, phase_gemm1(P, (PG8_LAS unsigned char*)dyn_lds); phase_ctx_proj(P));
  GBAR();
  for (int stage = 0; stage < 2; ++stage) {
    if (((stage ^ (int)(blockIdx.x >> 3)) & 1) == 0) { RUN(REP_GLAA, gla::pass_a(P, (gla::ldsp)dyn_lds)); }
    else { RUN(REP_CONV, phase_conv(P)); }
  }
  GBAR();
  for (int stage = 0; stage < 2; ++stage) {
    if (((stage ^ (int)(blockIdx.x >> 3)) & 1) == 0) { RUN(REP_GLAB, gla::pass_b(P, (gla::ldsp)dyn_lds)); }
    else { phase_cvx(P, (float*)dyn_lds); }
    __syncthreads();
  }
  GBAR();
  RUN(REP_GEMM, phase_gemm2(P, (PG8_LAS unsigned char*)dyn_lds));
  GBAR();
  RUN(REP_LN1, phase_ln1_router(P, (float*)dyn_lds));
  GBAR();
  RUN(REP_GEMM, phase_moe_up(P, (PG8_LAS unsigned char*)dyn_lds));
  RUN(REP_GEMM, phase_moe_down(P, (PG8_LAS unsigned char*)dyn_lds));
  GBAR();
  RUN(REP_FIN, phase_final(P));
}

static inline size_t al256(size_t v) { return (v + 255) & ~(size_t)255; }

extern "C" void kernel_launch(void* const* d_in, const int* in_sizes, int n_in, void* d_out, int out_size, void* d_ws, size_t ws_size, hipStream_t stream) {
  Params P{};
  const float* const* in = (const float* const*)d_in;
  P.x = in[0]; P.c = in[1]; P.ctx = in[2]; P.c_ctx = in[3]; P.ln_in_g = in[4]; P.ln_in_b = in[5]; P.w_ada = in[6]; P.b_ada = in[7]; P.w_in = in[8];
  P.conv_w = in[9]; P.conv_b = in[10]; P.gw_f = in[11]; P.gb_f = in[12]; P.gw_b = in[13]; P.gb_b = in[14]; P.gla_g = in[15]; P.w_out = in[16];
  P.ln1_g = in[17]; P.ln1_b = in[18]; P.wgr = in[19]; P.bgr = in[20]; P.wer = in[21]; P.ber = in[22]; P.w1 = in[23]; P.w3 = in[24]; P.w2 = in[25];
  P.ln2_g = in[26]; P.ln2_b = in[27];
  P.out = (float*)d_out;
  unsigned char* w = (unsigned char*)d_ws; size_t off = 0;
  auto take = [&](size_t bytes) { unsigned char* r = w + off; off = al256(off + bytes); return r; };
  P.ctrl = (unsigned*)take(65536);
  P.mod = (float*)take(9 * 6144 * 4);
  P.WinT = (bf16_t*)take((size_t)3072 * 1024 * 2);
  P.WgT = (bf16_t*)take((size_t)256 * 1024 * 2);
  P.WoutT = (bf16_t*)take((size_t)1024 * 1024 * 2);
  P.W13Q = (unsigned char*)take((size_t)16 * 1024 * 1024);
  P.W2Q = (unsigned char*)take((size_t)16 * 1024 * 512);
  P.h2q = (unsigned char*)take((size_t)NTOK * D);
  P.h2qs = (unsigned char*)take((size_t)MOE_ROWS * D);
  P.actq = (unsigned char*)take((size_t)MOE_ROWS * D);
  P.gqd = (bf16_t*)P.h2q; P.gkinv = P.gqd + (size_t)2 * NTOK * 256; P.gke = P.gkinv + (size_t)2 * NTOK * 256;
  P.hc = (bf16_t*)take((size_t)NCTX * D * 2);
  P.stats = (float*)take((size_t)NTOK * 2 * 4);
  P.low = (float*)take((size_t)(NTOK + NCTX) * 32 * 4);
  P.pctx = (bf16_t*)take((size_t)NCTX * 1024 * 2);
  P.cls = (int*)take((size_t)NTOK * 4);
  P.cw = (float*)take((size_t)NTOK * 2 * 4);
  P.hist = (int*)take(256 * NCLS * 4);
  P.perm = (int*)take((size_t)NTOK * 4);
  P.sidx = (int*)take((size_t)MOE_ROWS * 4);
  P.tileinfo = (int*)take(1024);
  P.cws = (float*)take((size_t)MOE_ROWS * 2 * 4);
  P.gdec = (float*)take((size_t)2 * 512 * 4 * 64 * 4);
  P.Useg = (float*)take((size_t)512 * 8192 * 4);
  P.Dseg = (float*)take((size_t)512 * 64 * 4);
  P.hln = (bf16_t*)take((size_t)NTOK * D * 2); P.ymix = P.hln;
  P.p = (bf16_t*)take((size_t)NTOK * NP * 2);
  P.ybuf = P.p; P.x1 = P.p + (size_t)NTOK * D; P.h2 = P.p + (size_t)2 * NTOK * D;
  P.h2s = (bf16_t*)take((size_t)MOE_ROWS * D * 2); P.moes = P.h2s; P.opart = P.h2s; P.ctxS = (float*)P.h2s;
  if (off > ws_size) { fprintf(stderr, "workspace too small: need %zu have %zu\n", off, ws_size); return; }
  static bool said = false; if (!said) { said = true; fprintf(stderr, "workspace: need %zu have %zu\n", off, ws_size); }

  static int ready = 0;
  if (!ready) {
    if (hipFuncSetAttribute((const void*)mega, hipFuncAttributeMaxDynamicSharedMemorySize, MEGA_LDS) != hipSuccess) { fprintf(stderr, "hipFuncSetAttribute failed\n"); ready = -1; return; }
    int dev = 0, cus = 0, per_cu = 0;
    (void)hipGetDevice(&dev); (void)hipDeviceGetAttribute(&cus, hipDeviceAttributeMultiprocessorCount, dev);
    (void)hipOccupancyMaxActiveBlocksPerMultiprocessor(&per_cu, (const void*)mega, 512, MEGA_LDS);
    if (cus < 256 || per_cu < 1) { fprintf(stderr, "mega: needs 256 CUs with one resident block each (cus %d, per_cu %d)\n", cus, per_cu); ready = -1; return; }
    ready = 1;
  }
  if (ready < 0) return;
  (void)hipMemsetAsync(P.ctrl, 0, 65536, stream);
  void* args[] = {&P};
  hipError_t e = hipLaunchCooperativeKernel((const void*)mega, dim3(256), dim3(512), args, MEGA_LDS, stream);
  if (e != hipSuccess) fprintf(stderr, "cooperative launch failed: %s\n", hipGetErrorString(e));
}
```

```cpp
#include <hip/hip_runtime.h>
#include <stdint.h>
#include <stdio.h>
#define ST_WT64(ptr, lo, hi) __hip_atomic_store((unsigned long long*)(ptr), ((unsigned long long)(hi) << 32) | (unsigned long long)(lo), __ATOMIC_RELAXED, __HIP_MEMORY_SCOPE_AGENT)

typedef unsigned short bf16_t;
constexpr int D = 1024, NB = 8, SEQ = 4096, NTOK = NB * SEQ, CTXL = 256, NCTX = NB * CTXL;
constexpr int DPROJ = 3104, NP = 3072;
constexpr int OFF_AB = 0, OFF_AC = 512, OFF_AX = 1024, OFF_Q = 1536, OFF_K = 1792, OFF_V = 2048, OFF_R = 2560;
constexpr int NCLS = 24, MOE_ROWS = NTOK + NCLS * 256, MOE_TILES = MOE_ROWS / 256;
constexpr float ALPHA = 1.189207115002721f;

struct Params {
  const float *x, *c, *ctx, *c_ctx, *ln_in_g, *ln_in_b, *w_ada, *b_ada, *w_in, *conv_w, *conv_b, *gw_f, *gb_f, *gw_b, *gb_b, *gla_g, *w_out,
      *ln1_g, *ln1_b, *wgr, *bgr, *wer, *ber, *w1, *w3, *w2, *ln2_g, *ln2_b;
  float* out;
  unsigned* ctrl;
  float* mod;
  bf16_t* WinT;
  bf16_t* WgT;
  bf16_t* WoutT;
  unsigned char* W13Q;
  unsigned char* W2Q;
  unsigned char* h2q;
  unsigned char* h2qs;
  unsigned char* actq;
  bf16_t* hln;
  bf16_t* hc;
  float* stats;
  float* low;
  bf16_t* p;
  bf16_t* pctx;
  float* ctxS;
  bf16_t* ymix;
  bf16_t* ybuf;
  bf16_t* x1;
  bf16_t* h2;
  int* cls;
  float* cw;
  int* hist;
  int* perm;
  int* sidx;
  int* tileinfo;
  float* cws;
  bf16_t* h2s;
  bf16_t* act;
  bf16_t* moes;
  bf16_t* gqd;
  bf16_t* gkinv;
  bf16_t* gke;
  float* gdec;
  float* Useg;
  float* Dseg;
  bf16_t* opart;
  float* o_f;
  float* o_b;
};

constexpr int MEGA_LDS = 160 * 1024, TIDTAB_OFF = MEGA_LDS - 16 - 256;
__device__ __forceinline__ int opaque_tid() {
  const unsigned hw = (unsigned)__builtin_amdgcn_s_getreg((6 << 11) | 4) & 63u;
  int lane; asm volatile("v_mbcnt_lo_u32_b32 %0, -1, 0\n\tv_mbcnt_hi_u32_b32 %0, -1, %0" : "=v"(lane));
  int wid = *(const __attribute__((address_space(3))) int*)(TIDTAB_OFF + hw * 4);
  wid = __builtin_amdgcn_readfirstlane(wid);
  int t = wid * 64 + lane; asm volatile("" : "+v"(t)); return t;
}
__device__ __forceinline__ float bf2f(bf16_t v) { return __uint_as_float(((unsigned)v) << 16); }
__device__ __forceinline__ bf16_t f2bf(float f) { return __builtin_bit_cast(bf16_t, (__bf16)f); }
typedef __bf16 bf16v2_t __attribute__((ext_vector_type(2)));
typedef float f32v2_t __attribute__((ext_vector_type(2)));
__device__ __forceinline__ unsigned pack2(float a, float b) { const f32v2_t v = {a, b}; return __builtin_bit_cast(unsigned, __builtin_convertvector(v, bf16v2_t)); }
__device__ __forceinline__ unsigned pack4_fp8(float a, float b, float c, float d) {
  a = __builtin_amdgcn_fmed3f(a, -448.f, 448.f); b = __builtin_amdgcn_fmed3f(b, -448.f, 448.f); c = __builtin_amdgcn_fmed3f(c, -448.f, 448.f); d = __builtin_amdgcn_fmed3f(d, -448.f, 448.f);
  unsigned w = 0; w = __builtin_amdgcn_cvt_pk_fp8_f32(a, b, w, false); w = __builtin_amdgcn_cvt_pk_fp8_f32(c, d, w, true); return w;
}
__device__ __forceinline__ float wave_sum(float v) {
#define DPP_ADD_(ctrl, rmask) v += __int_as_float(__builtin_amdgcn_update_dpp(0, __float_as_int(v), ctrl, rmask, 0xF, true))
  DPP_ADD_(0xB1, 0xF); DPP_ADD_(0x4E, 0xF); DPP_ADD_(0x141, 0xF); DPP_ADD_(0x140, 0xF); DPP_ADD_(0x142, 0xA); DPP_ADD_(0x143, 0xC);
#undef DPP_ADD_
  return __int_as_float(__builtin_amdgcn_readlane(__float_as_int(v), 63));
}
__device__ __forceinline__ float siluf(float v) { return v * __builtin_amdgcn_rcpf(1.f + __expf(-v)); }
__device__ __forceinline__ float logsigmoidf(float z) { return fminf(z, 0.f) - log1pf(__expf(-fabsf(z))); }
__device__ __forceinline__ float logsigmoid_fast(float z) { return fminf(z, 0.f) - 0.6931471806f * __builtin_amdgcn_logf(1.f + __builtin_amdgcn_exp2f(-1.4426950409f * fabsf(z))); }

__device__ __forceinline__ int rowmap(int n, int mode) { return mode == 0 ? n : ((n >> 7) * 256 + (mode == 2 ? 128 : 0) + (n & 127)); }
struct CvJob { const float* src; bf16_t* dst; int ld_src, k0, n0, nvalid, nbase, ldd, mode, q8; };
__device__ __forceinline__ void cv_decode(const Params& P, int ti, CvJob& j) {
  j.nvalid = 64; j.nbase = 0; j.mode = 0; j.q8 = 0;
  if (ti < 384) { const int kt = ti % 8, nt = ti / 8; j.src = P.w_in; j.ld_src = DPROJ; j.k0 = kt * 128; j.n0 = nt * 64; j.dst = P.WinT; j.ldd = 1024;
    if (j.n0 >= OFF_AC && j.n0 < OFF_AX + 512) { const int isx = j.n0 >= OFF_AX, c = j.n0 - (isx ? OFF_AX : OFF_AC); j.nbase = j.n0 - ((2 + (c >> 7)) * 256 + isx * 128 + (c & 127)); } }
  else if (ti < 392) { const int kt = ti - 384; j.src = P.w_in; j.ld_src = DPROJ; j.k0 = kt * 128; j.n0 = 3072; j.nvalid = 32; j.nbase = 3072; j.dst = P.WgT; j.ldd = 1024; }
  else if (ti < 520) { const int t = ti - 392, kt = t % 8, nt = t / 8; j.src = P.w_out; j.ld_src = 1024; j.k0 = kt * 128; j.n0 = nt * 64; j.dst = P.WoutT; j.ldd = 1024; j.q8 = 1; }
  else if (ti < 2568) { const int t = ti - 520, e = t / 128, r = t % 128, which = r / 64, r2 = r % 64, kt = r2 % 8, nt = r2 / 8;
    j.src = (which ? P.w3 : P.w1) + (size_t)e * 1024 * 512; j.ld_src = 512; j.k0 = kt * 128; j.n0 = nt * 64; j.dst = (bf16_t*)(P.W13Q + (size_t)e * 1024 * 1024); j.ldd = 1024; j.mode = 1 + which; j.q8 = 1; }
  else { const int t = ti - 2568, e = t / 64, r = t % 64, kt = r % 4, nt = r / 4; j.src = P.w2 + (size_t)e * 512 * 1024; j.ld_src = 1024; j.k0 = kt * 128; j.n0 = nt * 64; j.dst = (bf16_t*)(P.W2Q + (size_t)e * 1024 * 512); j.ldd = 512; j.q8 = 1; }
}
typedef float cvf4 __attribute__((ext_vector_type(4)));
__device__ __forceinline__ void cv_load(const CvJob& j, int tid, cvf4 (&r)[4]) {
  if (j.q8) { const int kq = (tid >> 2) & 31, n4 = 4 * ((tid & 3) + 4 * (tid >> 7)); const float* p = j.src + (size_t)(j.k0 + 4 * kq) * j.ld_src + j.n0 + n4;
#pragma unroll
    for (int i = 0; i < 4; ++i) r[i] = *(const cvf4*)(p + (size_t)i * j.ld_src);
    return; }
  const int kp = (tid >> 2) & 63;
#pragma unroll
  for (int i = 0; i < 2; ++i) { const int n4 = 4 * ((tid & 3) + 4 * ((tid >> 8) & 1) + 8 * i);
    if (n4 < j.nvalid) { const float* p = j.src + (size_t)(j.k0 + 2 * kp) * j.ld_src + j.n0 + n4; r[2 * i] = *(const cvf4*)p; r[2 * i + 1] = *(const cvf4*)(p + j.ld_src); } else { r[2 * i] = (cvf4){0.f, 0.f, 0.f, 0.f}; r[2 * i + 1] = r[2 * i]; } }
}
__device__ __forceinline__ void cv_to_lds(const CvJob& j, int tid, const cvf4 (&r)[4], bf16_t* T) {
  if (j.q8) { const int kq = (tid >> 2) & 31, n4 = 4 * ((tid & 3) + 4 * (tid >> 7)); unsigned* t = (unsigned*)((unsigned char*)T + n4 * 144 + 4 * kq);
#pragma unroll
    for (int c = 0; c < 4; ++c) t[36 * c] = pack4_fp8(r[0][c] * 8.f, r[1][c] * 8.f, r[2][c] * 8.f, r[3][c] * 8.f);
    return; }
  const int kp = (tid >> 2) & 63;
#pragma unroll
  for (int i = 0; i < 2; ++i) { const int n4 = 4 * ((tid & 3) + 4 * ((tid >> 8) & 1) + 8 * i);
    if (n4 < j.nvalid) { unsigned* t = (unsigned*)(T + n4 * 136 + 2 * kp);
      t[0] = pack2(r[2 * i][0], r[2 * i + 1][0]); t[68] = pack2(r[2 * i][1], r[2 * i + 1][1]); t[136] = pack2(r[2 * i][2], r[2 * i + 1][2]); t[204] = pack2(r[2 * i][3], r[2 * i + 1][3]); } }
}
__device__ __forceinline__ void cv_store(const CvJob& j, int tid, const bf16_t* T) {
  if (j.q8) { const int n = tid >> 3, kc = (tid & 7) * 16;
    *(uint4*)((unsigned char*)j.dst + (size_t)rowmap(j.n0 + n, j.mode) * j.ldd + j.k0 + kc) = *(const uint4*)((const unsigned char*)T + n * 144 + kc); return; }
#pragma unroll
  for (int i = 0; i < 2; ++i) { const int cidx = tid + 512 * i, n = cidx / 16, kc = (cidx % 16) * 8;
    if (n < j.nvalid) *(uint4*)(j.dst + (size_t)rowmap(j.n0 - j.nbase + n, j.mode) * j.ldd + j.k0 + kc) = *(const uint4*)(T + n * 136 + kc); }
}
__device__ void phase_pre(const Params& P, float* lds) {
  float* s = lds; float* red = lds + 9 * 1024;
  const int tid = opaque_tid();
  const int cg = tid % 6, kg = tid / 6, g0 = blockIdx.x * 6;
  cvf4 c4[5];
#pragma unroll
  for (int j = 0; j < 5; ++j) { const int f = tid + 512 * j; c4[j] = f < 2048 ? *(const cvf4*)(P.c + 4 * f) : (f < 2304 ? *(const cvf4*)(P.c_ctx + 4 * (f - 2048)) : (cvf4){0.f, 0.f, 0.f, 0.f}); }
  cvf4 w[13];
  if (kg < 85) {
#pragma unroll
    for (int i = 0; i < 13; ++i) { const int k = kg + 85 * i; w[i] = (k < 1024) ? *(const cvf4*)(P.w_ada + (size_t)k * 6144 + (size_t)(g0 + cg) * 4) : (cvf4){0.f, 0.f, 0.f, 0.f}; }
  } else {
#pragma unroll
    for (int i = 0; i < 13; ++i) w[i] = (cvf4){0.f, 0.f, 0.f, 0.f};
  }
  CvJob job; cvf4 r[4]; int ti = blockIdx.x;
  cv_decode(P, ti, job); cv_load(job, tid, r);
#pragma unroll
  for (int j = 0; j < 5; ++j) { const int f = tid + 512 * j; if (f < 2304) { const cvf4 v = c4[j]; *(cvf4*)(s + 4 * f) = (cvf4){siluf(v[0]), siluf(v[1]), siluf(v[2]), siluf(v[3])}; } }
  __syncthreads();
  if (kg < 85) {
    float a[9][4];
#pragma unroll
    for (int rr = 0; rr < 9; ++rr) { a[rr][0] = a[rr][1] = a[rr][2] = a[rr][3] = 0.f; }
#pragma unroll
    for (int i = 0; i < 13; ++i) { const int k = kg + 85 * i; if (k < 1024) {
#pragma unroll
        for (int rr = 0; rr < 9; ++rr) { const float sv = s[rr * 1024 + k]; a[rr][0] += sv * w[i][0]; a[rr][1] += sv * w[i][1]; a[rr][2] += sv * w[i][2]; a[rr][3] += sv * w[i][3]; } } }
#pragma unroll
    for (int rr = 0; rr < 9; ++rr)
#pragma unroll
      for (int jj = 0; jj < 4; ++jj) red[kg * 216 + rr * 24 + cg * 4 + jj] = a[rr][jj];
  }
  __syncthreads();
  if (tid < 216) { float t = 0.f; for (int kk = 0; kk < 85; ++kk) t += red[kk * 216 + tid]; const int rr = tid / 24, cc = tid % 24, col = g0 * 4 + cc; P.mod[rr * 6144 + col] = t + P.b_ada[col]; }
  __syncthreads();
  bf16_t* T = (bf16_t*)lds;
  while (ti < 520) {
    cv_to_lds(job, tid, r, T);
    const int tn = ti + gridDim.x;
    CvJob nj = job; cvf4 rn[4] = {r[0], r[1], r[2], r[3]};
    if (tn < 520) { cv_decode(P, tn, nj); cv_load(nj, tid, rn); }
    __syncthreads();
    cv_store(job, tid, T);
    __syncthreads();
    job = nj; r[0] = rn[0]; r[1] = rn[1]; r[2] = rn[2]; r[3] = rn[3];
    ti = tn;
  }
  uint4* z = (uint4*)(P.WgT + 32 * 1024);
  for (int i = blockIdx.x * 512 + tid; i < 224 * 1024 / 8; i += gridDim.x * 512) z[i] = make_uint4(0, 0, 0, 0);
}

__device__ void phase_cvx(const Params& P, float* lds) {
  const int tid = opaque_tid();
  bf16_t* T = (bf16_t*)lds;
  int ti = 520 + blockIdx.x;
  CvJob job; cvf4 r[4];
  cv_decode(P, ti, job); cv_load(job, tid, r);
  __syncthreads();
  while (ti < 3592) {
    cv_to_lds(job, tid, r, T);
    const int tn = ti + gridDim.x;
    CvJob nj = job; cvf4 rn[4] = {r[0], r[1], r[2], r[3]};
    if (tn < 3592) { cv_decode(P, tn, nj); cv_load(nj, tid, rn); }
    __syncthreads();
    cv_store(job, tid, T);
    __syncthreads();
    job = nj; r[0] = rn[0]; r[1] = rn[1]; r[2] = rn[2]; r[3] = rn[3];
    ti = tn;
  }
}

namespace hl {
typedef short bf16x8 __attribute__((ext_vector_type(8)));
typedef float f32x4 __attribute__((ext_vector_type(4)));
typedef unsigned u32x4 __attribute__((ext_vector_type(4)));
#define HLAS __attribute__((address_space(3)))
constexpr int WST = 2064;
__device__ __forceinline__ void ln_row(const float* src, const HLAS float* GB, bf16_t* dst, float* stats, int lane) {
    float v[16];
#pragma unroll
    for (int j = 0; j < 4; ++j) { const f32x4 t = __builtin_nontemporal_load((const f32x4*)(src + j * 256 + lane * 4)); v[4 * j] = t[0]; v[4 * j + 1] = t[1]; v[4 * j + 2] = t[2]; v[4 * j + 3] = t[3]; }
    float s = 0.f;
#pragma unroll
    for (int j = 0; j < 16; ++j) s += v[j];
    const float mean = wave_sum(s) * (1.f / 1024.f);
    float q = 0.f;
#pragma unroll
    for (int j = 0; j < 16; ++j) { const float d = v[j] - mean; q += d * d; }
    const float rstd = rsqrtf(wave_sum(q) * (1.f / 1024.f) + 1e-5f);
    if (stats && lane == 0) { stats[0] = mean; stats[1] = rstd; }
#pragma unroll
    for (int j = 0; j < 4; ++j) {
        const int k = j * 256 + lane * 4;
        const f32x4 g = *(const HLAS f32x4*)(GB + k), bb = *(const HLAS f32x4*)(GB + 1024 + k);
        const float h0 = (v[4 * j] - mean) * rstd * g[0] + bb[0], h1 = (v[4 * j + 1] - mean) * rstd * g[1] + bb[1];
        const float h2 = (v[4 * j + 2] - mean) * rstd * g[2] + bb[2], h3 = (v[4 * j + 3] - mean) * rstd * g[3] + bb[3];
        uint2 w; w.x = pack2(h0, h1); w.y = pack2(h2, h3);
        __hip_atomic_store((unsigned long long*)(dst + k), ((unsigned long long)w.y << 32) | w.x, __ATOMIC_RELAXED, __HIP_MEMORY_SCOPE_AGENT);
    }
}
}
__device__ void phase_hln(const Params& P, HLAS unsigned char* lds) {
    const int tid = opaque_tid(), lane = tid & 63, wid = tid >> 6;
    { hl::u32x4 wt[8];
#pragma unroll
      for (int u = 0; u < 8; ++u) { const int i = tid + 512 * u, n = i >> 7, c = i & 127; wt[u] = *(const hl::u32x4*)(P.WgT + (size_t)n * 1024 + c * 8); }
#pragma unroll
      for (int u = 0; u < 8; ++u) { const int i = tid + 512 * u, n = i >> 7, c = i & 127; *(HLAS hl::u32x4*)(lds + n * hl::WST + c * 16) = wt[u]; } }
    const int R0 = (blockIdx.x >> 5) * SEQ + (blockIdx.x & 31) * 8 + wid;
    HLAS float* GB = (HLAS float*)(lds + 32 * hl::WST);
    { float lsc[4], lsh[4], lg_[4], lb_[4];
#pragma unroll
      for (int u = 0; u < 4; ++u) { const int i = tid + 512 * u, which = i >> 10, k = i & 1023; const float* md = P.mod + (which ? 8 : R0 / SEQ) * 6144; lsc[u] = md[1024 + k]; lsh[u] = md[k]; lg_[u] = P.ln_in_g[k]; lb_[u] = P.ln_in_b[k]; }
#pragma unroll
      for (int u = 0; u < 4; ++u) { const int i = tid + 512 * u, which = i >> 10, k = i & 1023; const float sc1 = 1.f + lsc[u]; GB[which * 2048 + k] = lg_[u] * sc1; GB[which * 2048 + 1024 + k] = lb_[u] * sc1 + lsh[u]; } }
    __syncthreads();
    for (int rr = 0; rr < 16; ++rr) { const int row = R0 + 256 * rr; hl::ln_row(P.x + (size_t)row * D, GB, P.hln + (size_t)row * D, P.stats + row * 2, lane); }
    { const int crow = blockIdx.x * 8 + wid; hl::ln_row(P.ctx + (size_t)crow * D, GB + 2048, P.hc + (size_t)crow * D, nullptr, lane); }
    asm volatile("s_waitcnt vmcnt(0)" ::: "memory");
    __syncthreads();
    const int r16 = lane & 15, q = lane >> 4;
    hl::f32x4 a0 = {0.f, 0.f, 0.f, 0.f}, a1 = {0.f, 0.f, 0.f, 0.f};
    const bf16_t* arow = P.hln + (size_t)(R0 + 256 * r16) * D + 8 * q;
#pragma unroll 1
    for (int kb = 0; kb < 2; ++kb) {
        hl::bf16x8 av[16];
#pragma unroll
        for (int u = 0; u < 16; ++u) av[u] = *(const hl::bf16x8*)(arow + 32 * (16 * kb + u));
#pragma unroll
        for (int u = 0; u < 16; u += 4) asm volatile("" : "+v"(av[u]), "+v"(av[u + 1]), "+v"(av[u + 2]), "+v"(av[u + 3]));
#pragma unroll
        for (int u = 0; u < 16; ++u) { const int ks = 16 * kb + u;
            const hl::bf16x8 b0 = *(const HLAS hl::bf16x8*)(lds + r16 * hl::WST + (32 * ks + 8 * q) * 2), b1 = *(const HLAS hl::bf16x8*)(lds + (16 + r16) * hl::WST + (32 * ks + 8 * q) * 2);
            a0 = __builtin_amdgcn_mfma_f32_16x16x32_bf16(av[u], b0, a0, 0, 0, 0); a1 = __builtin_amdgcn_mfma_f32_16x16x32_bf16(av[u], b1, a1, 0, 0, 0); }
    }
#pragma unroll
    for (int j = 0; j < 4; ++j) { float* lp = P.low + (size_t)(R0 + 256 * (4 * q + j)) * 32; lp[r16] = a0[j]; lp[16 + r16] = a1[j]; }
}

namespace pg8 {
#define PG8_LAS __attribute__((address_space(3)))
typedef short bf16x8 __attribute__((ext_vector_type(8)));
typedef float f32x4 __attribute__((ext_vector_type(4)));
typedef unsigned u32x4 __attribute__((ext_vector_type(4)));
constexpr int BM = 256, BK = 64, HALF = 128, HTB = HALF * BK * 2, STAGE_BYTES = 8 * HTB, NXCD = 8, WGM = 8;
__host__ __device__ __forceinline__ int lds_byte(int r, int c) { const int st = (r >> 4) * 2 + (c >> 5), rr = r & 15, cc = c & 31, ob = rr * 64 + cc * 2; return st * 1024 + (ob ^ (((ob >> 9) & 1) << 5)); }
__host__ __device__ __forceinline__ void stage_rc(int b, int& R, int& C) { const int st = b / 1024, sb = b % 1024, swz = sb ^ (((sb >> 9) & 1) << 5); R = (st >> 1) * 16 + swz / 64; C = (st & 1) * 32 + (swz % 64) / 2; }
__host__ __device__ __forceinline__ int perm32(int rho) { const int n = rho >> 4, i = rho & 15; return 8 * (i >> 2) + 4 * n + (i & 3); }
__device__ __forceinline__ unsigned cvt_pk_bf16(float lo, float hi) { unsigned r; asm volatile("v_cvt_pk_bf16_f32 %0, %1, %2" : "=v"(r) : "v"(lo), "v"(hi)); return r; }

template <class T> struct sched_waits { static constexpr bool v = false; };
template <class T> struct epi_publishes { static constexpr bool v = false; };
struct Unit { const char* A; const char* B; const char* B2; int pm, pn, aux; };
struct GemmCfg { int lda, ldb, nt, ksplit, ldb2, ksplit2; };

__device__ __forceinline__ void static_order(int L, int nM, int nN, int& pm, int& pn) {
    const int nwg = nM * nN; int wgid = L;
    { const int q = nwg / NXCD, r = nwg % NXCD, xcd = wgid % NXCD, off = wgid / NXCD; wgid = (xcd < r ? xcd * (q + 1) : r * (q + 1) + (xcd - r) * q) + off; }
    const int nig = WGM * nN, gid = wgid / nig, fm = gid * WGM, gsz = (nM - fm) < WGM ? (nM - fm) : WGM;
    pm = fm + ((wgid % nig) % gsz); pn = (wgid % nig) / gsz;
}

template <int MODE, bool FP8, class Epi, class Sched>
__device__ __forceinline__ void gemm_phase(PG8_LAS unsigned char* lds, const GemmCfg g, const Sched& S, const Epi& E) {
    const int tid = opaque_tid(), wid = __builtin_amdgcn_readfirstlane(tid >> 6), lane = tid & 63, wr = wid >> 2, wc = wid & 3, fr = lane & 15, fq = lane >> 4;
    typedef int pg8_i32x4 __attribute__((ext_vector_type(4))); typedef int pg8_i32x8 __attribute__((ext_vector_type(8)));
    constexpr bool GATHER = MODE == 1, MIXED = MODE == 2, WAITS = MIXED || sched_waits<Sched>::v, PUBL = epi_publishes<Epi>::v; constexpr int ES = FP8 ? 1 : 2;
    const int nt = g.nt;
    unsigned voffA[2], voffB[2], voffB2[2];
#pragma unroll
    for (int i = 0; i < 2; ++i) { int R, C; stage_rc(tid * 16 + i * 8192, R, C); const int Rb = (R & ~31) + perm32(R & 31);
        voffA[i] = (unsigned)(R * g.lda * ES + 2 * C); voffB[i] = (unsigned)(Rb * g.ldb * ES + 2 * C); voffB2[i] = (unsigned)(Rb * g.ldb2 * ES + 2 * C); }
    const PG8_LAS int* gidx = (const PG8_LAS int*)(lds + STAGE_BYTES);
    unsigned vAc[2][2], vAn[2][2];
#define PG8_GIDX(ui_, vo) do { _Pragma("unroll") for (int _i = 0; _i < 2; ++_i) { int _R, _C; stage_rc(tid * 16 + _i * 8192, _R, _C); _Pragma("unroll") for (int _h = 0; _h < 2; ++_h) \
        vo[_h][_i] = (unsigned)(gidx[(ui_) * 256 + _h * 128 + _R] * g.lda * ES + 2 * _C); } } while (0)
#define PG8_STAGE_A(bufoff, base, h, nx) do { if constexpr (GATHER) { unsigned _vo[2] = {(nx) ? vAn[h][0] : vAc[h][0], (nx) ? vAn[h][1] : vAc[h][1]}; PG8_STAGE(bufoff, base, _vo); } \
        else { PG8_STAGE(bufoff, (base) + (h) * hstepA, voffA); } } while (0)
    const size_t kstep = (size_t)(BK * 2);
    const size_t hstepA = (size_t)HALF * g.lda * ES, hstepB = (size_t)HALF * g.ldb * ES, hstepB2 = (size_t)HALF * g.ldb2 * ES;
    const unsigned ldsw = (unsigned)wid * 1024u;
    const int aoff = lds_byte(wr * 64 + fr, fq * 8), boff = lds_byte(wc * 32 + fr, fq * 8);
#define PG8_SA(b, h) (((b) * 2 + (h)) * HTB)
#define PG8_SB(b, h) ((4 + (b) * 2 + (h)) * HTB)
#define PG8_STAGE(bufoff, gbase, voff) do { _Pragma("unroll") for (int _i = 0; _i < 2; ++_i) { unsigned _o = (voff)[_i]; asm volatile("" : "+v"(_o));   \
        __builtin_amdgcn_global_load_lds((const unsigned*)((const char*)(gbase) + _o), (PG8_LAS unsigned*)(lds + (bufoff) + ldsw + _i * 8192), 16, 0, 0); } } while (0)
#define PG8_LDA(dst, b, h) do { if constexpr (FP8) { _Pragma("unroll") for (int m = 0; m < 4; ++m) { dst##q[m].lo = *(const PG8_LAS pg8_i32x4*)(lds + PG8_SA(b, h) + aoff + m * 2048); dst##q[m].hi = *(const PG8_LAS pg8_i32x4*)(lds + PG8_SA(b, h) + aoff + m * 2048 + 1024); } } \
        else { _Pragma("unroll") for (int m = 0; m < 4; ++m) _Pragma("unroll") for (int k = 0; k < 2; ++k) dst[m][k] = *(const PG8_LAS bf16x8*)(lds + PG8_SA(b, h) + aoff + m * 2048 + k * 1024); } } while (0)
#define PG8_LDB(dst, b, h) do { if constexpr (FP8) { _Pragma("unroll") for (int n = 0; n < 2; ++n) { dst##q[n].lo = *(const PG8_LAS pg8_i32x4*)(lds + PG8_SB(b, h) + boff + n * 2048); dst##q[n].hi = *(const PG8_LAS pg8_i32x4*)(lds + PG8_SB(b, h) + boff + n * 2048 + 1024); } } \
        else { _Pragma("unroll") for (int n = 0; n < 2; ++n) _Pragma("unroll") for (int k = 0; k < 2; ++k) dst[n][k] = *(const PG8_LAS bf16x8*)(lds + PG8_SB(b, h) + boff + n * 2048 + k * 1024); } } while (0)
#define PG8_CAT(v) (v)
#define PG8_MMA(ai, bj, At, Bt) do { __builtin_amdgcn_s_setprio(1); \
        if constexpr (FP8) { _Pragma("unroll") for (int m = 0; m < 4; ++m) _Pragma("unroll") for (int n = 0; n < 2; ++n) \
            acc[ai][bj][m][n] = __builtin_amdgcn_mfma_scale_f32_16x16x128_f8f6f4(Bt##q[n], At##q[m], acc[ai][bj][m][n], 0, 0, 0, 0x7c7c7c7c, 0, 0x7c7c7c7c); } \
        else { _Pragma("unroll") for (int m = 0; m < 4; ++m) _Pragma("unroll") for (int n = 0; n < 2; ++n) _Pragma("unroll") for (int k = 0; k < 2; ++k) \
            acc[ai][bj][m][n] = __builtin_amdgcn_mfma_f32_16x16x32_bf16(Bt[n][k], At[m][k], acc[ai][bj][m][n], 0, 0, 0); } \
        __builtin_amdgcn_s_setprio(0); } while (0)
#define PG8_WAIT_V(n) asm volatile("s_waitcnt vmcnt(" #n ")" ::: "memory")
#define PG8_WAIT_L(n) asm volatile("s_waitcnt lgkmcnt(" #n ")" ::: "memory")
#define PG8_BAR __builtin_amdgcn_s_barrier()
#define PG8_SCHED __builtin_amdgcn_sched_barrier(0)
#define PG8_KSP(u) ((MIXED && (u).aux) ? g.ksplit2 : g.ksplit)
#define PG8_BK(u, t) ((t) < PG8_KSP(u) ? (u).B + (size_t)(t) * kstep : (u).B2 + (size_t)((t) - PG8_KSP(u)) * kstep)
#define PG8_VB2(i_) (FP8 ? (((voffB[i_] & ~1023u) >> 1) + (voffB[i_] & 1023u)) : voffB2[i_])
#define PG8_STAGE_B(bufoff, base, h, kd) do { if constexpr (MIXED) { unsigned _vb[2] = {(kd) ? PG8_VB2(0) : voffB[0], (kd) ? PG8_VB2(1) : voffB[1]}; PG8_STAGE(bufoff, (base) + (h) * ((kd) ? hstepB2 : hstepB), _vb); } \
        else { PG8_STAGE(bufoff, (base) + (h) * hstepB, voffB); } } while (0)
    Unit cur, nxt; int ui = 0; int pub_pm = -1;
    if (!S.next(0, cur)) return;
    f32x4 acc[2][2][4][2];
#pragma unroll
    for (int a = 0; a < 2; ++a)
#pragma unroll
        for (int b = 0; b < 2; ++b)
#pragma unroll
            for (int m = 0; m < 4; ++m)
#pragma unroll
                for (int n = 0; n < 2; ++n) acc[a][b][m][n] = (f32x4){0.f, 0.f, 0.f, 0.f};
    bf16x8 At[4][2], B0[2][2], B1[2][2];
    pg8_i32x8 Atq[4], B0q[2], B1q[2];
    {
        const char* cA = cur.A; const char* b0 = PG8_BK(cur, 0); const char* b1 = PG8_BK(cur, 1);
        if constexpr (WAITS) S.a_ready(cur);
        if constexpr (GATHER) { PG8_GIDX(0, vAc); }
        const int kc = cur.aux;
        PG8_STAGE_B(PG8_SB(0, 0), b0, 0, kc); PG8_STAGE_B(PG8_SB(0, 1), b0, 1, kc); PG8_STAGE_A(PG8_SA(0, 0), cA, 0, false); PG8_STAGE_A(PG8_SA(0, 1), cA, 1, false);
        if (wr == 1) PG8_BAR;
        PG8_WAIT_V(2); PG8_BAR;
        PG8_STAGE_B(PG8_SB(1, 0), b1, 0, kc); PG8_STAGE_A(PG8_SA(1, 0), cA + kstep, 0, false); PG8_STAGE_B(PG8_SB(1, 1), b1, 1, kc);
        PG8_WAIT_V(6); PG8_BAR;
    }
    for (;;) {
        const bool has_next = S.next(ui + 1, nxt);
        if (!has_next) nxt = cur;
        if constexpr (GATHER) { PG8_GIDX(has_next ? ui + 1 : ui, vAn); }
        const char* cA = cur.A;
#pragma unroll 1
        for (int t = 0; t < nt; t += 2) {
            const bool last = (t == nt - 2);
            const char* a1 = cA + (size_t)(t + 1) * kstep;
            const char* a2 = last ? nxt.A : cA + (size_t)(t + 2) * kstep;
            const char* a3 = a2 + kstep;
            const char* b2 = last ? PG8_BK(nxt, 0) : PG8_BK(cur, t + 2);
            const char* b3 = last ? PG8_BK(nxt, 1) : PG8_BK(cur, t + 3);
            const int kb = last ? nxt.aux : cur.aux;
            if constexpr (WAITS) { if (last && has_next) S.a_ready(nxt); }
            PG8_LDB(B0, 0, 0); PG8_LDB(B1, 0, 1); PG8_SCHED; PG8_LDA(At, 0, 0); PG8_STAGE_A(PG8_SA(1, 1), a1, 1, false);
            PG8_WAIT_V(8); PG8_WAIT_L(0); PG8_BAR;
            if constexpr (PUBL) { if (t == 2 && pub_pm >= 0) { if (wid == 0 && lane == 0) E.publish(pub_pm); pub_pm = -1; } }
            PG8_MMA(0, 0, At, B0); PG8_MMA(0, 1, At, B1); PG8_BAR; PG8_SCHED;
            PG8_LDA(At, 0, 1); PG8_STAGE_B(PG8_SB(0, 0), b2, 0, kb); PG8_STAGE_B(PG8_SB(0, 1), b2, 1, kb); PG8_STAGE_A(PG8_SA(0, 0), a2, 0, last);
            PG8_WAIT_V(8); PG8_WAIT_L(0); PG8_BAR; PG8_MMA(1, 0, At, B0); PG8_MMA(1, 1, At, B1); PG8_BAR; PG8_SCHED;
            PG8_LDB(B0, 1, 0); PG8_LDB(B1, 1, 1); PG8_SCHED; PG8_LDA(At, 1, 0); PG8_STAGE_A(PG8_SA(0, 1), a2, 1, last);
            PG8_WAIT_V(8); PG8_WAIT_L(0); PG8_BAR; PG8_MMA(0, 0, At, B0); PG8_MMA(0, 1, At, B1); PG8_BAR; PG8_SCHED;
            PG8_LDA(At, 1, 1); PG8_STAGE_B(PG8_SB(1, 0), b3, 0, kb); PG8_STAGE_B(PG8_SB(1, 1), b3, 1, kb); PG8_STAGE_A(PG8_SA(1, 0), a3, 0, last);
            PG8_WAIT_V(8); PG8_WAIT_L(0); PG8_BAR; PG8_MMA(1, 0, At, B0); PG8_MMA(1, 1, At, B1); PG8_BAR; PG8_SCHED;
        }
        if (wr == 0) PG8_BAR;
        E(acc, cur, wr, wc, fr, fq);
        if constexpr (PUBL) pub_pm = cur.pm;
        if (!has_next) break;
#pragma unroll
        for (int a = 0; a < 2; ++a)
#pragma unroll
            for (int b = 0; b < 2; ++b)
#pragma unroll
                for (int m = 0; m < 4; ++m)
#pragma unroll
                    for (int n = 0; n < 2; ++n) acc[a][b][m][n] = (f32x4){0.f, 0.f, 0.f, 0.f};
        cur = nxt; ++ui;
        if constexpr (GATHER) { _Pragma("unroll") for (int _h = 0; _h < 2; ++_h) _Pragma("unroll") for (int _i = 0; _i < 2; ++_i) vAc[_h][_i] = vAn[_h][_i]; }
        if (wr == 1) PG8_BAR;
    }
    PG8_WAIT_V(0);
    PG8_BAR;
    if constexpr (PUBL) { if (pub_pm >= 0 && wid == 0 && lane == 0) E.publish(pub_pm); }
#undef PG8_SA
#undef PG8_SB
#undef PG8_STAGE
#undef PG8_LDA
#undef PG8_LDB
#undef PG8_MMA
#undef PG8_CAT
#undef PG8_WAIT_V
#undef PG8_WAIT_L
#undef PG8_BAR
#undef PG8_SCHED
#undef PG8_BK
#undef PG8_KSP
#undef PG8_STAGE_B
#undef PG8_VB2
#undef PG8_GIDX
#undef PG8_STAGE_A
}

struct EpiStore {
    bf16_t* p; bf16_t* pctx; int mode;
    __device__ __forceinline__ void operator()(const f32x4 (&acc)[2][2][4][2], const Unit& u, int wr_, int wc_, int fr_, int fq_) const {
        const int t_ = opaque_tid(), wid_ = __builtin_amdgcn_readfirstlane(t_ >> 6), wr = wid_ >> 2, wc = wid_ & 3, fr = t_ & 15, fq = (t_ & 63) >> 4; (void)wr_; (void)wc_; (void)fr_; (void)fq_;
        bf16_t* base; int ldc;
        if (mode == 0) { if (u.aux) { base = pctx; ldc = 1024; } else { base = p; ldc = 3072; } } else { base = p; ldc = 1024; }
        const int row0 = u.pm * BM + wr * 64 + fr, col0 = u.pn * BM + wc * 32 + 8 * fq;
        if (mode == 0 && u.pn >= 2 && u.pn < 6) {
            const int colu = 512 + (u.pn - 2) * 128 + wc * 32 + 8 * fq;
#pragma unroll
            for (int ai = 0; ai < 2; ++ai)
#pragma unroll
                for (int m = 0; m < 4; ++m) { const f32x4 a0 = acc[ai][0][m][0], a1 = acc[ai][0][m][1], x0 = acc[ai][1][m][0], x1 = acc[ai][1][m][1];
                    u32x4 w; w.x = cvt_pk_bf16(a0[0] * x0[0], a0[1] * x0[1]); w.y = cvt_pk_bf16(a0[2] * x0[2], a0[3] * x0[3]); w.z = cvt_pk_bf16(a1[0] * x1[0], a1[1] * x1[1]); w.w = cvt_pk_bf16(a1[2] * x1[2], a1[3] * x1[3]);
                    __builtin_nontemporal_store(w, (u32x4*)(base + (size_t)(row0 + ai * HALF + m * 16) * ldc + colu)); }
            return;
        }
#pragma unroll
        for (int ai = 0; ai < 2; ++ai)
#pragma unroll
            for (int m = 0; m < 4; ++m) { bf16_t* rowp = base + (size_t)(row0 + ai * HALF + m * 16) * ldc + col0;
#pragma unroll
                for (int bj = 0; bj < 2; ++bj) { const f32x4 v0 = acc[ai][bj][m][0], v1 = acc[ai][bj][m][1];
                    u32x4 w; w.x = cvt_pk_bf16(v0[0], v0[1]); w.y = cvt_pk_bf16(v0[2], v0[3]); w.z = cvt_pk_bf16(v1[0], v1[1]); w.w = cvt_pk_bf16(v1[2], v1[3]);
                    if (mode == 0) __builtin_nontemporal_store(w, (u32x4*)(rowp + bj * HALF)); else *(u32x4*)(rowp + bj * HALF) = w; } }
    }
};
}

struct SchedG1 {
    const char* hln; const char* WinT; const char* hc; const char* WgT; int G, c;
    __device__ __forceinline__ bool next(int i, pg8::Unit& u) const {
        const int L = i * G + c;
        if (L < 1536) { int pm, pn; pg8::static_order(L, 128, 12, pm, pn); u.pm = pm; u.pn = pn; u.aux = 0; u.A = hln + (size_t)pm * 256 * 2048; u.B = WinT + (size_t)pn * 256 * 2048; u.B2 = u.B; return true; }
        return false;
    }
};
struct SchedG2 {
    const char* A; const char* Bt; int G, c;
    __device__ __forceinline__ bool next(int i, pg8::Unit& u) const {
        const int L = i * G + c; if (L >= 512) return false;
        int pm, pn; pg8::static_order(L, 128, 4, pm, pn); u.pm = pm; u.pn = pn; u.aux = 0; u.A = A + (size_t)pm * 256 * 1024; u.B = Bt + (size_t)pn * 256 * 1024; u.B2 = u.B; return true;
    }
};
__device__ __forceinline__ void cls_experts(int c, int& e_lo, int& e_hi) { const int g = c / 6, pi = c % 6; e_lo = g * 4 + (pi < 3 ? 0 : (pi < 5 ? 1 : 2)); e_hi = g * 4 + (pi < 3 ? pi + 1 : (pi < 5 ? pi - 1 : 3)); }
__device__ void phase_gemm1(const Params& P, PG8_LAS unsigned char* lds) {
    SchedG1 S{(const char*)P.hln, (const char*)P.WinT, (const char*)P.hc, (const char*)P.WgT, (int)gridDim.x, (int)blockIdx.x};
    pg8::EpiStore E{P.p, P.pctx, 0}; pg8::GemmCfg g{1024, 1024, 16, 16, 1024, 16};
    pg8::gemm_phase<0, false>(lds, g, S, E);
}
__device__ void phase_ctx_proj(const Params& P) {
    typedef short bf16x8 __attribute__((ext_vector_type(8))); typedef float f32x4 __attribute__((ext_vector_type(4)));
    const int tid = opaque_tid(), lane = tid & 63, wid = tid >> 6, r16 = lane & 15, q = lane >> 4;
    const int g = blockIdx.x >> 3, j = blockIdx.x & 7, rt = wid & 3, hf = wid >> 2;
    const bf16_t* arow = P.hc + (size_t)(g * 64 + rt * 16 + r16) * D + 8 * q;
    const bf16_t* brow[4]; bool ok[4];
#pragma unroll
    for (int u = 0; u < 4; ++u) { const int t = 7 * j + 4 * hf + u; ok[u] = (u < 4 - hf) && t < 50; const int tc = ok[u] ? t : 0;
        brow[u] = (tc < 48 ? P.WinT + (size_t)(OFF_K + 16 * tc + r16) * D : P.WgT + (size_t)(16 * (tc - 48) + r16) * D) + 8 * q; }
    f32x4 acc[4];
#pragma unroll
    for (int u = 0; u < 4; ++u) acc[u] = (f32x4){0.f, 0.f, 0.f, 0.f};
#pragma unroll 1
    for (int kb = 0; kb < 8; ++kb) {
        bf16x8 a[4], b[4][4];
#pragma unroll
        for (int k4 = 0; k4 < 4; ++k4) { a[k4] = *(const bf16x8*)(arow + 32 * (4 * kb + k4));
#pragma unroll
            for (int u = 0; u < 4; ++u) b[k4][u] = *(const bf16x8*)(brow[u] + 32 * (4 * kb + k4)); }
#pragma unroll
        for (int k4 = 0; k4 < 4; ++k4) asm volatile("" : "+v"(a[k4]), "+v"(b[k4][0]), "+v"(b[k4][1]), "+v"(b[k4][2]), "+v"(b[k4][3]));
#pragma unroll
        for (int k4 = 0; k4 < 4; ++k4)
#pragma unroll
            for (int u = 0; u < 4; ++u) acc[u] = __builtin_amdgcn_mfma_f32_16x16x32_bf16(a[k4], b[k4][u], acc[u], 0, 0, 0);
    }
#pragma unroll
    for (int u = 0; u < 4; ++u) if (ok[u]) { const int t = 7 * j + 4 * hf + u;
#pragma unroll
        for (int jj = 0; jj < 4; ++jj) P.pctx[(size_t)(g * 64 + rt * 16 + 4 * q + jj) * 1024 + 16 * t + r16] = f2bf(acc[u][jj]); }
}
__device__ void phase_gemm2(const Params& P, PG8_LAS unsigned char* lds) {
    SchedG2 S{(const char*)P.ymix, (const char*)P.WoutT, (int)gridDim.x, (int)blockIdx.x};
    pg8::EpiStore E{P.ybuf, nullptr, 1}; pg8::GemmCfg g{1024, 1024, 8, 8, 1024, 8};
    pg8::gemm_phase<0, true>(lds, g, S, E);
}

struct SchedUpQ {
    const char* h2qs; const char* W13Q; const int* tileinfo; int ntiles, c;
    __device__ __forceinline__ bool next(int i, pg8::Unit& u) const {
        const int x = c & 7, j = c >> 3, pm = 32 * i + 4 * (j >> 2) + (x >> 1), pn = 4 * (x & 1) + (j & 3);
        if (pm >= ntiles) return false;
        int e_lo, e_hi; cls_experts(__builtin_amdgcn_readfirstlane(tileinfo[1 + pm]), e_lo, e_hi); const int e = (pn >> 2) ? e_hi : e_lo;
        u.pm = pm; u.pn = pn; u.aux = 0; u.A = h2qs + (size_t)pm * 256 * 1024; u.B = W13Q + ((size_t)e * 1024 + (pn & 3) * 256) * 1024; u.B2 = u.B; return true;
    }
};
struct SchedDownQ {
    const char* actq; const char* W2Q; const int* tileinfo; const unsigned* cnt; int ntiles, c;
    __device__ __forceinline__ bool next(int k, pg8::Unit& u) const {
        const int x = c & 7, j = c >> 3, jj = j >> 2, rem = ntiles & 31;
        int Hx = (rem - (x >> 1) + 3) >> 2; Hx = Hx < 0 ? 0 : (Hx > 8 ? 8 : Hx);
        const int L = 8 - Hx; const bool light = jj >= Hx;
        const int pl = light ? (k == 0 ? jj - Hx : L + 8 * (k - 1) + jj) : L + 8 * k + jj;
        const int pm = 8 * pl + x, pn = j & 3;
        if (pm >= ntiles) return false;
        int e_lo, e_hi; cls_experts(__builtin_amdgcn_readfirstlane(tileinfo[1 + pm]), e_lo, e_hi);
        u.pm = pm; u.pn = pn; u.aux = 1; u.A = actq + (size_t)pm * 256 * 1024; u.B = W2Q + ((size_t)e_lo * 1024 + pn * 256) * 512; u.B2 = W2Q + ((size_t)e_hi * 1024 + pn * 256) * 512; return true;
    }
    __device__ __forceinline__ void a_ready(const pg8::Unit& u) const {
        const unsigned* p = cnt + u.pm; unsigned sp = 0;
        while (__hip_atomic_load(p, __ATOMIC_RELAXED, __HIP_MEMORY_SCOPE_AGENT) < 8u) { __builtin_amdgcn_s_sleep(4); if (++sp > (1u << 22)) break; }
    }
};
namespace pg8 { template <> struct sched_waits<SchedDownQ> { static constexpr bool v = true; }; }
namespace pg8 {
struct EpiUpQ {
    unsigned char* act; const float* cws; unsigned* cnt;
    __device__ __forceinline__ void publish(int pm) const { __hip_atomic_fetch_add(cnt + pm, 1u, __ATOMIC_RELAXED, __HIP_MEMORY_SCOPE_AGENT); }
    __device__ __forceinline__ void operator()(const f32x4 (&acc)[2][2][4][2], const Unit& u, int wr, int wc, int fr, int fq) const {
        const int half = u.pn >> 2, row0 = u.pm * BM + wr * 64 + fr, col0 = half * 512 + (u.pn & 3) * 128 + wc * 32 + 8 * fq;
        float cw8[8];
#pragma unroll
        for (int i = 0; i < 8; ++i) cw8[i] = cws[(size_t)(row0 + (i >> 2) * HALF + (i & 3) * 16) * 2 + half];
#pragma unroll
        for (int ai = 0; ai < 2; ++ai)
#pragma unroll
            for (int m = 0; m < 4; ++m) { const int row = row0 + ai * HALF + m * 16; const float cwv = cw8[ai * 4 + m] * 8.f;
                float o[8];
#pragma unroll
                for (int n = 0; n < 2; ++n)
#pragma unroll
                    for (int j = 0; j < 4; ++j) { const float a = acc[ai][0][m][n][j], b = acc[ai][1][m][n][j]; o[n * 4 + j] = a * __builtin_amdgcn_rcpf(1.f + __expf(-a)) * b * cwv; }
                uint2 w; w.x = pack4_fp8(o[0], o[1], o[2], o[3]); w.y = pack4_fp8(o[4], o[5], o[6], o[7]);
                __hip_atomic_store((unsigned long long*)(act + (size_t)row * 1024 + col0), ((unsigned long long)w.y << 32) | w.x, __ATOMIC_RELAXED, __HIP_MEMORY_SCOPE_AGENT); }
    }
};
template <> struct epi_publishes<EpiUpQ> { static constexpr bool v = true; };
}
__device__ void phase_moe_up(const Params& P, PG8_LAS unsigned char* lds) {
    SchedUpQ S{(const char*)P.h2qs, (const char*)P.W13Q, P.tileinfo, __builtin_amdgcn_readfirstlane((int)P.ctrl[4096 + 64 * NCLS]), (int)blockIdx.x};
    pg8::EpiUpQ E{P.actq, P.cws, P.ctrl + 12288}; pg8::GemmCfg g{1024, 1024, 8, 8, 1024, 8};
    pg8::gemm_phase<0, true>(lds, g, S, E);
}
__device__ void phase_moe_down(const Params& P, PG8_LAS unsigned char* lds) {
    SchedDownQ S{(const char*)P.actq, (const char*)P.W2Q, P.tileinfo, P.ctrl + 12288, __builtin_amdgcn_readfirstlane((int)P.ctrl[4096 + 64 * NCLS]), (int)blockIdx.x};
    pg8::EpiStore E{P.moes, nullptr, 1}; pg8::GemmCfg g{1024, 512, 8, 4, 512, 4};
    pg8::gemm_phase<0, true>(lds, g, S, E);
}

__device__ __forceinline__ void unpack8(const uint4& t, float* f) {
  f[0] = __uint_as_float(t.x << 16); f[1] = __uint_as_float(t.x & 0xffff0000u); f[2] = __uint_as_float(t.y << 16); f[3] = __uint_as_float(t.y & 0xffff0000u);
  f[4] = __uint_as_float(t.z << 16); f[5] = __uint_as_float(t.z & 0xffff0000u); f[6] = __uint_as_float(t.w << 16); f[7] = __uint_as_float(t.w & 0xffff0000u);
}
__device__ __forceinline__ uint4 pack8(const float* f) { uint4 w; w.x = pack2(f[0], f[1]); w.y = pack2(f[2], f[3]); w.z = pack2(f[4], f[5]); w.w = pack2(f[6], f[7]); return w; }

namespace gla {
typedef short bf16x8 __attribute__((ext_vector_type(8)));
typedef short s16x4 __attribute__((ext_vector_type(4)));
typedef short v4i16_t __attribute__((ext_vector_type(4)));
typedef float f32x4 __attribute__((ext_vector_type(4)));
typedef float f32x2 __attribute__((ext_vector_type(2)));
typedef unsigned u32x4 __attribute__((ext_vector_type(4)));
typedef unsigned u32x2 __attribute__((ext_vector_type(2)));
#define GLAS __attribute__((address_space(3)))
typedef GLAS unsigned char* ldsp;
constexpr int VST = 288, NST = 144, KEST = 160;
constexpr int L_V = 0, L_KR = L_V + 64 * VST, L_QR = L_KR + 64 * NST, L_LW = L_QR + 64 * NST, L_PT = L_LW + 64 * 32 * 4, L_DEC = L_PT + 2 * 16 * 64 * 4,
              L_QD = L_DEC + 512, L_KINV = L_QD + 64 * NST, L_KE = L_KINV + 64 * NST, L_KE2 = L_KE + 64 * KEST, L_P = L_KE2 + 64 * KEST, L_ST = L_P + 64 * NST,
              L_RS = L_ST + 128 * NST, L_GW = L_RS + 512, L_GB = L_GW + 2 * 16 * 64 * 4, L_END = L_GB + 512;
static_assert(L_END <= 128 * 1024, "gla lds");
constexpr int L_PB0 = L_KR, L_GG = L_PB0 + 2 * 16384, L_PB1 = L_GW;
static_assert(L_GG + 512 <= L_DEC && L_PB1 + 2 * 16384 <= TIDTAB_OFF, "gla pass B lds");
constexpr int L_Z = L_GW, ZST = 68;
static_assert(L_Z + 2 * 64 * ZST * 4 <= TIDTAB_OFF, "gla pass A z image");
constexpr int L_PT2 = L_QD, PTS = 68, L_TOT = L_KINV;
static_assert(2 * 16 * PTS * 4 <= 64 * NST, "gla pass A scan image");
template <int CTRL> __device__ __forceinline__ float dpp_zf(float v) { return __builtin_bit_cast(float, __builtin_amdgcn_update_dpp(0, __builtin_bit_cast(int, v), CTRL, 0xF, 0xF, true)); }
__device__ __forceinline__ s16x4 trr(const GLAS unsigned char* p) { return __builtin_bit_cast(s16x4, __builtin_amdgcn_ds_read_tr16_b64_v4i16((GLAS v4i16_t*)p)); }
__device__ __forceinline__ bf16x8 tr_frag(const GLAS unsigned char* img, int stride, int k0, int col0, int lane) {
    const int q = lane >> 4, r = (lane & 15) >> 2, pp = lane & 3;
    const GLAS unsigned char* a = img + (k0 + 4 * q + r) * stride + (col0 + 4 * pp) * 2;
    const s16x4 lo = trr(a), hi = trr(a + 16 * stride);
    return (bf16x8){lo[0], lo[1], lo[2], lo[3], hi[0], hi[1], hi[2], hi[3]};
}
__device__ __forceinline__ bf16x8 nat_frag(const GLAS unsigned char* img, int stride, int row0, int k0, int lane) {
    return *(const GLAS bf16x8*)(img + (row0 + (lane & 15)) * stride + (k0 + 8 * (lane >> 4)) * 2);
}
__device__ __forceinline__ bf16x8 natp_frag(const GLAS unsigned char* img, int stride, int row0, int k0, int lane) {
    const GLAS unsigned char* a = img + (row0 + (lane & 15)) * stride + (k0 + 4 * (lane >> 4)) * 2;
    const s16x4 lo = *(const GLAS s16x4*)a, hi = *(const GLAS s16x4*)(a + 32);
    return (bf16x8){lo[0], lo[1], lo[2], lo[3], hi[0], hi[1], hi[2], hi[3]};
}
#define GMFMA(a, b, c) __builtin_amdgcn_mfma_f32_16x16x32_bf16(a, b, c, 0, 0, 0)

struct Src { const bf16_t* pp; int ld, qoff, koff, voff; const float* low; int lowbf; };

struct ChunkRegs { u32x4 k, q, v0, v1; f32x4 lw; };
__device__ __forceinline__ void chunk_load(ChunkRegs& cr, const Src& s, size_t row0, int h, bool withq, int tid) {
    { const int r = tid >> 3, c8 = (tid & 7) * 8; const bf16_t* pr = s.pp + (row0 + r) * s.ld;
      cr.k = __builtin_nontemporal_load((const u32x4*)(pr + s.koff + h * 64 + c8));
      if (withq) cr.q = __builtin_nontemporal_load((const u32x4*)(pr + s.qoff + h * 64 + c8)); }
    { const int r = tid >> 4, c8 = (tid & 15) * 8; cr.v0 = *(const u32x4*)(s.pp + (row0 + r) * s.ld + s.voff + h * 128 + c8); cr.v1 = *(const u32x4*)(s.pp + (row0 + 32 + r) * s.ld + s.voff + h * 128 + c8); }
    { const int r = tid >> 3, c4 = (tid & 7) * 4;
      if (s.lowbf) { const uint2 t = *(const uint2*)(s.pp + (row0 + r) * s.ld + 768 + c4);
        cr.lw = (f32x4){__uint_as_float(t.x << 16), __uint_as_float(t.x & 0xffff0000u), __uint_as_float(t.y << 16), __uint_as_float(t.y & 0xffff0000u)}; }
      else cr.lw = *(const f32x4*)(s.low + (row0 + r) * 32 + c4); }
}
__device__ __forceinline__ void chunk_store(ldsp lds, const ChunkRegs& cr, bool withq, int tid) {
    { const int r = tid >> 3, c8 = (tid & 7) * 8; *(GLAS u32x4*)(lds + L_KR + r * NST + c8 * 2) = cr.k; if (withq) *(GLAS u32x4*)(lds + L_QR + r * NST + c8 * 2) = cr.q; }
    { const int r = tid >> 4, c8 = (tid & 15) * 8; *(GLAS u32x4*)(lds + L_V + r * VST + c8 * 2) = cr.v0; *(GLAS u32x4*)(lds + L_V + (32 + r) * VST + c8 * 2) = cr.v1; }
    { const int r = tid >> 3, c4 = (tid & 7) * 4; *(GLAS f32x4*)(lds + L_LW + (r * 32 + c4) * 4) = cr.lw; }
}
__device__ __forceinline__ void gate_scan(ldsp lds, int dir, int dp, int part, float (&c)[4][2]) {
    float z[4][2];
#pragma unroll
    for (int rr = 0; rr < 4; ++rr) { const f32x2 t = *(const GLAS f32x2*)(lds + L_Z + ((dir * 64 + 4 * part + rr) * ZST + 2 * dp) * 4); z[rr][0] = t[0]; z[rr][1] = t[1]; }
    float g[4][2];
#pragma unroll
    for (int rr = 0; rr < 4; ++rr) { g[rr][0] = logsigmoid_fast(z[rr][0]) * (1.f / 16.f); g[rr][1] = logsigmoid_fast(z[rr][1]) * (1.f / 16.f); }
#pragma unroll
    for (int e = 0; e < 2; ++e) {
        const float a0 = g[0][e], a1 = a0 + g[1][e], a2 = a1 + g[2][e], a3 = a2 + g[3][e];
        c[0][e] = dir ? a3 : a0; c[1][e] = dir ? a3 - a0 : a1; c[2][e] = dir ? a3 - a1 : a2; c[3][e] = dir ? a3 - a2 : a3;
    }
}
__device__ __forceinline__ void stage_gate_w(const Params& P, ldsp lds, int h, int tid) {
#pragma unroll
    for (int i = 0; i < 4; ++i) { const int idx = tid + 512 * i, dir = idx >> 10, r = (idx >> 6) & 15, d = idx & 63;
        *(GLAS float*)(lds + L_GW + idx * 4) = (dir ? P.gw_b : P.gw_f)[r * 256 + h * 64 + d]; }
    if (tid < 128) *(GLAS float*)(lds + L_GB + tid * 4) = ((tid >> 6) ? P.gb_b : P.gb_f)[h * 64 + (tid & 63)];
}

__device__ void pass_a(const Params& P, ldsp lds) {
    const int tid = opaque_tid(), lane = tid & 63, wid = tid >> 6, dp = tid & 31, part = tid >> 5;
    const int dt = wid & 3, eh = wid >> 2, q = lane >> 4, c16 = lane & 15;
    for (int item = blockIdx.x; item < 256 + 128; item += gridDim.x) {
        const bool isctx = item >= 256;
        int b, h, seg, nch; Src s; size_t rowbase;
        if (!isctx) { b = item >> 5; h = (item >> 3) & 3; seg = item & 7; nch = 8; s = Src{P.p, NP, OFF_Q, OFF_K, OFF_V, P.low, 0}; rowbase = (size_t)b * SEQ + seg * 512; }
        else { const int j = item - 256; b = j >> 4; h = (j >> 2) & 3; seg = 0; nch = 1; s = Src{P.pctx, 1024, 0, 0, 256, P.low, 1}; rowbase = (size_t)b * CTXL + (j & 3) * 64; }
        __syncthreads();
        const int zrt = wid & 3, zdir = wid >> 2;
        float zbias[4];
        { bf16x8 zb[4]; const float* gwp = (zdir ? P.gw_b : P.gw_f) + h * 64; const float* gbp = (zdir ? P.gb_b : P.gb_f) + h * 64;
#pragma unroll
          for (int ct = 0; ct < 4; ++ct) { float wv8[8];
#pragma unroll
            for (int jj = 0; jj < 8; ++jj) wv8[jj] = gwp[((8 * q + jj) & 15) * 256 + 16 * ct + c16];
#pragma unroll
            for (int jj = 0; jj < 8; ++jj) zb[ct][jj] = (short)f2bf(wv8[jj]);
            zbias[ct] = gbp[16 * ct + c16]; }
          if (zrt == 0) {
#pragma unroll
            for (int ct = 0; ct < 4; ++ct) *(GLAS bf16x8*)(lds + L_PT + ((zdir * 4 + ct) * 64 + lane) * 16) = zb[ct]; } }
        f32x4 Sf[4], Sb[4];
#pragma unroll
        for (int n = 0; n < 4; ++n) { Sf[n] = (f32x4){0.f, 0.f, 0.f, 0.f}; Sb[n] = (f32x4){0.f, 0.f, 0.f, 0.f}; }
        float LPb[2] = {0.f, 0.f}, LPf[2] = {0.f, 0.f};
        const bool wq = !isctx;
        ChunkRegs cr; chunk_load(cr, s, rowbase, h, wq, tid);
        for (int n = 0; n < nch; ++n) {
            __syncthreads();
            chunk_store(lds, cr, wq, tid);
            if (n + 1 < nch) chunk_load(cr, s, rowbase + (n + 1) * 64, h, wq, tid);
            __syncthreads();
            {
                const GLAS float* lp = (const GLAS float*)(lds + L_LW) + (16 * zrt + c16) * 32 + zdir * 16 + 8 * (q & 1);
                const f32x4 x0 = *(const GLAS f32x4*)lp, x1 = *(const GLAS f32x4*)(lp + 4);
                const float xv[8] = {x0[0], x0[1], x0[2], x0[3], x1[0], x1[1], x1[2], x1[3]};
                bf16x8 za;
#pragma unroll
                for (int jj = 0; jj < 8; ++jj) { const bf16_t hi = f2bf(xv[jj]); const float hif = __uint_as_float((unsigned)hi << 16); za[jj] = (short)((q >> 1) ? f2bf(xv[jj] - hif) : hi); }
#pragma unroll
                for (int ct = 0; ct < 4; ++ct) { f32x4 zc = (f32x4){0.f, 0.f, 0.f, 0.f}; zc = GMFMA(za, *(const GLAS bf16x8*)(lds + L_PT + ((zdir * 4 + ct) * 64 + lane) * 16), zc);
#pragma unroll
                    for (int j = 0; j < 4; ++j) *(GLAS float*)(lds + L_Z + ((zdir * 64 + 16 * zrt + 4 * q + j) * ZST + 16 * ct + c16) * 4) = zc[j] + zbias[ct]; }
            }
            __syncthreads();
            float cf[4][2], cb[4][2];
            gate_scan(lds, 0, dp, part, cf); gate_scan(lds, 1, dp, part, cb);
            GLAS float* PT = (GLAS float*)(lds + L_PT2); GLAS float* TOT = (GLAS float*)(lds + L_TOT);
            *(GLAS f32x2*)(PT + part * PTS + 2 * dp) = (f32x2){cf[3][0], cf[3][1]};
            *(GLAS f32x2*)(PT + 16 * PTS + part * PTS + 2 * dp) = (f32x2){cb[0][0], cb[0][1]};
            __syncthreads();
            { const int sdir = wid >> 2, spart = lane & 15; GLAS float* PTd = PT + sdir * 16 * PTS + spart * PTS + 16 * (wid & 3) + (lane >> 4);
#pragma unroll
              for (int p4 = 0; p4 < 4; ++p4) { const float v = PTd[4 * p4]; float sc = v;
                if (sdir == 0) { sc += dpp_zf<0x111>(sc); sc += dpp_zf<0x112>(sc); sc += dpp_zf<0x114>(sc); sc += dpp_zf<0x118>(sc); }
                else { sc += dpp_zf<0x101>(sc); sc += dpp_zf<0x102>(sc); sc += dpp_zf<0x104>(sc); sc += dpp_zf<0x108>(sc); }
                PTd[4 * p4] = sc - v;
                if (spart == (sdir ? 0 : 15)) TOT[sdir * 64 + 16 * (wid & 3) + 4 * p4 + (lane >> 4)] = sc; } }
            __syncthreads();
            float offf[2], totf[2], offb[2], totb[2];
            { const f32x2 of = *(const GLAS f32x2*)(PT + part * PTS + 2 * dp), ob = *(const GLAS f32x2*)(PT + 16 * PTS + part * PTS + 2 * dp), tf = *(const GLAS f32x2*)(TOT + 2 * dp), tb = *(const GLAS f32x2*)(TOT + 64 + 2 * dp);
              offf[0] = of[0]; offf[1] = of[1]; offb[0] = ob[0]; offb[1] = ob[1]; totf[0] = tf[0]; totf[1] = tf[1]; totb[0] = tb[0]; totb[1] = tb[1]; }
            const float etf0 = __expf(totf[0]), etf1 = __expf(totf[1]), etb0 = __expf(totb[0]), etb1 = __expf(totb[1]), elp0 = __expf(LPb[0]), elp1 = __expf(LPb[1]);
#pragma unroll
            for (int rr = 0; rr < 4; ++rr) { const int i = 4 * part + rr;
                const unsigned kk = *(const GLAS unsigned*)(lds + L_KR + i * NST + 4 * dp);
                const float k0 = __uint_as_float(kk << 16), k1 = __uint_as_float(kk & 0xffff0000u);
                const float egf0 = __expf(cf[rr][0] + offf[0]), egf1 = __expf(cf[rr][1] + offf[1]), egb0 = __expf(cb[rr][0] + offb[0]), egb1 = __expf(cb[rr][1] + offb[1]);
                const float eif0 = __builtin_amdgcn_rcpf(egf0), eif1 = __builtin_amdgcn_rcpf(egf1), eib0 = __builtin_amdgcn_rcpf(egb0), eib1 = __builtin_amdgcn_rcpf(egb1);
                const float kef0 = k0 * (etf0 * eif0), kef1 = k1 * (etf1 * eif1), keb0 = k0 * (etb0 * eib0), keb1 = k1 * (etb1 * eib1);
                *(GLAS unsigned*)(lds + L_KE + i * KEST + 4 * dp) = pack2(kef0, kef1);
                *(GLAS unsigned*)(lds + L_KE2 + i * KEST + 4 * dp) = pack2(keb0 * elp0, keb1 * elp1);
                if (wq) {
                    const unsigned qq = *(const GLAS unsigned*)(lds + L_QR + i * NST + 4 * dp);
                    const float q0 = __uint_as_float(qq << 16) * 0.125f, q1 = __uint_as_float(qq & 0xffff0000u) * 0.125f;
                    const size_t o0 = (rowbase + n * 64 + i) * 256 + h * 64 + 2 * dp, o1 = o0 + (size_t)NTOK * 256;
                    __builtin_nontemporal_store(pack2(q0 * egf0, q1 * egf1), (unsigned*)(P.gqd + o0)); __builtin_nontemporal_store(pack2(k0 * eif0, k1 * eif1), (unsigned*)(P.gkinv + o0));
                    __builtin_nontemporal_store(pack2(q0 * egb0, q1 * egb1), (unsigned*)(P.gqd + o1)); __builtin_nontemporal_store(pack2(k0 * eib0, k1 * eib1), (unsigned*)(P.gkinv + o1)); } }
            if (part == 0) { *(GLAS f32x2*)(lds + L_DEC + 8 * dp) = (f32x2){etf0, etf1};
                if (wq) { const size_t ch = (rowbase >> 6) + n; *(float2*)(P.gdec + (ch * 4 + h) * 64 + 2 * dp) = (float2){etf0, etf1}; *(float2*)(P.gdec + ((512 + ch) * 4 + h) * 64 + 2 * dp) = (float2){etb0, etb1}; } }
            LPb[0] += totb[0]; LPb[1] += totb[1]; LPf[0] += totf[0]; LPf[1] += totf[1];
            __syncthreads();
            const f32x4 dec = *(const GLAS f32x4*)(lds + L_DEC + (16 * dt + 4 * q) * 4);
#pragma unroll
            for (int nn = 0; nn < 4; ++nn) Sf[nn] = Sf[nn] * dec;
#pragma unroll
            for (int ks = 0; ks < 2; ++ks) {
                const bf16x8 af = tr_frag(lds + L_KE, KEST, 32 * ks, 16 * dt, lane), ab = tr_frag(lds + L_KE2, KEST, 32 * ks, 16 * dt, lane);
#pragma unroll
                for (int nn = 0; nn < 4; ++nn) { const bf16x8 bv = tr_frag(lds + L_V, VST, 32 * ks, 64 * eh + 16 * nn, lane); Sf[nn] = GMFMA(af, bv, Sf[nn]); Sb[nn] = GMFMA(ab, bv, Sb[nn]); }
            }
        }
        float* Uf; float* Ub;
        if (!isctx) { Uf = P.Useg + (size_t)(item * 2) * 8192; Ub = Uf + 8192; }
        else { Uf = P.ctxS + (size_t)((item - 256) * 2) * 8192; Ub = Uf + 8192; }
#pragma unroll
        for (int nn = 0; nn < 4; ++nn) { *(f32x4*)(Uf + tid * 16 + 4 * nn) = Sf[nn]; *(f32x4*)(Ub + tid * 16 + 4 * nn) = Sb[nn]; }
        if (part == 0) { float* Dg = isctx ? P.ctxS + (size_t)256 * 8192 + (size_t)((item - 256) * 2) * 64 : P.Dseg + (size_t)(item * 2) * 64;
            *(float2*)(Dg + 2 * dp) = (float2){__expf(LPf[0]), __expf(LPf[1])}; *(float2*)(Dg + 64 + 2 * dp) = (float2){__expf(LPb[0]), __expf(LPb[1])}; }
    }
}

struct ChunkB { u32x4 qd, kinv, v0, v1; f32x4 dec; };
__device__ __forceinline__ void chunkb_load(ChunkB& cr, const Params& P, int dir, size_t row0, int h, int tid) {
    { const int r = tid >> 3, c8 = (tid & 7) * 8; const size_t o = ((size_t)dir * NTOK + row0 + r) * 256 + h * 64 + c8;
      cr.qd = __builtin_nontemporal_load((const u32x4*)(P.gqd + o)); cr.kinv = __builtin_nontemporal_load((const u32x4*)(P.gkinv + o)); }
    { const int r = tid >> 4, c8 = (tid & 15) * 8; cr.v0 = *(const u32x4*)(P.p + (row0 + r) * NP + OFF_V + h * 128 + c8); cr.v1 = *(const u32x4*)(P.p + (row0 + 32 + r) * NP + OFF_V + h * 128 + c8); }
    if (tid < 16) cr.dec = *(const f32x4*)(P.gdec + (((size_t)dir * 512 + (row0 >> 6)) * 4 + h) * 64 + 4 * tid);
}
__device__ __forceinline__ void chunkb_store(ldsp lds, const ChunkB& cr, int tid) {
    { const int r = tid >> 3, c8 = (tid & 7) * 8; *(GLAS u32x4*)(lds + L_QD + r * NST + c8 * 2) = cr.qd; *(GLAS u32x4*)(lds + L_KE + r * KEST + c8 * 2) = cr.kinv; }
    { const int r = tid >> 4, c8 = (tid & 15) * 8; *(GLAS u32x4*)(lds + L_V + r * VST + c8 * 2) = cr.v0; *(GLAS u32x4*)(lds + L_V + (32 + r) * VST + c8 * 2) = cr.v1; }
    if (tid < 16) *(GLAS f32x4*)(lds + L_DEC + 16 * tid) = cr.dec;
}
__device__ __forceinline__ void fold_state(const Params& P, f32x4 (&S)[4], int item, int dir, int tid, int dt, int q) {
    const int b = item >> 5, h = (item >> 3) & 3, seg = item & 7;
    {
        f32x4 u[4][4], dd[4];
#pragma unroll
        for (int ff = 0; ff < 4; ++ff) { const int cc = dir ? 3 - ff : ff, e = (((b * 4 + h) * 4 + cc) * 2 + dir);
            const float* U = P.ctxS + (size_t)e * 8192 + tid * 16;
            dd[ff] = *(const f32x4*)(P.ctxS + (size_t)256 * 8192 + (size_t)e * 64 + 16 * dt + 4 * q);
#pragma unroll
            for (int nn = 0; nn < 4; ++nn) u[ff][nn] = *(const f32x4*)(U + 4 * nn); }
#pragma unroll
        for (int nn = 0; nn < 4; ++nn) S[nn] = u[0][nn];
#pragma unroll
        for (int ff = 1; ff < 4; ++ff)
#pragma unroll
            for (int nn = 0; nn < 4; ++nn) S[nn] = dd[ff] * S[nn] + u[ff][nn]; }
    const int nfold = dir ? 7 - seg : seg;
    for (int f0 = 0; f0 < nfold; f0 += 4) { f32x4 u[4][4], dd[4];
#pragma unroll
        for (int ff = 0; ff < 4; ++ff) { const int f = min(f0 + ff, nfold - 1), sp = dir ? 7 - f : f, it2 = (item & ~7) + sp;
            const float* U = P.Useg + (size_t)(it2 * 2 + dir) * 8192 + tid * 16;
            dd[ff] = *(const f32x4*)(P.Dseg + (size_t)(it2 * 2 + dir) * 64 + 16 * dt + 4 * q);
#pragma unroll
            for (int nn = 0; nn < 4; ++nn) u[ff][nn] = *(const f32x4*)(U + 4 * nn); }
#pragma unroll
        for (int ff = 0; ff < 4; ++ff) { const bool v = f0 + ff < nfold; const f32x4 one = (f32x4){1.f, 1.f, 1.f, 1.f}, zero = (f32x4){0.f, 0.f, 0.f, 0.f}; const f32x4 de = v ? dd[ff] : one;
#pragma unroll
            for (int nn = 0; nn < 4; ++nn) S[nn] = de * S[nn] + (v ? u[ff][nn] : zero); } }
}
__device__ void pass_b(const Params& P, ldsp lds) {
    const int tid = opaque_tid(), lane = tid & 63, wid = tid >> 6;
    const int dt = wid & 3, eh = wid >> 2, q = lane >> 4, c16 = lane & 15, it = wid & 3;
    for (int item = blockIdx.x; item < 256; item += gridDim.x) {
        const int b = item >> 5, h = (item >> 3) & 3, seg = item & 7;
        const size_t rowbase = (size_t)b * SEQ + seg * 512;
        __syncthreads();
        if (tid < 128) *(GLAS float*)(lds + L_GG + tid * 4) = P.gla_g[tid];
        f32x4 Sd[2][4];
        fold_state(P, Sd[0], item, 0, tid, dt, q); fold_state(P, Sd[1], item, 1, tid, dt, q);
        u32x2 part[4][4];
        ChunkB cr; chunkb_load(cr, P, 0, rowbase, h, tid);
#pragma unroll
        for (int t = 0; t < 8; ++t) {
#pragma unroll
            for (int dir = 0; dir < 2; ++dir) {
                const int n = dir ? 7 - t : t;
                const bool fin = dir ? (n < 4) : (n >= 4);
                int n_o = n, nx_o = dir ? t + 1 : 7 - t;
                asm volatile("" : "+s"(n_o), "+s"(nx_o));
                const size_t row0 = rowbase + n_o * 64;
                __syncthreads();
#pragma unroll
                for (int nn = 0; nn < 4; ++nn) { u32x2 wv; wv[0] = pack2(Sd[dir][nn][0], Sd[dir][nn][1]); wv[1] = pack2(Sd[dir][nn][2], Sd[dir][nn][3]);
                    *(GLAS u32x2*)(lds + L_ST + (64 * eh + 16 * nn + c16) * NST + (16 * dt + 4 * q) * 2) = wv; }
                chunkb_store(lds, cr, tid);
                if (dir == 0) chunkb_load(cr, P, 1, rowbase + nx_o * 64, h, tid);
                else if (t < 7) chunkb_load(cr, P, 0, rowbase + nx_o * 64, h, tid);
                uint2 rvr[4];
                if (fin) {
#pragma unroll
                    for (int nn = 0; nn < 4; ++nn) rvr[nn] = *(const uint2*)(P.p + (row0 + 16 * it + c16) * NP + OFF_R + h * 128 + 64 * eh + 16 * nn + 4 * q);
                }
                __syncthreads();
#pragma unroll
                for (int t2 = 0; t2 < 2; ++t2) { const int jt = eh * 2 + t2;
                    f32x4 sc = (f32x4){0.f, 0.f, 0.f, 0.f};
#pragma unroll
                    for (int ks = 0; ks < 2; ++ks) sc = GMFMA(nat_frag(lds + L_KE, KEST, 16 * jt, 32 * ks, lane), nat_frag(lds + L_QD, NST, 16 * it, 32 * ks, lane), sc);
                    const int i = 16 * it + c16;
#pragma unroll
                    for (int j = 0; j < 4; ++j) { const int jj = 16 * jt + 4 * q + j; const bool keep = dir ? (jj >= i) : (jj <= i); if (!keep) sc[j] = 0.f; }
                    u32x2 wv; wv[0] = pack2(sc[0], sc[1]); wv[1] = pack2(sc[2], sc[3]);
                    *(GLAS u32x2*)(lds + L_P + i * NST + (16 * jt + 4 * q) * 2) = wv; }
                __syncthreads();
                f32x4 o[4];
#pragma unroll
                for (int nn = 0; nn < 4; ++nn) o[nn] = (f32x4){0.f, 0.f, 0.f, 0.f};
#pragma unroll
                for (int ks = 0; ks < 2; ++ks) {
                    const bf16x8 pb = natp_frag(lds + L_P, NST, 16 * it, 32 * ks, lane), qb = nat_frag(lds + L_QD, NST, 16 * it, 32 * ks, lane);
#pragma unroll
                    for (int nn = 0; nn < 4; ++nn) { o[nn] = GMFMA(tr_frag(lds + L_V, VST, 32 * ks, 64 * eh + 16 * nn, lane), pb, o[nn]);
                        o[nn] = GMFMA(nat_frag(lds + L_ST, NST, 64 * eh + 16 * nn, 32 * ks, lane), qb, o[nn]); }
                }
                { const f32x4 dec = *(const GLAS f32x4*)(lds + L_DEC + (16 * dt + 4 * q) * 4);
#pragma unroll
                  for (int ks = 0; ks < 2; ++ks) { const bf16x8 af = tr_frag(lds + L_KE, KEST, 32 * ks, 16 * dt, lane);
#pragma unroll
                    for (int nn = 0; nn < 4; ++nn) Sd[dir][nn] = GMFMA(af, tr_frag(lds + L_V, VST, 32 * ks, 64 * eh + 16 * nn, lane), Sd[dir][nn]); }
#pragma unroll
                  for (int nn = 0; nn < 4; ++nn) Sd[dir][nn] = Sd[dir][nn] * dec; }
                if (!fin) {
#pragma unroll
                    for (int nn = 0; nn < 4; ++nn) { u32x2 wv; wv[0] = pack2(o[nn][0], o[nn][1]); wv[1] = pack2(o[nn][2], o[nn][3]);
                        if (n < 4) part[n & 3][nn] = wv; else *(GLAS u32x2*)(lds + (n < 6 ? L_PB0 + (n - 4) * 16384 : L_PB1 + (n - 6) * 16384) + nn * 4096 + tid * 8) = wv; }
                } else {
                    float ss = 0.f;
#pragma unroll
                    for (int nn = 0; nn < 4; ++nn) { const u32x2 pv = n < 4 ? part[n & 3][nn] : *(const GLAS u32x2*)(lds + (n < 6 ? L_PB0 + (n - 4) * 16384 : L_PB1 + (n - 6) * 16384) + nn * 4096 + tid * 8);
                        o[nn][0] += __uint_as_float(pv[0] << 16); o[nn][1] += __uint_as_float(pv[0] & 0xffff0000u); o[nn][2] += __uint_as_float(pv[1] << 16); o[nn][3] += __uint_as_float(pv[1] & 0xffff0000u);
                        ss += o[nn][0] * o[nn][0] + o[nn][1] * o[nn][1] + o[nn][2] * o[nn][2] + o[nn][3] * o[nn][3]; }
                    ss += __shfl_xor(ss, 16); ss += __shfl_xor(ss, 32);
                    GLAS float* RS = (GLAS float*)(lds + L_RS);
                    if (q == 0) RS[eh * 64 + 16 * it + c16] = ss;
                    __syncthreads();
                    const float tot2 = RS[16 * it + c16] + RS[64 + 16 * it + c16];
                    const float rs = rsqrtf(tot2 * (1.f / 128.f) + 1e-6f);
                    const size_t tok = row0 + 16 * it + c16;
#pragma unroll
                    for (int nn = 0; nn < 4; ++nn) { const int e = 64 * eh + 16 * nn + 4 * q;
                        const uint2 rv = rvr[nn];
                        const f32x4 gg = *(const GLAS f32x4*)(lds + L_GG + e * 4);
                        const float r0 = __uint_as_float(rv.x << 16), r1 = __uint_as_float(rv.x & 0xffff0000u), r2 = __uint_as_float(rv.y << 16), r3 = __uint_as_float(rv.y & 0xffff0000u);
                        const float rs8 = rs * 8.f;
                        *(unsigned*)((unsigned char*)P.ymix + tok * D + 512 + h * 128 + e) = pack4_fp8(o[nn][0] * rs8 * gg[0] * siluf(r0), o[nn][1] * rs8 * gg[1] * siluf(r1), o[nn][2] * rs8 * gg[2] * siluf(r2), o[nn][3] * rs8 * gg[3] * siluf(r3)); }
                }
            }
        }
    }
}
}

__device__ void phase_conv(const Params& P) {
  typedef unsigned cu32x4 __attribute__((ext_vector_type(4)));
  const int tid_ = opaque_tid(); const int lane = tid_ & 63, wl = blockIdx.x * 8 + (tid_ >> 6);
  const int ch = lane * 8;
  float cw0[8], cw1[8], cw2[8], cb[8];
#pragma unroll
  for (int j = 0; j < 8; ++j) { cw0[j] = P.conv_w[ch + j]; cw1[j] = P.conv_w[512 + ch + j]; cw2[j] = P.conv_w[1024 + ch + j]; cb[j] = P.conv_b[ch + j]; }
#pragma unroll 1
  for (int task = wl; task < 4096; task += 2048) {
    const int tok0 = task * 8, gx0 = tok0 & 63;
    const bool hl = gx0 > 0, hr = gx0 < 56;
    const bf16_t* pr = P.p + (size_t)tok0 * NP;
    cu32x4 ru[10], rb[8];
#pragma unroll
    for (int t = 0; t < 10; ++t) { const int dtk = (t == 0) ? (hl ? -1 : 0) : ((t == 9) ? (hr ? 8 : 7) : t - 1);
      ru[t] = __builtin_nontemporal_load((const cu32x4*)(pr + (ptrdiff_t)dtk * NP + OFF_AC + ch)); }
#pragma unroll
    for (int t = 0; t < 8; ++t) rb[t] = __builtin_nontemporal_load((const cu32x4*)(pr + (size_t)t * NP + OFF_AB + ch));
    float um[8], u0[8];
#pragma unroll
    for (int w = 0; w < 4; ++w) { const unsigned a0 = ru[0][w], a1 = ru[1][w];
      um[2 * w] = hl ? __uint_as_float(a0 << 16) : 0.f; um[2 * w + 1] = hl ? __uint_as_float(a0 & 0xffff0000u) : 0.f;
      u0[2 * w] = __uint_as_float(a1 << 16); u0[2 * w + 1] = __uint_as_float(a1 & 0xffff0000u); }
#pragma unroll
    for (int i = 0; i < 8; ++i) {
      const bool hn = (i < 7) || hr;
      float up[8], ya[8];
#pragma unroll
      for (int w = 0; w < 4; ++w) { const unsigned a = ru[i + 2][w];
        up[2 * w] = hn ? __uint_as_float(a << 16) : 0.f; up[2 * w + 1] = hn ? __uint_as_float(a & 0xffff0000u) : 0.f; }
#pragma unroll
      for (int w = 0; w < 4; ++w) { const unsigned bv = rb[i][w]; const float b0 = __uint_as_float(bv << 16), b1 = __uint_as_float(bv & 0xffff0000u);
        ya[2 * w] = b0 * (um[2 * w] * cw0[2 * w] + u0[2 * w] * cw1[2 * w] + up[2 * w] * cw2[2 * w] + cb[2 * w]);
        ya[2 * w + 1] = b1 * (um[2 * w + 1] * cw0[2 * w + 1] + u0[2 * w + 1] * cw1[2 * w + 1] + up[2 * w + 1] * cw2[2 * w + 1] + cb[2 * w + 1]); }
#pragma unroll
      for (int j = 0; j < 8; ++j) { um[j] = u0[j]; u0[j] = up[j]; }
      { uint2 w8; w8.x = pack4_fp8(ya[0] * 8.f, ya[1] * 8.f, ya[2] * 8.f, ya[3] * 8.f); w8.y = pack4_fp8(ya[4] * 8.f, ya[5] * 8.f, ya[6] * 8.f, ya[7] * 8.f);
        ST_WT64((unsigned char*)P.ymix + (size_t)(tok0 + i) * D + ch, w8.x, w8.y); }
    }
  }
}

struct Ln1In { float4 x[4]; uint2 y[4]; float mean0, rstd0; };
__device__ __forceinline__ void ln1_load(const Params& P, int tok, int lane, Ln1In& in) {
#pragma unroll
    for (int j = 0; j < 4; ++j) { const int k = j * 256 + lane * 4; { typedef float nx4 __attribute__((ext_vector_type(4))); const nx4 t_ = __builtin_nontemporal_load((const nx4*)(P.x + (size_t)tok * D + k)); in.x[j] = make_float4(t_[0], t_[1], t_[2], t_[3]); } in.y[j] = *(const uint2*)(P.ybuf + (size_t)tok * D + k); }
    in.mean0 = P.stats[tok * 2]; in.rstd0 = P.stats[tok * 2 + 1];
}
__device__ __forceinline__ void ln1_row(const Params& P, int tok, int lane, const Ln1In& in, const float* PR) {
    typedef float f32x4 __attribute__((ext_vector_type(4)));
    const float mean0 = in.mean0, rstd0 = in.rstd0;
    float v[16];
#pragma unroll
    for (int j = 0; j < 4; ++j) {
      const int k = j * 256 + lane * 4;
      const float4 xv = in.x[j]; const uint2 yv = in.y[j];
      const f32x4 g = *(const f32x4*)(PR + k), bb = *(const f32x4*)(PR + 1024 + k), g1 = *(const f32x4*)(PR + 2048 + k);
      v[4 * j] = (xv.x - mean0) * rstd0 * g[0] + bb[0] + g1[0] * __uint_as_float(yv.x << 16);
      v[4 * j + 1] = (xv.y - mean0) * rstd0 * g[1] + bb[1] + g1[1] * __uint_as_float(yv.x & 0xffff0000u);
      v[4 * j + 2] = (xv.z - mean0) * rstd0 * g[2] + bb[2] + g1[2] * __uint_as_float(yv.y << 16);
      v[4 * j + 3] = (xv.w - mean0) * rstd0 * g[3] + bb[3] + g1[3] * __uint_as_float(yv.y & 0xffff0000u);
    }
    float s = 0.f;
#pragma unroll
    for (int j = 0; j < 16; ++j) s += v[j];
    const float mean = wave_sum(s) * (1.f / 1024.f);
    float q = 0.f;
#pragma unroll
    for (int j = 0; j < 16; ++j) { const float dd = v[j] - mean; q += dd * dd; }
    const float rstd = rsqrtf(wave_sum(q) * (1.f / 1024.f) + 1e-5f);
#pragma unroll
    for (int j = 0; j < 4; ++j) {
      const int k = j * 256 + lane * 4;
      const f32x4 g = *(const f32x4*)(PR + 3072 + k), bb = *(const f32x4*)(PR + 4096 + k);
      const float x0 = (v[4 * j] - mean) * rstd * g[0] + bb[0], x1v = (v[4 * j + 1] - mean) * rstd * g[1] + bb[1], x2 = (v[4 * j + 2] - mean) * rstd * g[2] + bb[2], x3 = (v[4 * j + 3] - mean) * rstd * g[3] + bb[3];
      ST_WT64(P.x1 + (size_t)tok * D + k, pack2(x0, x1v), pack2(x2, x3));
    }
}
__device__ __forceinline__ void route_token(const Params& P, const float (&lg)[20], int* hcnt, int& c_out, int& rank_out, float& wlo_out, float& whi_out) {
    const float g0 = lg[0], g1 = lg[1], g2 = lg[2], g3 = lg[3];
    int gi = 0; float gm = g0;
    if (g1 > gm) { gm = g1; gi = 1; } if (g2 > gm) { gm = g2; gi = 2; } if (g3 > gm) { gm = g3; gi = 3; }
    const float pg = 1.f / (__expf(g0 - gm) + __expf(g1 - gm) + __expf(g2 - gm) + __expf(g3 - gm));
    float e[4];
#pragma unroll
    for (int n = 0; n < 4; ++n) e[n] = (gi == 0 ? lg[4 + n] : (gi == 1 ? lg[8 + n] : (gi == 2 ? lg[12 + n] : lg[16 + n])));
    int i1 = 0; float m1 = e[0];
    if (e[1] > m1) { m1 = e[1]; i1 = 1; } if (e[2] > m1) { m1 = e[2]; i1 = 2; } if (e[3] > m1) { m1 = e[3]; i1 = 3; }
    int i2 = -1; float m2 = -3.0e38f;
#pragma unroll
    for (int n = 0; n < 4; ++n) if (n != i1 && (i2 < 0 || e[n] > m2)) { m2 = e[n]; i2 = n; }
    const float ex2 = __expf(m2 - m1);
    const float w1 = 1.f / (1.f + ex2), w2 = ex2 / (1.f + ex2);
    const int lo = i1 < i2 ? i1 : i2, hi = i1 < i2 ? i2 : i1;
    const float wlo = (i1 < i2 ? w1 : w2) * pg, whi = (i1 < i2 ? w2 : w1) * pg;
    const int pidx = lo == 0 ? hi - 1 : (lo == 1 ? hi + 1 : 5);
    const int c = gi * 6 + pidx;
    c_out = c; wlo_out = wlo; whi_out = whi;
    rank_out = atomicAdd(&hcnt[c], 1);
}
__device__ void phase_ln1_router(const Params& P, float* ldsf) {
  typedef short bf16x8 __attribute__((ext_vector_type(8))); typedef float f32x4 __attribute__((ext_vector_type(4)));
  constexpr int WST = 2064;
  unsigned char* lds = (unsigned char*)ldsf;
  float* LG = (float*)(lds + 20 * WST);
  int* hcnt = (int*)(lds + 20 * WST + 8 * 16 * 32 * 4);
  float* PR = (float*)(lds + 20 * WST + 8 * 16 * 32 * 4 + 128);
  const int tid = opaque_tid(), lane = tid & 63, wid = tid >> 6;
  { const float* md = P.mod + ((blockIdx.x * 128) / SEQ) * 6144;
    for (int k = tid; k < 1024; k += 512) { PR[k] = ALPHA * P.ln_in_g[k]; PR[1024 + k] = ALPHA * P.ln_in_b[k]; PR[2048 + k] = md[2048 + k]; PR[3072 + k] = P.ln1_g[k]; PR[4096 + k] = P.ln1_b[k];
      PR[5120 + k] = 1.f + md[4096 + k]; PR[6144 + k] = md[3072 + k]; } }
  float* BS = PR + 7 * 1024;
  int* tcls = (int*)(BS + 192); int* trank = tcls + 128; int* tpos = trank + 128; int* cbase = tpos + 128; float* tw = (float*)(cbase + 32);
  { const float* md = P.mod + ((blockIdx.x * 128) / SEQ) * 6144;
    typedef float lf4 __attribute__((ext_vector_type(4)));
    lf4 wl[10]; float scl[10];
#pragma unroll
    for (int u = 0; u < 10; ++u) { const int i = tid + 512 * u, k = i / 5, c4 = i % 5; wl[u] = c4 == 0 ? *(const lf4*)(P.wgr + k * 4) : *(const lf4*)(P.wer + k * 16 + (c4 - 1) * 4); scl[u] = md[4096 + k]; }
#pragma unroll
    for (int u = 0; u < 10; ++u) {
      const int i = tid + 512 * u, k = i / 5, c4 = i % 5; const float4 t = make_float4(wl[u][0], wl[u][1], wl[u][2], wl[u][3]);
      const float sc = 1.f + scl[u];
      *(bf16_t*)(lds + (c4 * 4 + 0) * WST + k * 2) = f2bf(t.x * sc); *(bf16_t*)(lds + (c4 * 4 + 1) * WST + k * 2) = f2bf(t.y * sc);
      *(bf16_t*)(lds + (c4 * 4 + 2) * WST + k * 2) = f2bf(t.z * sc); *(bf16_t*)(lds + (c4 * 4 + 3) * WST + k * 2) = f2bf(t.w * sc); }
    float bp[20];
#pragma unroll
    for (int n = 0; n < 20; ++n) bp[n] = 0.f;
#pragma unroll
    for (int kk = 0; kk < 2; ++kk) { const int k = tid + 512 * kk; const float sh = md[3072 + k];
      const float4 g4 = *(const float4*)(P.wgr + k * 4); bp[0] += sh * g4.x; bp[1] += sh * g4.y; bp[2] += sh * g4.z; bp[3] += sh * g4.w;
#pragma unroll
      for (int c4 = 0; c4 < 4; ++c4) { const float4 e4 = *(const float4*)(P.wer + k * 16 + c4 * 4); bp[4 + 4 * c4] += sh * e4.x; bp[5 + 4 * c4] += sh * e4.y; bp[6 + 4 * c4] += sh * e4.z; bp[7 + 4 * c4] += sh * e4.w; } }
#pragma unroll
    for (int n = 0; n < 20; ++n) { const float t = wave_sum(bp[n]); if (lane == 0) BS[wid * 20 + n] = t; } }
  if (tid < NCLS) hcnt[tid] = 0;
  if (tid >= 64 && tid < 84) BS[160 + (tid - 64)] = (tid - 64) < 4 ? P.bgr[tid - 64] : P.ber[tid - 68];
  const int tokb = blockIdx.x * 128 + wid * 16;
  Ln1In inA, inB;
  ln1_load(P, tokb, lane, inA); ln1_load(P, tokb + 1, lane, inB);
  __syncthreads();
#pragma unroll 1
  for (int it = 0; it < 8; ++it) {
    const int tok0 = tokb + it * 2;
    const Ln1In cA = inA, cB = inB;
    if (it < 7) { ln1_load(P, tok0 + 2, lane, inA); ln1_load(P, tok0 + 3, lane, inB); }
    ln1_row(P, tok0, lane, cA, PR); ln1_row(P, tok0 + 1, lane, cB, PR);
  }
  asm volatile("s_waitcnt vmcnt(0)" ::: "memory");
  __syncthreads();
  const int r16 = lane & 15, q = lane >> 4;
  f32x4 a0 = {0.f, 0.f, 0.f, 0.f}, a1 = {0.f, 0.f, 0.f, 0.f};
  const bf16_t* arow = P.x1 + (size_t)(tokb + r16) * D + 8 * q;
  const unsigned char* b0p = lds + r16 * WST + 16 * q; const unsigned char* b1p = lds + (r16 < 4 ? 16 + r16 : 19) * WST + 16 * q;
#pragma unroll 1
  for (int kb = 0; kb < 2; ++kb) {
    bf16x8 av[16];
#pragma unroll
    for (int u = 0; u < 16; ++u) av[u] = *(const bf16x8*)(arow + 32 * (16 * kb + u));
#pragma unroll
    for (int u = 0; u < 16; u += 4) asm volatile("" : "+v"(av[u]), "+v"(av[u + 1]), "+v"(av[u + 2]), "+v"(av[u + 3]));
#pragma unroll
    for (int u = 0; u < 16; ++u) { const int ks = 16 * kb + u;
      a0 = __builtin_amdgcn_mfma_f32_16x16x32_bf16(av[u], *(const bf16x8*)(b0p + 64 * ks), a0, 0, 0, 0);
      a1 = __builtin_amdgcn_mfma_f32_16x16x32_bf16(av[u], *(const bf16x8*)(b1p + 64 * ks), a1, 0, 0, 0); }
  }
  float* lgw = LG + wid * 512;
#pragma unroll
  for (int j = 0; j < 4; ++j) { lgw[(4 * q + j) * 32 + r16] = a0[j]; if (r16 < 4) lgw[(4 * q + j) * 32 + 16 + r16] = a1[j]; }
  __syncthreads();
  if (lane < 16) {
    float lg[20];
#pragma unroll
    for (int n4 = 0; n4 < 5; ++n4) { const float4 t = *(const float4*)(lgw + lane * 32 + 4 * n4); lg[4 * n4] = t.x; lg[4 * n4 + 1] = t.y; lg[4 * n4 + 2] = t.z; lg[4 * n4 + 3] = t.w; }
#pragma unroll
    for (int n = 0; n < 20; ++n) { float bsum = 0.f;
#pragma unroll
      for (int w8 = 0; w8 < 8; ++w8) bsum += BS[w8 * 20 + n];
      lg[n] = (lg[n] + bsum) + BS[160 + n]; }
    int c, rk; float w0, w1; route_token(P, lg, hcnt, c, rk, w0, w1);
    const int ti = wid * 16 + lane; tcls[ti] = c; trank[ti] = rk; tw[2 * ti] = w0; tw[2 * ti + 1] = w1;
  }
  __syncthreads();
  unsigned* ctl = P.ctrl;
  if (tid < NCLS) { const int n = hcnt[tid]; unsigned base = 0u;
    if (n > 0) { base = __hip_atomic_fetch_add(ctl + 4096 + 64 * tid, (unsigned)n, __ATOMIC_RELAXED, __HIP_MEMORY_SCOPE_AGENT);
      for (unsigned k = (base + 255u) >> 8; (k << 8) < base + (unsigned)n; ++k) { const unsigned id = __hip_atomic_fetch_add(ctl + 4096 + 64 * NCLS, 1u, __ATOMIC_RELAXED, __HIP_MEMORY_SCOPE_AGENT);
        P.tileinfo[1 + id] = tid; __hip_atomic_store(ctl + 8192 + tid * 128 + k, id + 1u, __ATOMIC_RELAXED, __HIP_MEMORY_SCOPE_AGENT); } }
    cbase[tid] = (int)base; }
  __syncthreads();
  if (tid < 128) { const int c = tcls[tid]; const unsigned slot = (unsigned)(cbase[c] + trank[tid]), k = slot >> 8; unsigned* pe = ctl + 8192 + c * 128 + k; unsigned pt, sp = 0;
    while ((pt = __hip_atomic_load(pe, __ATOMIC_RELAXED, __HIP_MEMORY_SCOPE_AGENT)) == 0u) { __builtin_amdgcn_s_sleep(1); if (++sp > (1u << 24)) { pt = 1u; break; } }
    const int pos = (int)((pt - 1u) * 256u + (slot & 255u)); tpos[tid] = pos;
    P.perm[blockIdx.x * 128 + tid] = pos; P.cws[(size_t)pos * 2] = tw[2 * tid]; P.cws[(size_t)pos * 2 + 1] = tw[2 * tid + 1]; }
  __syncthreads();
  { typedef unsigned cu32x4 __attribute__((ext_vector_type(4)));
    f32x4 sc[4], sh[4];
#pragma unroll
    for (int u = 0; u < 4; ++u) { sc[u] = *(const f32x4*)(PR + 5120 + lane * 16 + 4 * u) * 8.f; sh[u] = *(const f32x4*)(PR + 6144 + lane * 16 + 4 * u) * 8.f; }
#pragma unroll
    for (int h = 0; h < 2; ++h) {
      cu32x4 t[8][2];
#pragma unroll
      for (int r = 0; r < 8; ++r) { const cu32x4* src = (const cu32x4*)(P.x1 + (size_t)(tokb + 8 * h + r) * D + lane * 16); t[r][0] = src[0]; t[r][1] = src[1]; }
#pragma unroll
      for (int r = 0; r < 8; ++r) { cu32x4 o;
#pragma unroll
        for (int u = 0; u < 4; ++u) { const unsigned w0 = t[r][u >> 1][2 * (u & 1)], w1 = t[r][u >> 1][2 * (u & 1) + 1];
          o[u] = pack4_fp8(__uint_as_float(w0 << 16) * sc[u][0] + sh[u][0], __uint_as_float(w0 & 0xffff0000u) * sc[u][1] + sh[u][1],
                           __uint_as_float(w1 << 16) * sc[u][2] + sh[u][2], __uint_as_float(w1 & 0xffff0000u) * sc[u][3] + sh[u][3]); }
        *(cu32x4*)(P.h2qs + (size_t)tpos[wid * 16 + 8 * h + r] * D + lane * 16) = o; } } }
}

__device__ void phase_moe_sort(const Params& P, int* lds) {
  int* H = lds;
  int* tot = lds + 256 * NCLS;
  int* cstart = tot + NCLS;
  int* base = cstart + 32;
  int* mycls = base + NCLS;
  int* mypos = mycls + 128;
  const int tid = opaque_tid(), b = blockIdx.x;
  { int hv[12];
#pragma unroll
    for (int u = 0; u < 12; ++u) hv[u] = P.hist[tid + 512 * u];
#pragma unroll
    for (int u = 0; u < 12; ++u) H[tid + 512 * u] = hv[u]; }
  if (tid < 128) mycls[tid] = P.cls[b * 128 + tid];
  __syncthreads();
  if (tid < NCLS) { int t = 0, pre = 0; for (int bb = 0; bb < 256; ++bb) { if (bb == b) pre = t; t += H[bb * NCLS + tid]; } tot[tid] = t; base[tid] = pre; }
  __syncthreads();
  if (tid == 0) { int s = 0; for (int c = 0; c < NCLS; ++c) { cstart[c] = s; s += (tot[c] + 255) / 256 * 256; } cstart[NCLS] = s; }
  __syncthreads();
  if (tid < 128) { const int c = mycls[tid]; int r = 0; for (int j = 0; j < tid; ++j) r += (mycls[j] == c) ? 1 : 0; const int pos = cstart[c] + base[c] + r; mypos[tid] = pos;
    P.perm[b * 128 + tid] = pos; P.sidx[pos] = b * 128 + tid; P.cws[(size_t)pos * 2] = P.cw[(b * 128 + tid) * 2]; P.cws[(size_t)pos * 2 + 1] = P.cw[(b * 128 + tid) * 2 + 1]; }
  __syncthreads();
  { typedef unsigned su32x4 __attribute__((ext_vector_type(4))); su32x4 t[16];
#pragma unroll
    for (int i = 0; i < 16; ++i) { const int idx = tid + 512 * i, r = idx >> 6, cc = idx & 63; t[i] = *(const su32x4*)(P.h2q + (size_t)(b * 128 + r) * D + cc * 16); }
#pragma unroll
    for (int i = 0; i < 16; ++i) { const int idx = tid + 512 * i, r = idx >> 6, cc = idx & 63; *(su32x4*)(P.h2qs + (size_t)mypos[r] * D + cc * 16) = t[i]; } }
  if (b < NCLS) {
    const int r0 = cstart[b] + tot[b], r1 = cstart[b + 1];
    for (int i = tid; i < (r1 - r0) * 64; i += blockDim.x) *(uint4*)(P.h2qs + (size_t)(r0 + i / 64) * D + (i % 64) * 16) = make_uint4(0, 0, 0, 0);
    for (int i = tid; i < (r1 - r0); i += blockDim.x) { P.sidx[r0 + i] = 0; P.cws[(size_t)(r0 + i) * 2] = 0.f; P.cws[(size_t)(r0 + i) * 2 + 1] = 0.f; }
  }
  if (b == 0) {
    const int nt = cstart[NCLS] / 256;
    if (tid == 0) P.tileinfo[0] = nt;
    for (int t = tid; t < nt; t += blockDim.x) { int c = 0; while (c < NCLS - 1 && t * 256 >= cstart[c + 1]) ++c; P.tileinfo[1 + t] = c; }
  }
}

struct FinIn { uint2 x[4], m[4]; };
__device__ __forceinline__ void fin_load(const Params& P, int tok, int pos, int lane, FinIn& in) {
#pragma unroll
  for (int j = 0; j < 4; ++j) { const int k = j * 256 + lane * 4; in.x[j] = *(const uint2*)(P.x1 + (size_t)tok * D + k); in.m[j] = *(const uint2*)(P.moes + (size_t)pos * D + k); }
}
__device__ __forceinline__ void fin_row(const Params& P, int tok, int lane, const FinIn& in, const float4 (&g2)[4], const float4 (&lg)[4], const float4 (&lb)[4]) {
  float v[16];
#pragma unroll
  for (int j = 0; j < 4; ++j) {
    const uint2 xv = in.x[j], mv = in.m[j];
    v[4 * j] = ALPHA * __uint_as_float(xv.x << 16) + g2[j].x * __uint_as_float(mv.x << 16);
    v[4 * j + 1] = ALPHA * __uint_as_float(xv.x & 0xffff0000u) + g2[j].y * __uint_as_float(mv.x & 0xffff0000u);
    v[4 * j + 2] = ALPHA * __uint_as_float(xv.y << 16) + g2[j].z * __uint_as_float(mv.y << 16);
    v[4 * j + 3] = ALPHA * __uint_as_float(xv.y & 0xffff0000u) + g2[j].w * __uint_as_float(mv.y & 0xffff0000u);
  }
  float s = 0.f;
#pragma unroll
  for (int j = 0; j < 16; ++j) s += v[j];
  const float mean = wave_sum(s) * (1.f / 1024.f);
  float q = 0.f;
#pragma unroll
  for (int j = 0; j < 16; ++j) { const float dd = v[j] - mean; q += dd * dd; }
  const float rstd = rsqrtf(wave_sum(q) * (1.f / 1024.f) + 1e-5f);
#pragma unroll
  for (int j = 0; j < 4; ++j) {
    float4 o;
    o.x = (v[4 * j] - mean) * rstd * lg[j].x + lb[j].x; o.y = (v[4 * j + 1] - mean) * rstd * lg[j].y + lb[j].y;
    o.z = (v[4 * j + 2] - mean) * rstd * lg[j].z + lb[j].z; o.w = (v[4 * j + 3] - mean) * rstd * lg[j].w + lb[j].w;
    *(float4*)(P.out + (size_t)tok * D + j * 256 + lane * 4) = o;
  }
}
__device__ void phase_final(const Params& P) {
  const int tid_ = opaque_tid(); const int lane = tid_ & 63, wv = (blockIdx.x * blockDim.x + tid_) >> 6;
  const int tok0 = wv * 16;
  const float* md = P.mod + (tok0 / SEQ) * 6144;
  float4 g2[4], lg[4], lb[4];
#pragma unroll
  for (int j = 0; j < 4; ++j) { const int k = j * 256 + lane * 4; g2[j] = *(const float4*)(md + 5120 + k); lg[j] = *(const float4*)(P.ln2_g + k); lb[j] = *(const float4*)(P.ln2_b + k); }
  const int posl = P.perm[tok0 + (lane & 15)];
  FinIn inA, inB;
  fin_load(P, tok0, __shfl(posl, 0), lane, inA); fin_load(P, tok0 + 1, __shfl(posl, 1), lane, inB);
#pragma unroll 1
  for (int i = 0; i < 16; i += 2) {
    FinIn cA = inA, cB = inB;
    if (i + 2 < 16) { fin_load(P, tok0 + i + 2, __shfl(posl, i + 2), lane, inA); fin_load(P, tok0 + i + 3, __shfl(posl, i + 3), lane, inB); }
    fin_row(P, tok0 + i, lane, cA, g2, lg, lb); fin_row(P, tok0 + i + 1, lane, cB, g2, lg, lb);
  }
}

extern __shared__ __attribute__((aligned(16))) unsigned char dyn_lds[];

#define XB_TMO      128
#define XB_XCNT(j)  (256  + 64 * (j))
#define XB_XSUB(j)  (1280 + 64 * (j))
#define XB_XGEN(j)  (2304 + 64 * (j))
#define XB_TOP      3328
#define XB_TOPGEN   3392
#define XCD_BAR_WORDS 3456
#define XB_SPIN_CAP (1u << 22)
#define XLAS __attribute__((address_space(3)))
__device__ __forceinline__ unsigned xb_ld(unsigned* p)              { return __hip_atomic_load(p, __ATOMIC_RELAXED, __HIP_MEMORY_SCOPE_AGENT); }
__device__ __forceinline__ unsigned xb_add(unsigned* p, unsigned v) { return __hip_atomic_fetch_add(p, v, __ATOMIC_RELAXED, __HIP_MEMORY_SCOPE_AGENT); }
__device__ __forceinline__ unsigned xb_xcc_id() { return (unsigned)__builtin_amdgcn_s_getreg((3 << 11) | 20) & 0xFu; }
#define XB_SPIN(cond, bar) do { unsigned _sp = 0; while (cond) { __builtin_amdgcn_s_sleep(1); \
    if ((++_sp & 255u) == 0u) { if (xb_ld(&(bar)[XB_TMO])) break; if (_sp > XB_SPIN_CAP) { atomicAdd(&(bar)[XB_TMO], 1u); break; } } } } while (0)
struct XcdBarrier { unsigned* bar; unsigned x; volatile XLAS unsigned* st; };
__device__ __forceinline__ XcdBarrier xcd_barrier_post(unsigned* bar, volatile XLAS unsigned* st) {
    XcdBarrier b; b.bar = bar; b.x = xb_xcc_id(); b.st = st;
    if (threadIdx.x == 0) (void)xb_add(&bar[XB_XCNT(b.x)], 1u);
    return b;
}
__device__ __forceinline__ void xcd_barrier_complete(unsigned* bar, unsigned x, unsigned& nloc, unsigned& nx) {
    const unsigned G = gridDim.x * gridDim.y * gridDim.z;
    unsigned sum, cnt, mine, sp = 0u;
    for (;;) {
        sum = 0u; cnt = 0u; mine = 0u;
#pragma unroll
        for (unsigned j = 0; j < 16; ++j) { const unsigned c = xb_ld(&bar[XB_XCNT(j)]); sum += c; cnt += (c > 0u) ? 1u : 0u; mine = (j == x) ? c : mine; }
        if (sum == G) break;
        __builtin_amdgcn_s_sleep(1);
        if ((++sp & 255u) == 0u) { if (xb_ld(&bar[XB_TMO])) break; if (sp > XB_SPIN_CAP) { atomicAdd(&bar[XB_TMO], 1u); break; } }
    }
    nloc = mine > 0u ? mine : 1u; nx = cnt > 0u ? cnt : 1u;
}
__device__ __forceinline__ void xcd_barrier(const XcdBarrier& b) {
    asm volatile("s_waitcnt vmcnt(0)" ::: "memory");
    __syncthreads();
    if (opaque_tid() == 0) {
        unsigned* bar = b.bar;
        __builtin_amdgcn_s_waitcnt(0);
        unsigned nloc = b.st[0], nx = b.st[1];
        if (nloc == 0u) { xcd_barrier_complete(bar, b.x, nloc, nx); b.st[0] = nloc; b.st[1] = nx; }
        const unsigned old = xb_add(&bar[XB_XSUB(b.x)], 1u);
        const unsigned gen = old / nloc;
        if (old + 1u == (gen + 1u) * nloc) {
            __builtin_amdgcn_fence(__ATOMIC_RELEASE, "agent");
            asm volatile("s_waitcnt vmcnt(0)" ::: "memory");
            const unsigned og = xb_add(&bar[XB_TOP], 1u);
            const unsigned tg = og / nx;
            if (og + 1u == (tg + 1u) * nx) xb_add(&bar[XB_TOPGEN], 1u);
            else XB_SPIN(xb_ld(&bar[XB_TOPGEN]) == tg, bar);
            __builtin_amdgcn_fence(__ATOMIC_ACQUIRE, "agent");
            xb_add(&bar[XB_XGEN(b.x)], 1u);
            asm volatile("s_waitcnt vmcnt(0)" ::: "memory");
        } else {
            XB_SPIN(xb_ld(&bar[XB_XGEN(b.x)]) == gen, bar);
            __builtin_amdgcn_fence(__ATOMIC_ACQUIRE, "agent");
            asm volatile("s_waitcnt vmcnt(0)" ::: "memory");
        }
    }
    __syncthreads();
}

#ifndef REP_PRE
#define REP_PRE 1
#endif
#ifndef REP_HLN
#define REP_HLN 1
#endif
#ifndef REP_GEMM
#define REP_GEMM 1
#endif
#ifndef REP_GLAA
#define REP_GLAA 1
#endif
#ifndef REP_GLAB
#define REP_GLAB 1
#endif
#ifndef REP_CONV
#define REP_CONV 1
#endif
#ifndef REP_LN1
#define REP_LN1 1
#endif
#ifndef REP_SORT
#define REP_SORT 1
#endif
#ifndef REP_FIN
#define REP_FIN 1
#endif
#ifndef REP_BAR
#define REP_BAR 1
#endif
#define RUN_1(x) do { x; __syncthreads(); } while (0)
#define RUN_2(x) do { x; __syncthreads(); x; __syncthreads(); } while (0)
#define RUN_3(x) do { x; __syncthreads(); x; __syncthreads(); x; __syncthreads(); } while (0)
#define RUN__(n, x) RUN_##n(x)
#define RUN(n, x) RUN__(n, x)
#define GBAR() do { for (int _r = 0; _r < REP_BAR; ++_r) { XcdBarrier _b; _b.bar = P.ctrl; _b.x = xb_xcc_id(); _b.st = (volatile XLAS unsigned*)((XLAS unsigned char*)dyn_lds + MEGA_LDS - 16); xcd_barrier(_b); } } while (0)
__global__ __launch_bounds__(512, 2) void mega(Params P) {
  XLAS unsigned* stw = (XLAS unsigned*)((XLAS unsigned char*)dyn_lds + MEGA_LDS - 16);
  if (threadIdx.x < 4) stw[threadIdx.x] = 0u;
  if ((threadIdx.x & 63) == 0) { const unsigned hw = (unsigned)__builtin_amdgcn_s_getreg((6 << 11) | 4) & 63u; *(XLAS int*)((XLAS unsigned char*)dyn_lds + TIDTAB_OFF + hw * 4) = (int)(threadIdx.x >> 6); }
  __syncthreads();
  (void)xcd_barrier_post(P.ctrl, (volatile XLAS unsigned*)stw);
  RUN(REP_PRE, phase_pre(P, (float*)dyn_lds));
  GBAR();
  RUN(REP_HLN, phase_hln(P, (HLAS unsigned char*)dyn_lds));
  GBAR();
  RUN(REP_GEMM, phase_gemm1(P, (PG8_LAS unsigned char*)dyn_lds); phase_ctx_proj(P));
  GBAR();
  for (int stage = 0; stage < 2; ++stage) {
    if (((stage ^ (int)(blockIdx.x >> 3)) & 1) == 0) { RUN(REP_GLAA, gla::pass_a(P, (gla::ldsp)dyn_lds)); }
    else { RUN(REP_CONV, phase_conv(P)); }
  }
  GBAR();
  for (int stage = 0; stage < 2; ++stage) {
    if (((stage ^ (int)(blockIdx.x >> 3)) & 1) == 0) { RUN(REP_GLAB, gla::pass_b(P, (gla::ldsp)dyn_lds)); }
    else { phase_cvx(P, (float*)dyn_lds); }
    __syncthreads();
  }
  GBAR();
  RUN(REP_GEMM, phase_gemm2(P, (PG8_LAS unsigned char*)dyn_lds));
  GBAR();
  RUN(REP_LN1, phase_ln1_router(P, (float*)dyn_lds));
  GBAR();
  RUN(REP_GEMM, phase_moe_up(P, (PG8_LAS unsigned char*)dyn_lds));
  RUN(REP_GEMM, phase_moe_down(P, (PG8_LAS unsigned char*)dyn_lds));
  GBAR();
  RUN(REP_FIN, phase_final(P));
}

static inline size_t al256(size_t v) { return (v + 255) & ~(size_t)255; }

extern "C" void kernel_launch(void* const* d_in, const int* in_sizes, int n_in, void* d_out, int out_size, void* d_ws, size_t ws_size, hipStream_t stream) {
  Params P{};
  const float* const* in = (const float* const*)d_in;
  P.x = in[0]; P.c = in[1]; P.ctx = in[2]; P.c_ctx = in[3]; P.ln_in_g = in[4]; P.ln_in_b = in[5]; P.w_ada = in[6]; P.b_ada = in[7]; P.w_in = in[8];
  P.conv_w = in[9]; P.conv_b = in[10]; P.gw_f = in[11]; P.gb_f = in[12]; P.gw_b = in[13]; P.gb_b = in[14]; P.gla_g = in[15]; P.w_out = in[16];
  P.ln1_g = in[17]; P.ln1_b = in[18]; P.wgr = in[19]; P.bgr = in[20]; P.wer = in[21]; P.ber = in[22]; P.w1 = in[23]; P.w3 = in[24]; P.w2 = in[25];
  P.ln2_g = in[26]; P.ln2_b = in[27];
  P.out = (float*)d_out;
  unsigned char* w = (unsigned char*)d_ws; size_t off = 0;
  auto take = [&](size_t bytes) { unsigned char* r = w + off; off = al256(off + bytes); return r; };
  P.ctrl = (unsigned*)take(65536);
  P.mod = (float*)take(9 * 6144 * 4);
  P.WinT = (bf16_t*)take((size_t)3072 * 1024 * 2);
  P.WgT = (bf16_t*)take((size_t)256 * 1024 * 2);
  P.WoutT = (bf16_t*)take((size_t)1024 * 1024 * 2);
  P.W13Q = (unsigned char*)take((size_t)16 * 1024 * 1024);
  P.W2Q = (unsigned char*)take((size_t)16 * 1024 * 512);
  P.h2q = (unsigned char*)take((size_t)NTOK * D);
  P.h2qs = (unsigned char*)take((size_t)MOE_ROWS * D);
  P.actq = (unsigned char*)take((size_t)MOE_ROWS * D);
  P.gqd = (bf16_t*)P.h2q; P.gkinv = P.gqd + (size_t)2 * NTOK * 256; P.gke = P.gkinv + (size_t)2 * NTOK * 256;
  P.hc = (bf16_t*)take((size_t)NCTX * D * 2);
  P.stats = (float*)take((size_t)NTOK * 2 * 4);
  P.low = (float*)take((size_t)(NTOK + NCTX) * 32 * 4);
  P.pctx = (bf16_t*)take((size_t)NCTX * 1024 * 2);
  P.cls = (int*)take((size_t)NTOK * 4);
  P.cw = (float*)take((size_t)NTOK * 2 * 4);
  P.hist = (int*)take(256 * NCLS * 4);
  P.perm = (int*)take((size_t)NTOK * 4);
  P.sidx = (int*)take((size_t)MOE_ROWS * 4);
  P.tileinfo = (int*)take(1024);
  P.cws = (float*)take((size_t)MOE_ROWS * 2 * 4);
  P.gdec = (float*)take((size_t)2 * 512 * 4 * 64 * 4);
  P.Useg = (float*)take((size_t)512 * 8192 * 4);
  P.Dseg = (float*)take((size_t)512 * 64 * 4);
  P.h2s = (bf16_t*)take((size_t)MOE_ROWS * D * 2); P.moes = P.h2s; P.opart = P.h2s; P.ctxS = (float*)P.h2s;
  P.p = (bf16_t*)take((size_t)NTOK * NP * 2);
  P.ybuf = P.p; P.x1 = P.p + (size_t)NTOK * D; P.h2 = P.p + (size_t)2 * NTOK * D;
  P.hln = (bf16_t*)take((size_t)NTOK * D * 2); P.ymix = P.hln;
  if (off > ws_size) { fprintf(stderr, "workspace too small: need %zu have %zu\n", off, ws_size); return; }
  static bool said = false; if (!said) { said = true; fprintf(stderr, "workspace: need %zu have %zu\n", off, ws_size); }

  static int ready = 0;
  if (!ready) {
    if (hipFuncSetAttribute((const void*)mega, hipFuncAttributeMaxDynamicSharedMemorySize, MEGA_LDS) != hipSuccess) { fprintf(stderr, "hipFuncSetAttribute failed\n"); ready = -1; return; }
    int dev = 0, cus = 0, per_cu = 0;
    (void)hipGetDevice(&dev); (void)hipDeviceGetAttribute(&cus, hipDeviceAttributeMultiprocessorCount, dev);
    (void)hipOccupancyMaxActiveBlocksPerMultiprocessor(&per_cu, (const void*)mega, 512, MEGA_LDS);
    if (cus < 256 || per_cu < 1) { fprintf(stderr, "mega: needs 256 CUs with one resident block each (cus %d, per_cu %d)\n", cus, per_cu); ready = -1; return; }
    ready = 1;
  }
  if (ready < 0) return;
  (void)hipMemsetAsync(P.ctrl, 0, 65536, stream);
  void* args[] = {&P};
  hipError_t e = hipLaunchCooperativeKernel((const void*)mega, dim3(256), dim3(512), args, MEGA_LDS, stream);
  if (e != hipSuccess) fprintf(stderr, "cooperative launch failed: %s\n", hipGetErrorString(e));
}
```
